# Optimizing an MI355X kernel written in HIP

```python
import math
import jax, jax.numpy as jnp
from jax import lax
import numpy as np

D_MODEL = 2048
BATCH = 4
SEQ = 4096
DEPTH = 2

HEAD_DIM = 128
ROPE_THETA = 10000.0
NORM_EPS = 1e-6
Q_BLOCK = 128
NEG_INF = -1e30
PLE_DIM = 256
MAX_POS_OFFSET = 1024
N_EVEN = (DEPTH + 1) // 2
N_ODD = DEPTH // 2
A_HEADS = 8
A_KV_HEADS = 2
A_WINDOW = 128
B_HEADS = 8
B_Q_LORA = 512
B_KV_LORA = 256
B_NOPE = 128
B_ROPE = 64
B_V = 128
C_HEADS = 8
D_HEADS = 8
D_KV_HEADS = 2
D_CMP_LEN = 32
D_CMP_STRIDE = 16
D_CMP_HIDDEN = 256
D_SLC_LEN = 64
D_SLC_TOPN = 8
D_WINDOW = 512
FORCE_BONUS = 1e4
N_GROUPS = 4
EXPERTS_PER_GROUP = 8
N_EXPERTS = N_GROUPS * EXPERTS_PER_GROUP
EXPERT_HIDDEN = 512
TOP_K = 2
MOE_BLOCK = 128

EVEN_SPLITS = [A_HEADS * HEAD_DIM, A_KV_HEADS * HEAD_DIM, A_KV_HEADS * HEAD_DIM, B_Q_LORA, B_KV_LORA, B_ROPE]
EVEN_IN = sum(EVEN_SPLITS)
EVEN_OUT = A_HEADS * HEAD_DIM + B_HEADS * B_V
ODD_SPLITS = [C_HEADS * HEAD_DIM] * 3 + [C_HEADS] + [D_HEADS * HEAD_DIM] + [D_KV_HEADS * HEAD_DIM] * 6 + [3 * D_HEADS]
ODD_IN = sum(ODD_SPLITS)
ODD_OUT = C_HEADS * HEAD_DIM + D_HEADS * HEAD_DIM

kernel_name = "hybrid_swa_mla_fox_nsa_hmoe"


def rms_norm(x, g):
    xf = x.astype(jnp.float32)
    y = xf * lax.rsqrt(jnp.mean(xf * xf, axis=-1, keepdims=True) + NORM_EPS)
    return (y * g.astype(jnp.float32)).astype(x.dtype)


def split_cols(y, sizes):
    return jnp.split(y, np.cumsum(sizes)[:-1].tolist(), axis=-1)


def rope_tables(positions, dim):
    inv = 1.0 / (ROPE_THETA ** (jnp.arange(0, dim, 2, dtype=jnp.float32) / dim))
    ang = positions.astype(jnp.float32)[..., None] * inv
    return jnp.cos(ang), jnp.sin(ang)


def apply_rope(x, cos, sin):
    x1, x2 = jnp.split(x.astype(jnp.float32), 2, axis=-1)
    c = cos[:, :, None, :]
    s = sin[:, :, None, :]
    return jnp.concatenate([x1 * c - x2 * s, x2 * c + x1 * s], axis=-1).astype(x.dtype)


def masked_softmax(s, mask):
    s = jnp.where(mask, s, NEG_INF)
    m = jnp.max(s, axis=-1, keepdims=True)
    e = jnp.where(mask, jnp.exp(s - m), 0.0)
    return e / jnp.maximum(jnp.sum(e, axis=-1, keepdims=True), jnp.finfo(jnp.float32).tiny)


def banded_attention(q, k, v, window, sinks=None):
    B, S, H, d = q.shape
    Hk = k.shape[2]
    G = H // Hk
    nb = S // Q_BLOCK
    n_prev = -(-window // Q_BLOCK)
    L = (n_prev + 1) * Q_BLOCK

    def with_history(z):
        zp = jnp.pad(z, ((0, 0), (n_prev * Q_BLOCK, 0), (0, 0), (0, 0)))
        zp = zp.reshape(B, nb + n_prev, Q_BLOCK, Hk, z.shape[-1])
        return jnp.concatenate([zp[:, i:i + nb] for i in range(n_prev + 1)], axis=2)

    kb = with_history(k)
    vb = with_history(v)
    qb = q.reshape(B, nb, Q_BLOCK, Hk, G, d)
    s = jnp.einsum('bnqhgd,bnkhd->bnhgqk', qb, kb).astype(jnp.float32) * (d ** -0.5)
    rel = (jnp.arange(Q_BLOCK)[:, None] + n_prev * Q_BLOCK) - jnp.arange(L)[None, :]
    abs_k = jnp.arange(nb)[:, None] * Q_BLOCK - n_prev * Q_BLOCK + jnp.arange(L)[None, :]
    mask = ((rel >= 0) & (rel < window))[None] & (abs_k >= 0)[:, None, :]
    s = jnp.where(mask[None, :, None, None], s, NEG_INF)
    if sinks is not None:
        sk = jnp.broadcast_to(sinks.astype(jnp.float32).reshape(Hk, G)[None, None, :, :, None, None],
                              s.shape[:-1] + (1,))
        p = jax.nn.softmax(jnp.concatenate([s, sk], axis=-1), axis=-1)[..., :-1]
    else:
        p = jax.nn.softmax(s, axis=-1)
    o = jnp.einsum('bnhgqk,bnkhd->bnqhgd', p.astype(v.dtype), vb)
    return o.reshape(B, S, H, v.shape[-1])


def causal_attention(q, k, v, cum=None):
    B, S, H, dk = q.shape
    nb = S // Q_BLOCK
    scale = dk ** -0.5
    kpos = jnp.arange(S)
    qb = jnp.moveaxis(q.reshape(B, nb, Q_BLOCK, H, dk), 1, 0)

    def attend(i, q_i, cq_i):
        s = jnp.einsum('bqhd,bkhd->bhqk', q_i, k).astype(jnp.float32) * scale
        if cq_i is not None:
            s = s + (jnp.swapaxes(cq_i, 1, 2)[..., None] - jnp.swapaxes(cum, 1, 2)[:, :, None, :])
        qpos = i * Q_BLOCK + jnp.arange(Q_BLOCK)
        s = jnp.where(qpos[:, None] >= kpos[None, :], s, NEG_INF)
        p = jax.nn.softmax(s, axis=-1).astype(v.dtype)
        return jnp.einsum('bhqk,bkhd->bqhd', p, v)

    idx = jnp.arange(nb)
    if cum is None:
        out = lax.map(lambda a: attend(a[0], a[1], None), (idx, qb))
    else:
        cb = jnp.moveaxis(cum.reshape(B, nb, Q_BLOCK, H), 1, 0)
        out = lax.map(lambda a: attend(a[0], a[1], a[2]), (idx, qb, cb))
    return jnp.moveaxis(out, 0, 1).reshape(B, S, H, v.shape[-1])


def mixer_ab(h, cos, sin, cos_r, sin_r, w_in, sinks, q_lat_norm, kv_lat_norm, w_uq, w_ukv, w_o):
    B, S, _ = h.shape
    a_q, a_k, a_v, b_qlat, b_kvlat, b_krope = split_cols(h @ w_in, EVEN_SPLITS)
    a_q = apply_rope(a_q.reshape(B, S, A_HEADS, HEAD_DIM), cos, sin)
    a_k = apply_rope(a_k.reshape(B, S, A_KV_HEADS, HEAD_DIM), cos, sin)
    a_v = a_v.reshape(B, S, A_KV_HEADS, HEAD_DIM)
    o_a = banded_attention(a_q, a_k, a_v, A_WINDOW, sinks)
    qb = (rms_norm(b_qlat, q_lat_norm) @ w_uq).reshape(B, S, B_HEADS, B_NOPE + B_ROPE)
    q_nope, q_rope = jnp.split(qb, [B_NOPE], axis=-1)
    q_rope = apply_rope(q_rope, cos_r, sin_r)
    kv = (rms_norm(b_kvlat, kv_lat_norm) @ w_ukv).reshape(B, S, B_HEADS, B_NOPE + B_V)
    k_nope, v_b = jnp.split(kv, [B_NOPE], axis=-1)
    k_rope = apply_rope(b_krope[:, :, None, :], cos_r, sin_r)
    q_full = jnp.concatenate([q_nope, q_rope], axis=-1)
    k_full = jnp.concatenate([k_nope, jnp.broadcast_to(k_rope, (B, S, B_HEADS, B_ROPE))], axis=-1)
    o_b = causal_attention(q_full, k_full, v_b)
    o = jnp.concatenate([o_a.reshape(B, S, -1), o_b.reshape(B, S, -1)], axis=-1)
    return o @ w_o


def cmp_block_index(S):
    n_cmp = (S - D_CMP_LEN) // D_CMP_STRIDE + 1
    return np.arange(n_cmp)[:, None] * D_CMP_STRIDE + np.arange(D_CMP_LEN)[None, :]


def cmp_slc_overlap(S):
    n_cmp = (S - D_CMP_LEN) // D_CMP_STRIDE + 1
    n_slc = S // D_SLC_LEN
    c0 = np.arange(n_cmp) * D_CMP_STRIDE
    s0 = np.arange(n_slc) * D_SLC_LEN
    ov = (c0[:, None] < (s0 + D_SLC_LEN)[None, :]) & ((c0 + D_CMP_LEN)[:, None] > s0[None, :])
    return ov.astype(np.float32)


def compress_blocks(z, pe, w1, w2):
    B, S, Hk, d = z.shape
    idx = cmp_block_index(S)
    blk = z[:, idx] + pe[:, None, :].astype(z.dtype)
    blk = jnp.swapaxes(blk, 2, 3).reshape(B, idx.shape[0], Hk, D_CMP_LEN * d)
    return jax.nn.gelu(blk @ w1) @ w2


def nsa_compressed(q, k, v, positions, pe_k, w1_k, w2_k, pe_v, w1_v, w2_v):
    B, S, H, d = q.shape
    Hk = k.shape[2]
    G = H // Hk
    end = cmp_block_index(S)[:, -1]
    k_cmp = compress_blocks(k, pe_k, w1_k, w2_k)
    v_cmp = compress_blocks(v, pe_v, w1_v, w2_v)
    cos_c, sin_c = rope_tables(positions[:, end], HEAD_DIM)
    k_cmp = apply_rope(k_cmp, cos_c, sin_c)
    s = jnp.einsum('bthgd,bchd->bhgtc', q.reshape(B, S, Hk, G, d), k_cmp).astype(jnp.float32) * (d ** -0.5)
    valid = end[None, :] <= np.arange(S)[:, None]
    p = masked_softmax(s, valid)
    o = jnp.einsum('bhgtc,bchd->bthgd', p.astype(v_cmp.dtype), v_cmp).reshape(B, S, H, d)
    return o, p


def nsa_select_blocks(p_cmp, S):
    n_slc = S // D_SLC_LEN
    imp = jnp.einsum('bhgtc,cj->bhtj', p_cmp, cmp_slc_overlap(S))
    t = jnp.arange(S)[:, None]
    j = jnp.arange(n_slc)[None, :]
    cur = t // D_SLC_LEN
    forced = (j == 0) | (j == cur) | (j == cur - 1)
    imp = jnp.where(j * D_SLC_LEN > t, NEG_INF, imp + jnp.where(forced, FORCE_BONUS, 0.0))
    return lax.top_k(imp, min(D_SLC_TOPN, n_slc))[1]


def nsa_selected(q, k, v, sel):
    B, S, H, d = q.shape
    Hk = k.shape[2]
    G = H // Hk
    nb = S // Q_BLOCK
    n_slc = S // D_SLC_LEN
    topn = sel.shape[-1]
    kb = jnp.transpose(k.reshape(B, n_slc, D_SLC_LEN, Hk, d), (0, 3, 1, 2, 4))
    vb = jnp.transpose(v.reshape(B, n_slc, D_SLC_LEN, Hk, d), (0, 3, 1, 2, 4))
    qb = jnp.moveaxis(q.reshape(B, nb, Q_BLOCK, Hk, G, d), 1, 0)
    sb = jnp.moveaxis(sel.reshape(B, Hk, nb, Q_BLOCK, topn), 2, 0)
    bi = jnp.arange(B)[:, None, None, None]
    hi = jnp.arange(Hk)[None, :, None, None]

    def one_block(args):
        i, q_i, sel_i = args
        kg = kb[bi, hi, sel_i]
        vg = vb[bi, hi, sel_i]
        s = jnp.einsum('bqhgd,bhqnld->bhgqnl', q_i, kg).astype(jnp.float32) * (d ** -0.5)
        tpos = i * Q_BLOCK + jnp.arange(Q_BLOCK)
        kpos = sel_i[..., None] * D_SLC_LEN + jnp.arange(D_SLC_LEN)
        mask = (kpos <= tpos[None, None, :, None, None])[:, :, None]
        s = jnp.where(mask, s, NEG_INF).reshape(B, Hk, G, Q_BLOCK, topn * D_SLC_LEN)
        p = jax.nn.softmax(s, axis=-1).reshape(B, Hk, G, Q_BLOCK, topn, D_SLC_LEN)
        return jnp.einsum('bhgqnl,bhqnld->bqhgd', p.astype(vg.dtype), vg)

    out = lax.map(one_block, (jnp.arange(nb), qb, sb))
    return jnp.moveaxis(out, 0, 1).reshape(B, S, H, d)


def mixer_cd(h, positions, cos, sin, w_in, forget_bias, pe_k, w1_k, w2_k, pe_v, w1_v, w2_v, w_o):
    B, S, _ = h.shape
    (c_q, c_k, c_v, c_f, d_q, d_kc, d_vc, d_ks, d_vs, d_kw, d_vw, d_g) = split_cols(h @ w_in, ODD_SPLITS)
    log_f = jax.nn.log_sigmoid(c_f.astype(jnp.float32) + forget_bias.astype(jnp.float32))
    cum = jnp.cumsum(log_f, axis=1)
    o_c = causal_attention(c_q.reshape(B, S, C_HEADS, HEAD_DIM), c_k.reshape(B, S, C_HEADS, HEAD_DIM),
                           c_v.reshape(B, S, C_HEADS, HEAD_DIM), cum)
    kvh = lambda z: z.reshape(B, S, D_KV_HEADS, HEAD_DIM)
    q = apply_rope(d_q.reshape(B, S, D_HEADS, HEAD_DIM), cos, sin)
    o_cmp, p_cmp = nsa_compressed(q, kvh(d_kc), kvh(d_vc), positions, pe_k, w1_k, w2_k, pe_v, w1_v, w2_v)
    sel = nsa_select_blocks(p_cmp, S)
    o_slc = nsa_selected(q, apply_rope(kvh(d_ks), cos, sin), kvh(d_vs), sel)
    o_win = banded_attention(q, apply_rope(kvh(d_kw), cos, sin), kvh(d_vw), D_WINDOW)
    g = jax.nn.sigmoid(d_g.reshape(B, S, 3, D_HEADS, 1))
    o_d = g[:, :, 0] * o_cmp + g[:, :, 1] * o_slc + g[:, :, 2] * o_win
    o = jnp.concatenate([o_c.reshape(B, S, -1), o_d.reshape(B, S, -1)], axis=-1)
    return o @ w_o


def hierarchical_moe(h, w_group, b_group, w_expert, b_expert, w_gate, w_up, w_down):
    B, S, D = h.shape
    x = h.reshape(-1, D)
    T = x.shape[0]
    g_prob = jax.nn.softmax((x @ w_group).astype(jnp.float32) + b_group.astype(jnp.float32), axis=-1)
    g_val, g_idx = lax.top_k(g_prob, 1)
    e_logits = ((x @ w_expert).astype(jnp.float32) + b_expert.astype(jnp.float32)).reshape(T, N_GROUPS, EXPERTS_PER_GROUP)
    e_logits = jnp.take_along_axis(e_logits, g_idx[:, :, None], axis=1)[:, 0]
    e_val, e_idx = lax.top_k(jax.nn.softmax(e_logits, axis=-1), TOP_K)
    weights = g_val * e_val / jnp.sum(e_val, axis=-1, keepdims=True)
    experts = g_idx * EXPERTS_PER_GROUP + e_idx

    N = T * TOP_K
    flat_e = experts.reshape(N)
    flat_tok = jnp.repeat(jnp.arange(T, dtype=jnp.int32), TOP_K)
    flat_w = weights.reshape(N)
    order = jnp.argsort(flat_e)
    se = flat_e[order]
    counts = jnp.bincount(flat_e, length=N_EXPERTS)
    starts = jnp.cumsum(counts) - counts
    padded = (counts + MOE_BLOCK - 1) // MOE_BLOCK * MOE_BLOCK
    pends = jnp.cumsum(padded)
    dest = (pends - padded)[se] + jnp.arange(N) - starts[se]
    P = N + N_EXPERTS * MOE_BLOCK
    row_tok = jnp.full((P,), T, jnp.int32).at[dest].set(flat_tok[order])
    row_w = jnp.zeros((P,), jnp.float32).at[dest].set(flat_w[order])
    nblk = P // MOE_BLOCK
    blk_e = jnp.minimum(jnp.searchsorted(pends, jnp.arange(nblk) * MOE_BLOCK, side='right'), N_EXPERTS - 1)
    x_pad = jnp.concatenate([x, jnp.zeros((1, D), x.dtype)], axis=0)
    xb = x_pad[row_tok].reshape(nblk, MOE_BLOCK, D)

    def expert_block(args):
        xb_i, e = args
        return (jax.nn.silu(xb_i @ w_gate[e]) * (xb_i @ w_up[e])) @ w_down[e]

    yb = lax.map(expert_block, (xb, blk_e)).reshape(P, D)
    y = jax.ops.segment_sum(yb * row_w[:, None].astype(yb.dtype), row_tok, num_segments=T + 1)[:T]
    return y.reshape(B, S, D)


def per_layer_input(h, p_i, w_proj, gate_norm, w_gate):
    return h + (p_i @ w_proj) * jax.nn.sigmoid(rms_norm(h, gate_norm) @ w_gate)


def setup_inputs(seed: int = 0) -> dict:
    key = jax.random.key(seed)
    ks = iter(jax.random.split(key, 48))

    def nrm(shape, scale):
        return jax.random.normal(next(ks), shape, jnp.float32) * scale

    def gain(shape):
        return 1.0 + 0.01 * jax.random.normal(next(ks), shape, jnp.float32)

    ne, no, D = N_EVEN, N_ODD, D_MODEL
    cmp_in = D_CMP_LEN * HEAD_DIM
    return {
        "x": nrm((BATCH, SEQ, D), 1.0),
        "p": nrm((DEPTH, BATCH, SEQ, PLE_DIM), 1.0),
        "positions": (jax.random.randint(next(ks), (BATCH, 1), 0, MAX_POS_OFFSET)
                      + jnp.arange(SEQ)[None, :]).astype(jnp.int32),
        "ab_w_in": nrm((ne, D, EVEN_IN), D ** -0.5),
        "ab_sinks": nrm((ne, A_HEADS), 0.5),
        "ab_q_lat_norm": gain((ne, B_Q_LORA)),
        "ab_kv_lat_norm": gain((ne, B_KV_LORA)),
        "ab_w_uq": nrm((ne, B_Q_LORA, B_HEADS * (B_NOPE + B_ROPE)), B_Q_LORA ** -0.5),
        "ab_w_ukv": nrm((ne, B_KV_LORA, B_HEADS * (B_NOPE + B_V)), B_KV_LORA ** -0.5),
        "ab_w_o": nrm((ne, EVEN_OUT, D), EVEN_OUT ** -0.5),
        "cd_w_in": nrm((no, D, ODD_IN), D ** -0.5),
        "cd_forget_bias": 3.0 + nrm((no, C_HEADS), 0.5),
        "cd_cmp_pe_k": nrm((no, D_CMP_LEN, HEAD_DIM), 0.02),
        "cd_cmp_w1_k": nrm((no, cmp_in, D_CMP_HIDDEN), cmp_in ** -0.5),
        "cd_cmp_w2_k": nrm((no, D_CMP_HIDDEN, HEAD_DIM), D_CMP_HIDDEN ** -0.5),
        "cd_cmp_pe_v": nrm((no, D_CMP_LEN, HEAD_DIM), 0.02),
        "cd_cmp_w1_v": nrm((no, cmp_in, D_CMP_HIDDEN), cmp_in ** -0.5),
        "cd_cmp_w2_v": nrm((no, D_CMP_HIDDEN, HEAD_DIM), D_CMP_HIDDEN ** -0.5),
        "cd_w_o": nrm((no, ODD_OUT, D), ODD_OUT ** -0.5),
        "mixer_norm": gain((DEPTH, D)),
        "moe_norm": gain((DEPTH, D)),
        "router_group_w": nrm((DEPTH, D, N_GROUPS), D ** -0.5),
        "router_group_b": nrm((DEPTH, N_GROUPS), 0.01),
        "router_expert_w": nrm((DEPTH, D, N_EXPERTS), D ** -0.5),
        "router_expert_b": nrm((DEPTH, N_EXPERTS), 0.01),
        "expert_w_gate": nrm((DEPTH, N_EXPERTS, D, EXPERT_HIDDEN), D ** -0.5),
        "expert_w_up": nrm((DEPTH, N_EXPERTS, D, EXPERT_HIDDEN), D ** -0.5),
        "expert_w_down": nrm((DEPTH, N_EXPERTS, EXPERT_HIDDEN, D), EXPERT_HIDDEN ** -0.5),
        "ple_proj": nrm((DEPTH, PLE_DIM, D), PLE_DIM ** -0.5),
        "ple_gate_norm": gain((DEPTH, D)),
        "ple_gate_w": nrm((DEPTH, D, D), D ** -0.5),
        "final_norm": gain((D,)),
    }


def reference(x, p, positions, ab_w_in, ab_sinks, ab_q_lat_norm, ab_kv_lat_norm, ab_w_uq, ab_w_ukv, ab_w_o,
              cd_w_in, cd_forget_bias, cd_cmp_pe_k, cd_cmp_w1_k, cd_cmp_w2_k, cd_cmp_pe_v, cd_cmp_w1_v,
              cd_cmp_w2_v, cd_w_o, mixer_norm, moe_norm, router_group_w, router_group_b, router_expert_w,
              router_expert_b, expert_w_gate, expert_w_up, expert_w_down, ple_proj, ple_gate_norm, ple_gate_w,
              final_norm):
    cos, sin = rope_tables(positions, HEAD_DIM)
    cos_r, sin_r = rope_tables(positions, B_ROPE)
    h = x
    for i in range(DEPTH):
        j = i // 2
        hn = rms_norm(h, mixer_norm[i])
        if i % 2 == 0:
            h = h + mixer_ab(hn, cos, sin, cos_r, sin_r, ab_w_in[j], ab_sinks[j], ab_q_lat_norm[j],
                             ab_kv_lat_norm[j], ab_w_uq[j], ab_w_ukv[j], ab_w_o[j])
        else:
            h = h + mixer_cd(hn, positions, cos, sin, cd_w_in[j], cd_forget_bias[j], cd_cmp_pe_k[j],
                             cd_cmp_w1_k[j], cd_cmp_w2_k[j], cd_cmp_pe_v[j], cd_cmp_w1_v[j], cd_cmp_w2_v[j],
                             cd_w_o[j])
        h = h + hierarchical_moe(rms_norm(h, moe_norm[i]), router_group_w[i], router_group_b[i],
                                 router_expert_w[i], router_expert_b[i], expert_w_gate[i], expert_w_up[i],
                                 expert_w_down[i])
        h = per_layer_input(h, p[i], ple_proj[i], ple_gate_norm[i], ple_gate_w[i])
    return rms_norm(h, final_norm)
```

```cpp
#include <hip/hip_runtime.h>
#include <stdint.h>
#include <stdio.h>

#define LAS __attribute__((address_space(3)))
typedef unsigned short bf16_t;
typedef short bf16x8 __attribute__((ext_vector_type(8)));
typedef float f32x4 __attribute__((ext_vector_type(4)));
typedef float f32x2 __attribute__((ext_vector_type(2)));
typedef float f32x16 __attribute__((ext_vector_type(16)));
typedef unsigned u32x4 __attribute__((ext_vector_type(4)));
typedef unsigned u32x2 __attribute__((ext_vector_type(2)));
typedef unsigned long long u64;
typedef int i32x4 __attribute__((ext_vector_type(4)));
typedef int i32x8 __attribute__((ext_vector_type(8)));

constexpr int T = 16384, D = 2048, NB = 4, S = 4096;
constexpr int EVEN_IN = 2368, ODD_IN = 5664;
constexpr int NIN0 = 2560, NIN1 = 5888;
constexpr int NEXP = 32, EH = 512;
constexpr int MAXRT = 160;
constexpr float EPS = 1e-6f;
constexpr bool F8_IN0 = true, F8_MOE0 = false, F8_PLE0 = true, F8_IN1 = true, F8_MOE1 = true, F8_PLE1 = true, F8_WO0 = true, F8_WO1 = true;
constexpr float F8_OSC = 16.f;
constexpr bool F8_CMP = true;
constexpr bool F8_Y1 = true;
constexpr bool KVDMA = true;
constexpr bool KV8 = true;
constexpr bool PV8 = true;
constexpr bool QK8 = true;
constexpr float LOG2E = 1.4426950408889634f;
constexpr int NTHR = 512;

constexpr size_t al256(size_t x) { return (x + 255) & ~(size_t)255; }
constexpr size_t WS_CTL = 0;
constexpr size_t CTL_BYTES = 65536;
constexpr size_t WS_WIN0T = WS_CTL + CTL_BYTES;
constexpr size_t WS_WUQT = WS_WIN0T + (size_t)NIN0 * 2048 * 2;
constexpr size_t WS_WUKVT = WS_WUQT + (size_t)1536 * 512 * 2;
constexpr size_t WS_WO0T = WS_WUKVT + (size_t)2048 * 256 * 2;
constexpr size_t WS_WIN1T = WS_WO0T + (size_t)2048 * 2048 * 2;
constexpr size_t WS_WC1KT = WS_WIN1T + (size_t)NIN1 * 2048 * 2;
constexpr size_t WS_WC1VT = WS_WC1KT + (size_t)256 * 4096 * 2;
constexpr size_t WS_WC2KT = WS_WC1VT + (size_t)256 * 4096 * 2;
constexpr size_t WS_WC2VT = WS_WC2KT + (size_t)256 * 256 * 2;
constexpr size_t WS_WO1T = WS_WC2VT + (size_t)256 * 256 * 2;
constexpr size_t WS_WPPT = WS_WO1T + (size_t)2048 * 2048 * 2;
constexpr size_t WS_WPGT = WS_WPPT + (size_t)2 * 2048 * 256 * 2;
constexpr size_t WS_WGU = WS_WPGT + (size_t)2 * 2048 * 2048 * 2;
constexpr size_t WS_WGU1 = WS_WGU + (size_t)32 * 1024 * 2048 * 2;
constexpr size_t WS_PP1 = WS_WGU1 + (size_t)32 * 1024 * 2048;
static_assert(F8_MOE1, "WS_PP1 lives in the space the fp8 layer-1 expert weights leave free");
constexpr size_t WS_WDN = WS_WGU + (size_t)2 * 32 * 1024 * 2048 * 2;
constexpr size_t WS_WRT = WS_WDN + (size_t)2 * 32 * 2048 * 512 * 2;
constexpr size_t WS_CBIAS = WS_WRT + (size_t)2 * 48 * 2048 * 4;
constexpr size_t WS_COS128 = WS_CBIAS + 2 * 256 * 4;
constexpr size_t WS_SIN128 = WS_COS128 + (size_t)T * 64 * 4;
constexpr size_t WS_COS64 = WS_SIN128 + (size_t)T * 64 * 4;
constexpr size_t WS_SIN64 = WS_COS64 + (size_t)T * 32 * 4;
constexpr size_t WS_HBA = WS_SIN64 + (size_t)T * 32 * 4;
constexpr size_t WS_HBB = WS_HBA + (size_t)(T + 256) * 2048 * 2;
constexpr size_t WS_PB = WS_HBB + (size_t)(T + 256) * 2048 * 2;
constexpr size_t WS_PP = WS_PB + (size_t)2 * T * 256 * 2;
constexpr size_t WS_RSTD0 = WS_PP + (size_t)T * 2048 * 2;
constexpr size_t WS_RSTDM = WS_RSTD0 + (size_t)T * 4;
constexpr size_t WS_RSTDP = WS_RSTDM + (size_t)(T + 64) * 4;
constexpr size_t WS_SSQP = WS_RSTDP + (size_t)T * 4;
constexpr size_t WS_SSQQ = WS_SSQP + (size_t)T * 32 * 4;
constexpr size_t WS_SSQKV = WS_SSQQ + (size_t)T * 8 * 4;
constexpr size_t WS_SLOTE = WS_SSQKV + (size_t)T * 4 * 4;
constexpr size_t WS_SLOTR = WS_SLOTE + (size_t)T * 2 * 4;
constexpr size_t WS_LIST = WS_SLOTR + (size_t)T * 2 * 4;
constexpr size_t WS_WLIST = WS_LIST + (size_t)32 * T * 4;
constexpr size_t WS_RLIST = WS_WLIST + (size_t)32 * T * 4;
constexpr size_t WS_H8A = al256(WS_RLIST + (size_t)32 * T * 4);
constexpr size_t WS_H8B = WS_H8A + (size_t)(T + 256) * 2048;
constexpr size_t WS_O8 = WS_H8B + (size_t)(T + 256) * 2048;
constexpr size_t WS_SCR = al256(WS_O8 + (size_t)T * 2048);
constexpr size_t S0_QA = WS_SCR;
constexpr size_t S0_KA = S0_QA + (size_t)T * 1024 * 2;
constexpr size_t S0_VTA = S0_KA + (size_t)T * 256 * 2;
constexpr size_t S0_QLAT = S0_VTA + (size_t)T * 256 * 2;
constexpr size_t S0_KVLAT = S0_QLAT + (size_t)T * 512 * 2;
constexpr size_t S0_QB = S0_KVLAT + (size_t)T * 256 * 2;
constexpr size_t S0_KB = S0_QB + (size_t)T * 1536 * 2;
constexpr size_t S0_VTB = S0_KB + (size_t)T * 1536 * 2;
constexpr size_t S0_O = S0_VTB + (size_t)T * 1024 * 2;
constexpr size_t S0_END = S0_O + (size_t)T * 2048 * 2;
constexpr size_t SM_H = WS_SCR;
constexpr size_t SM_Y = SM_H + (size_t)MAXRT * 256 * 512 * 2;
constexpr size_t SM_END = SM_Y + (size_t)MAXRT * 256 * 2048 * 2;
constexpr size_t S1_CQ = WS_SCR;
constexpr size_t S1_CK = S1_CQ + (size_t)T * 1024 * 2;
constexpr size_t S1_CVT = S1_CK + (size_t)T * 1024 * 2;
constexpr size_t S1_DQ = S1_CVT + (size_t)T * 1024 * 2;
constexpr size_t S1_KC = S1_DQ + (size_t)T * 1024 * 2;
constexpr size_t S1_VC = S1_KC + (size_t)T * 256 * 2 + 8192;
constexpr size_t S1_KS = S1_VC + (size_t)T * 256 * 2 + 8192;
constexpr size_t S1_VST = S1_KS + (size_t)T * 256 * 2;
constexpr size_t S1_KW = S1_VST + (size_t)T * 256 * 2;
constexpr size_t S1_VWT = S1_KW + (size_t)T * 256 * 2;
constexpr size_t S1_LF = S1_VWT + (size_t)T * 256 * 2;
constexpr size_t S1_CUM = S1_LF + (size_t)T * 8 * 4;
constexpr size_t S1_DG = S1_CUM + (size_t)T * 8 * 4;
constexpr size_t S1_HID = S1_DG + (size_t)T * 24 * 4;
constexpr size_t S1_KCMP = S1_HID + (size_t)2 * 2048 * 256 * 2;
constexpr size_t S1_VCMPT = S1_KCMP + (size_t)8 * 256 * 128 * 2;
constexpr size_t S1_SEL = S1_VCMPT + (size_t)8 * 128 * 256 * 2;
constexpr size_t S1_O = al256(S1_SEL + (size_t)8 * S * 8);
constexpr size_t S1_END = S1_O + (size_t)T * 2048 * 2;
constexpr size_t cmax3(size_t a, size_t b, size_t c) { return a > b ? (a > c ? a : c) : (b > c ? b : c); }
constexpr size_t WS_END = cmax3(S0_END, SM_END, S1_END);

constexpr int CW_BAR = 0;
constexpr int CW_CNT = 4096;
constexpr int CW_QUEUE = 4224;
constexpr int CW_DBG = 8192;

constexpr int LDS_STAGE = 0;
constexpr int LDS_IMP = 131072;
constexpr int LDS_SEL = LDS_IMP + 16384;
constexpr int LDS_MISC = LDS_SEL + 512;
constexpr int LDS_RS = LDS_MISC + 1024;
constexpr int LDS_ORD = LDS_RS + 1024;
constexpr int LDS_BYTES = LDS_ORD + 1024;
constexpr int MW_BAR = 0;
constexpr int MW_ITEM = 8;
constexpr int MW_TAB = 16;
constexpr int MW_CNT = 64;
constexpr int MW_NORD = 96;

struct Params { const float* in[32]; float* out; unsigned char* ws; int ph_lo, ph_hi; };

enum { I_X = 0, I_P, I_POS, I_ABWIN, I_SINKS, I_QLN, I_KVLN, I_WUQ, I_WUKV, I_ABWO, I_CDWIN, I_FB, I_PEK, I_W1K, I_W2K, I_PEV, I_W1V, I_W2V, I_CDWO,
       I_MIXN, I_MOEN, I_RGW, I_RGB, I_REW, I_REB, I_EWG, I_EWU, I_EWD, I_PLEP, I_PLEN, I_PLEG, I_FINN };

__device__ __forceinline__ unsigned cvt_pk(float lo, float hi) { unsigned r; asm volatile("v_cvt_pk_bf16_f32 %0, %1, %2" : "=v"(r) : "v"(lo), "v"(hi)); return r; }
__device__ __forceinline__ u32x4 pack8(const float (&v)[8]) { u32x4 w; w.x = cvt_pk(v[0], v[1]); w.y = cvt_pk(v[2], v[3]); w.z = cvt_pk(v[4], v[5]); w.w = cvt_pk(v[6], v[7]); return w; }
__device__ __forceinline__ u32x2 pack8_f8(const float (&v)[8]) {
    int a = __builtin_amdgcn_cvt_pk_fp8_f32(v[0], v[1], __float_as_int(v[0]), false); a = __builtin_amdgcn_cvt_pk_fp8_f32(v[2], v[3], a, true);
    int b = __builtin_amdgcn_cvt_pk_fp8_f32(v[4], v[5], __float_as_int(v[4]), false); b = __builtin_amdgcn_cvt_pk_fp8_f32(v[6], v[7], b, true); u32x2 w; w.x = (unsigned)a; w.y = (unsigned)b; return w; }
__device__ __forceinline__ float bf2f(unsigned short b) { return __uint_as_float(((unsigned)b) << 16); }
__device__ __forceinline__ bf16_t f2bf(float f) { return (bf16_t)(cvt_pk(f, 0.f) & 0xffffu); }
__device__ __forceinline__ void unpack8(const u32x4 w, float (&v)[8]) {
    v[0] = __uint_as_float(w.x << 16); v[1] = __uint_as_float(w.x & 0xffff0000u); v[2] = __uint_as_float(w.y << 16); v[3] = __uint_as_float(w.y & 0xffff0000u);
    v[4] = __uint_as_float(w.z << 16); v[5] = __uint_as_float(w.z & 0xffff0000u); v[6] = __uint_as_float(w.w << 16); v[7] = __uint_as_float(w.w & 0xffff0000u); }
__device__ __forceinline__ float fast_exp2(float x) { return __builtin_amdgcn_exp2f(x); }
__device__ __forceinline__ float fast_rcp(float x) { return __builtin_amdgcn_rcpf(x); }
__device__ __forceinline__ float sigmoidf_(float x) { return fast_rcp(1.0f + fast_exp2(-x * LOG2E)); }
__device__ __forceinline__ int perm32(int rho) { const int n = rho >> 4, i = rho & 15; return 8 * (i >> 2) + 4 * n + (i & 3); }
__device__ __forceinline__ int kperm16(int x) { return (x & 3) | ((x & 4) << 1) | ((x & 8) >> 1); }
__device__ __forceinline__ int vpos(int s) { return (s & ~15) | kperm16(s & 15); }

struct Frame {
    LAS unsigned char* lds; volatile LAS unsigned* misc; unsigned* ctl; unsigned char* ws;
    int tid, lane, wave, G, bx, vcu;
};
#define XB_TMO      128
#define XB_XCNT(j)  (256  + 64 * (j))
#define XB_XSUB(j)  (1280 + 64 * (j))
#define XB_XGEN(j)  (2304 + 64 * (j))
#define XB_TOP      3328
#define XB_TOPGEN   3392
#define XCD_BAR_WORDS 3456
#define XB_SPIN_CAP (1u << 18)

__device__ __forceinline__ unsigned xb_ld(unsigned* p)              { return __hip_atomic_load(p, __ATOMIC_RELAXED, __HIP_MEMORY_SCOPE_AGENT); }
__device__ __forceinline__ unsigned xb_add(unsigned* p, unsigned v) { return __hip_atomic_fetch_add(p, v, __ATOMIC_RELAXED, __HIP_MEMORY_SCOPE_AGENT); }
__device__ __forceinline__ unsigned xb_xcc_id() { return (unsigned)__builtin_amdgcn_s_getreg((3 << 11) | 20) & 0xFu; }
#define XB_SPIN(cond, bar) do { unsigned _sp = 0; while (cond) { __builtin_amdgcn_s_sleep(1); \
    if ((++_sp & 255u) == 0u) { if (xb_ld(&(bar)[XB_TMO])) break; if (_sp > XB_SPIN_CAP) { atomicAdd(&(bar)[XB_TMO], 1u); break; } } } } while (0)

struct XcdBarrier {
    unsigned* bar; unsigned x;
    volatile LAS unsigned* st;
};

__device__ __forceinline__ XcdBarrier xcd_barrier_post(unsigned* bar, volatile LAS unsigned* st) {
    XcdBarrier b; b.bar = bar; b.x = xb_xcc_id(); b.st = st;
    if (threadIdx.x == 0) (void)xb_add(&bar[XB_XCNT(b.x)], 1u);
    return b;
}
__device__ __forceinline__ void xcd_barrier_complete(unsigned* bar, unsigned x, unsigned& nloc, unsigned& nx) {
    const unsigned G = gridDim.x * gridDim.y * gridDim.z;
    unsigned sum, cnt, mine, sp = 0u;
    for (;;) {
        sum = 0u; cnt = 0u; mine = 0u;
#pragma unroll
        for (unsigned j = 0; j < 16; ++j) { const unsigned c = xb_ld(&bar[XB_XCNT(j)]); sum += c; cnt += (c > 0u) ? 1u : 0u; mine = (j == x) ? c : mine; }
        if (sum == G) break;
        __builtin_amdgcn_s_sleep(1);
        if ((++sp & 255u) == 0u) { if (xb_ld(&bar[XB_TMO])) break; if (sp > XB_SPIN_CAP) { atomicAdd(&bar[XB_TMO], 1u); break; } }
    }
    nloc = mine > 0u ? mine : 1u; nx = cnt > 0u ? cnt : 1u;
}

__device__ __forceinline__ void xcd_barrier(const XcdBarrier& b) {
    asm volatile("s_waitcnt vmcnt(0)" ::: "memory");
    __syncthreads();
    if (threadIdx.x == 0) {
        unsigned* bar = b.bar;
        __builtin_amdgcn_s_waitcnt(0);
        unsigned nloc = b.st[0], nx = b.st[1];
        if (nloc == 0u) { xcd_barrier_complete(bar, b.x, nloc, nx); b.st[0] = nloc; b.st[1] = nx; }
        const unsigned old = xb_add(&bar[XB_XSUB(b.x)], 1u);
        const unsigned gen = old / nloc;
        if (old + 1u == (gen + 1u) * nloc) {
            __builtin_amdgcn_fence(__ATOMIC_RELEASE, "agent");
            asm volatile("s_waitcnt vmcnt(0)" ::: "memory");
            const unsigned og = xb_add(&bar[XB_TOP], 1u);
            const unsigned tg = og / nx;
            if (og + 1u == (tg + 1u) * nx) xb_add(&bar[XB_TOPGEN], 1u);
            else XB_SPIN(xb_ld(&bar[XB_TOPGEN]) == tg, bar);
            __builtin_amdgcn_fence(__ATOMIC_ACQUIRE, "agent");
            xb_add(&bar[XB_XGEN(b.x)], 1u);
            asm volatile("s_waitcnt vmcnt(0)" ::: "memory");
        } else {
            XB_SPIN(xb_ld(&bar[XB_XGEN(b.x)]) == gen, bar);
            __builtin_amdgcn_fence(__ATOMIC_ACQUIRE, "agent");
            asm volatile("s_waitcnt vmcnt(0)" ::: "memory");
        }
    }
    __syncthreads();
}

enum { CK_PLAIN = 0, CK_IN0, CK_UQ, CK_UKV, CK_IN1, CK_CMP2K, CK_GU, CK_PLAIN128 };
struct ConvJob { const float* src; const float* src2; const float* gain; bf16_t* dst; int K, ldn, nrows, kind; float f8; };

__device__ __forceinline__ int rope_pair_col(int q, int base, int pl) { const int bj = q >> 7, qq = q & 127; return base + (2 * pl + (qq >> 6)) * 128 + (qq & 63) + 64 * bj; }
__device__ __forceinline__ int colmap(int kind, int n) {
    const int pn = n >> 8, q = n & 255;
    switch (kind) {
    case CK_PLAIN: return n;
    case CK_PLAIN128: return n < 128 ? n : -1;
    case CK_IN0:
        if (pn < 4) return rope_pair_col(q, 0, pn);
        if (pn == 4) return rope_pair_col(q, 1024, 0);
        if (pn == 5) return 1280 + q;
        if (pn < 8) return 1536 + (pn - 6) * 256 + q;
        if (pn == 8) return 2048 + q;
        { const int bj = q >> 7, qq = q & 127; return qq < 32 ? 2304 + qq + 32 * bj : -1; }
    case CK_UQ:
        if (n < 1024) return (n >> 7) * 192 + (n & 127);
        { const int n2 = n - 1024, r = n2 >> 8, q2 = n2 & 255, bj = q2 >> 7, qq = q2 & 127; return (4 * r + (qq >> 5)) * 192 + 128 + (qq & 31) + 32 * bj; }
    case CK_UKV:
        if (n < 1024) return (n >> 7) * 256 + (n & 127);
        { const int n2 = n - 1024; return (n2 >> 7) * 256 + 128 + (n2 & 127); }
    case CK_IN1:
        if (pn < 12) return n;
        if (pn < 16) return rope_pair_col(q, 3080, pn - 12);
        if (pn == 16) return 4104 + q;
        if (pn == 17) return 4360 + q;
        if (pn == 18) return rope_pair_col(q, 4616, 0);
        if (pn == 19) return 4872 + q;
        if (pn == 20) return rope_pair_col(q, 5128, 0);
        if (pn == 21) return 5384 + q;
        return q < 8 ? 3072 + q : (q < 32 ? 5640 + q - 8 : -1);
    case CK_CMP2K: { const int bj = q >> 7, qq = q & 127; return (n < 256 && qq < 64) ? qq + 64 * bj : -1; }
    case CK_GU: return q < 128 ? 128 * pn + q : ((128 * pn + q - 128) | (1 << 20));
    }
    return -1;
}

constexpr float F8_WGU = 64.f, F8_WDN = 32.f, F8_WPG = 64.f, F8_WIN1 = 64.f;
constexpr unsigned F8_SC_GU = 127 - 6, F8_SC_DN = 127 - 5, F8_SC_PG = 127 - 6, F8_SC_IN1 = 127 - 6, F8_SC_WO = 127 - 6 - 4;
constexpr int NFIXJOB = 14, NFIXTILE = 2360, NGUTILE = 128, NDNTILE = 64, NCONVTILE = NFIXTILE + 64 * NGUTILE + 64 * NDNTILE;
__device__ __forceinline__ void get_job(const Params& P, int tile, ConvJob& J, int& lt) {
    unsigned char* ws = P.ws;
    J.src2 = nullptr; J.gain = nullptr; J.f8 = 0.f;
    if (tile >= NFIXTILE) {
        int t2 = tile - NFIXTILE;
        if (t2 < 64 * NGUTILE) { const int le = t2 / NGUTILE; lt = t2 % NGUTILE; const int l = le >> 5;
            J.src = P.in[I_EWG] + (size_t)le * 2048 * 512; J.src2 = P.in[I_EWU] + (size_t)le * 2048 * 512; J.gain = P.in[I_MOEN] + l * 2048;
            J.dst = l ? (bf16_t*)(ws + WS_WGU1 + (size_t)(le - 32) * 1024 * 2048) : (bf16_t*)(ws + WS_WGU) + (size_t)le * 1024 * 2048; J.K = 2048; J.ldn = 512; J.nrows = 1024; J.kind = CK_GU; J.f8 = (l ? F8_MOE1 : F8_MOE0) ? F8_WGU : 0.f; return; }
        t2 -= 64 * NGUTILE; { const int le = t2 / NDNTILE; lt = t2 % NDNTILE;
            J.src = P.in[I_EWD] + (size_t)le * 512 * 2048; J.dst = (bf16_t*)(ws + WS_WDN) + (size_t)le * 2048 * 512; J.K = 512; J.ldn = 2048; J.nrows = 2048; J.kind = CK_PLAIN; J.f8 = ((le >> 5) ? F8_MOE1 : F8_MOE0) ? F8_WDN : 0.f; return; }
    }
    const int ft[NFIXJOB] = {320, 48, 32, 256, 736, 64, 64, 4, 4, 256, 32, 32, 256, 256};
    int j = 0, base = 0; bool found = false;
#pragma unroll
    for (int i = 0; i < NFIXJOB; ++i) { if (!found) { if (tile < base + ft[i]) { found = true; j = i; } else base += ft[i]; } }
    lt = tile - base;
    switch (j) {
    case 0: J.src = P.in[I_ABWIN]; J.gain = P.in[I_MIXN]; J.dst = (bf16_t*)(ws + WS_WIN0T); J.K = 2048; J.ldn = EVEN_IN; J.nrows = NIN0; J.kind = CK_IN0; J.f8 = F8_IN0 ? F8_WIN1 : 0.f; break;
    case 1: J.src = P.in[I_WUQ]; J.gain = P.in[I_QLN]; J.dst = (bf16_t*)(ws + WS_WUQT); J.K = 512; J.ldn = 1536; J.nrows = 1536; J.kind = CK_UQ; break;
    case 2: J.src = P.in[I_WUKV]; J.gain = P.in[I_KVLN]; J.dst = (bf16_t*)(ws + WS_WUKVT); J.K = 256; J.ldn = 2048; J.nrows = 2048; J.kind = CK_UKV; break;
    case 3: J.src = P.in[I_ABWO]; J.dst = (bf16_t*)(ws + WS_WO0T); J.K = 2048; J.ldn = 2048; J.nrows = 2048; J.kind = CK_PLAIN; J.f8 = F8_WO0 ? F8_WIN1 : 0.f; break;
    case 4: J.src = P.in[I_CDWIN]; J.gain = P.in[I_MIXN] + 2048; J.dst = (bf16_t*)(ws + WS_WIN1T); J.K = 2048; J.ldn = ODD_IN; J.nrows = NIN1; J.kind = CK_IN1; J.f8 = F8_IN1 ? F8_WIN1 : 0.f; break;
    case 5: J.src = P.in[I_W1K]; J.dst = (bf16_t*)(ws + WS_WC1KT); J.K = 4096; J.ldn = 256; J.nrows = 256; J.kind = CK_PLAIN; J.f8 = F8_CMP ? F8_WIN1 : 0.f; break;
    case 6: J.src = P.in[I_W1V]; J.dst = (bf16_t*)(ws + WS_WC1VT); J.K = 4096; J.ldn = 256; J.nrows = 256; J.kind = CK_PLAIN; J.f8 = F8_CMP ? F8_WIN1 : 0.f; break;
    case 7: J.src = P.in[I_W2K]; J.dst = (bf16_t*)(ws + WS_WC2KT); J.K = 256; J.ldn = 128; J.nrows = 256; J.kind = CK_CMP2K; break;
    case 8: J.src = P.in[I_W2V]; J.dst = (bf16_t*)(ws + WS_WC2VT); J.K = 256; J.ldn = 128; J.nrows = 256; J.kind = CK_PLAIN128; break;
    case 9: J.src = P.in[I_CDWO]; J.dst = (bf16_t*)(ws + WS_WO1T); J.K = 2048; J.ldn = 2048; J.nrows = 2048; J.kind = CK_PLAIN; J.f8 = F8_WO1 ? F8_WIN1 : 0.f; break;
    case 10: case 11: J.src = P.in[I_PLEP] + (size_t)(j - 10) * 256 * 2048; J.dst = (bf16_t*)(ws + WS_WPPT) + (size_t)(j - 10) * 2048 * 256; J.K = 256; J.ldn = 2048; J.nrows = 2048; J.kind = CK_PLAIN; break;
    default: J.src = P.in[I_PLEG] + (size_t)(j - 12) * 2048 * 2048; J.gain = P.in[I_PLEN] + (j - 12) * 2048; J.dst = (bf16_t*)(ws + WS_WPGT) + (size_t)(j - 12) * 2048 * 2048; J.K = 2048; J.ldn = 2048; J.nrows = 2048; J.kind = CK_PLAIN; J.f8 = ((j == 13) ? F8_PLE1 : F8_PLE0) ? F8_WPG : 0.f; break;
    }
}

struct ConvRegs { f32x4 v[8]; f32x4 g0, g1; };
__device__ __forceinline__ void conv_load(const ConvJob& J, int lt, int tid, ConvRegs& R) {
    const int kt = J.K >> 8, tn = lt / kt, tk = lt % kt;
    const int n0 = tn * 64, k0 = tk * 256;
    const int g = tid & 15, kc = tid >> 4;
    const int r = n0 + 4 * g;
    const int nat = (r & ~31) + perm32(r & 31);
    int col = colmap(J.kind, nat);
    const float* src = J.src;
    if (col >= 0 && (col & (1 << 20))) { src = J.src2; col &= ~(1 << 20); }
    const int kb = k0 + 8 * kc;
#pragma unroll
    for (int e = 0; e < 8; ++e) R.v[e] = (col >= 0) ? __builtin_nontemporal_load((const f32x4*)(src + (size_t)(kb + e) * J.ldn + col)) : (f32x4){0.f, 0.f, 0.f, 0.f};
    if (J.gain) { R.g0 = *(const f32x4*)(J.gain + kb); R.g1 = *(const f32x4*)(J.gain + kb + 4); } else { R.g0 = (f32x4){1.f, 1.f, 1.f, 1.f}; R.g1 = R.g0; }
}
__device__ __forceinline__ void conv_store(const ConvJob& J, int lt, int tid, const ConvRegs& R) {
    const int kt = J.K >> 8, tn = lt / kt, tk = lt % kt;
    const int n0 = tn * 64, k0 = tk * 256;
    const int g = tid & 15, kc = tid >> 4;
    const int r = n0 + 4 * g, kb = k0 + 8 * kc;
    if (J.f8 != 0.f) {
#pragma unroll
        for (int i = 0; i < 4; i += 2) {
            float o0[8], o1[8];
#pragma unroll
            for (int e = 0; e < 4; ++e) { o0[e] = R.v[e][i] * R.g0[e] * J.f8; o0[e + 4] = R.v[e + 4][i] * R.g1[e] * J.f8; o1[e] = R.v[e][i + 1] * R.g0[e] * J.f8; o1[e + 4] = R.v[e + 4][i + 1] * R.g1[e] * J.f8; }
            const u32x2 pa = pack8_f8(o0), pb = pack8_f8(o1);
            const auto rx = __builtin_amdgcn_permlane16_swap(pa.x, pb.x, false, false); const auto ry = __builtin_amdgcn_permlane16_swap(pa.y, pb.y, false, false);
            unsigned char* d0 = (unsigned char*)J.dst + (size_t)(r + i) * J.K + kb;
            *(u32x4*)((kc & 1) ? d0 + J.K - 8 : d0) = (u32x4){rx[0], ry[0], rx[1], ry[1]};
        }
        return;
    }
#pragma unroll
    for (int i = 0; i < 4; ++i) {
        float o[8];
#pragma unroll
        for (int e = 0; e < 4; ++e) { o[e] = R.v[e][i] * R.g0[e]; o[e + 4] = R.v[e + 4][i] * R.g1[e]; }
        *(u32x4*)(J.dst + (size_t)(r + i) * J.K + kb) = pack8(o);
    }
}

__device__ __forceinline__ void sincos_rev(float ang, float& c, float& s) {
    const double rev = (double)ang * 0.15915494309189535;
    const float fr = (float)(rev - __builtin_rint(rev));
    c = __builtin_amdgcn_cosf(fr); s = __builtin_amdgcn_sinf(fr);
}

constexpr int NCONV_FG = NFIXTILE, NCHUNK_L = (32 * NGUTILE + 32 * NDNTILE) / 4;
__device__ __forceinline__ int conv_tile_id(int i, int layer) {
    if (layer < 0) return i;
    return i < 32 * NGUTILE ? NFIXTILE + layer * 32 * NGUTILE + i : NFIXTILE + 64 * NGUTILE + layer * 32 * NDNTILE + (i - 32 * NGUTILE);
}
__device__ __forceinline__ void conv_range(const Params& P, int tid, int first, int stride, int n, int layer) {
    for (int i = first; i < n; i += 2 * stride) {
        ConvJob J0, J1; int lt0, lt1 = 0; ConvRegs R0, R1; const bool two = i + stride < n;
        get_job(P, conv_tile_id(i, layer), J0, lt0); conv_load(J0, lt0, tid, R0);
        if (two) { get_job(P, conv_tile_id(i + stride, layer), J1, lt1); conv_load(J1, lt1, tid, R1); }
        conv_store(J0, lt0, tid, R0);
        if (two) conv_store(J1, lt1, tid, R1);
    }
}
__device__ __forceinline__ void p0_prologue(const Params& P, const Frame& F) {
    unsigned char* ws = P.ws;
    const int tid = F.tid, G = F.G;
    conv_range(P, tid, F.bx, G, 320, -1);
    {
        const float* x = P.in[I_X]; bf16_t* hb = (bf16_t*)(ws + WS_HBA); float* rstd0 = (float*)(ws + WS_RSTD0);
        const int step = G * 8;
        for (int t0 = F.bx * 8 + F.wave; t0 < T; t0 += 2 * step) {
            const int t1 = t0 + step; const bool two = t1 < T; const int tb = two ? t1 : t0;
            f32x4 va[8], vb[8];
#pragma unroll
            for (int j = 0; j < 8; ++j) { const int c = 4 * (F.lane + 64 * j); va[j] = *(const f32x4*)(x + (size_t)t0 * D + c); vb[j] = *(const f32x4*)(x + (size_t)tb * D + c); }
            float ssa = 0.f, ssb = 0.f;
#pragma unroll
            for (int j = 0; j < 8; ++j) { const int c = 4 * (F.lane + 64 * j);
                { const f32x4 v = va[j]; ssa += v[0] * v[0] + v[1] * v[1] + v[2] * v[2] + v[3] * v[3];
                  if (!F8_IN0) { u32x2 w; w.x = cvt_pk(v[0], v[1]); w.y = cvt_pk(v[2], v[3]); *(u32x2*)(hb + (size_t)t0 * D + c) = w; }
                  if (F8_IN0) { int q = __float_as_int(v[0]); q = __builtin_amdgcn_cvt_pk_fp8_f32(v[0], v[1], q, false); q = __builtin_amdgcn_cvt_pk_fp8_f32(v[2], v[3], q, true); *(int*)(ws + WS_H8A + (size_t)t0 * D + c) = q; } }
                if (two) { const f32x4 v = vb[j]; ssb += v[0] * v[0] + v[1] * v[1] + v[2] * v[2] + v[3] * v[3];
                  if (!F8_IN0) { u32x2 w; w.x = cvt_pk(v[0], v[1]); w.y = cvt_pk(v[2], v[3]); *(u32x2*)(hb + (size_t)t1 * D + c) = w; }
                  if (F8_IN0) { int q = __float_as_int(v[0]); q = __builtin_amdgcn_cvt_pk_fp8_f32(v[0], v[1], q, false); q = __builtin_amdgcn_cvt_pk_fp8_f32(v[2], v[3], q, true); *(int*)(ws + WS_H8A + (size_t)t1 * D + c) = q; } } }
#pragma unroll
            for (int o = 32; o > 0; o >>= 1) { ssa += __shfl_xor(ssa, o); ssb += __shfl_xor(ssb, o); }
            if (F.lane == 0) { rstd0[t0] = __builtin_amdgcn_rsqf(ssa * (1.0f / D) + EPS); if (two) rstd0[t1] = __builtin_amdgcn_rsqf(ssb * (1.0f / D) + EPS); }
        }
    }
    const int gtid = F.bx * NTHR + tid, gn = G * NTHR;
    { const int* pos = (const int*)P.in[I_POS]; float* c128 = (float*)(ws + WS_COS128); float* s128 = (float*)(ws + WS_SIN128); float* c64 = (float*)(ws + WS_COS64); float* s64 = (float*)(ws + WS_SIN64);
      for (int i = gtid; i < T * 96; i += gn) {
          const int t = i / 96, r = i % 96; const float pf = (float)pos[t];
          if (r < 64) { const float inv = 1.0f / fast_exp2((float)(2 * r) * (1.0f / 128.0f) * 13.287712379549449f); float c, s; sincos_rev(pf * inv, c, s); c128[t * 64 + r] = c; s128[t * 64 + r] = s; }
          else { const int q = r - 64; const float inv = 1.0f / fast_exp2((float)(2 * q) * (1.0f / 64.0f) * 13.287712379549449f); float c, s; sincos_rev(pf * inv, c, s); c64[t * 32 + q] = c; s64[t * 32 + q] = s; }
      } }
}
__device__ __forceinline__ void p0_rest(const Params& P, const Frame& F, int w, int nw) {
    unsigned char* ws = P.ws; const int tid = F.tid;
    const int gtid = w * NTHR + tid, gn = nw * NTHR;
    { const float* p = P.in[I_P]; bf16_t* pb = (bf16_t*)(ws + WS_PB);
      for (int i = gtid; i < 2 * T * 256 / 4; i += gn) { const f32x4 v = *(const f32x4*)(p + (size_t)i * 4); u32x2 w; w.x = cvt_pk(v[0], v[1]); w.y = cvt_pk(v[2], v[3]); *(u32x2*)(pb + (size_t)i * 4) = w; } }
    { bf16_t* wh = (bf16_t*)(ws + WS_WRT); bf16_t* wl = wh + 2 * 48 * 2048;
      for (int i = gtid; i < 2 * 48 * 2048; i += gn) { const int l = i / (48 * 2048), c = (i / 2048) % 48, k = i % 2048; const float g = P.in[I_MOEN][l * 2048 + k];
          float w = 0.f; if (c < 4) w = P.in[I_RGW][((size_t)l * 2048 + k) * 4 + c]; else if (c < 36) w = P.in[I_REW][((size_t)l * 2048 + k) * 32 + (c - 4)];
          w *= g; const bf16_t h = f2bf(w); wh[i] = h; wl[i] = f2bf(w - bf2f(h)); } }
    { float* part = (float*)(ws + WS_SSQP);
      for (int i = gtid; i < 64 * 512; i += gn) { const int kp = i >> 9, z = (i >> 8) & 1, n = i & 255; const float* pe = P.in[z ? I_PEV : I_PEK]; const float* w1 = P.in[z ? I_W1V : I_W1K];
          float a = 0.f;
#pragma unroll 16
          for (int k = kp * 64; k < kp * 64 + 64; ++k) a += pe[k] * w1[(size_t)k * 256 + n];
          part[i] = a; } }
    { u32x4* z0 = (u32x4*)(ws + WS_HBA + (size_t)T * D * 2); u32x4* z1 = (u32x4*)(ws + WS_HBB + (size_t)T * D * 2);
      for (int i = gtid; i < 256 * D * 2 / 16; i += gn) { z0[i] = (u32x4){0u, 0u, 0u, 0u}; z1[i] = (u32x4){0u, 0u, 0u, 0u}; }
      u32x4* z8a = (u32x4*)(ws + WS_H8A + (size_t)T * D); u32x4* z8b = (u32x4*)(ws + WS_H8B + (size_t)T * D);
      for (int i = gtid; i < 256 * D / 16; i += gn) { z8a[i] = (u32x4){0u, 0u, 0u, 0u}; z8b[i] = (u32x4){0u, 0u, 0u, 0u}; }
      float* rm = (float*)(ws + WS_RSTDM); if (gtid < 64) rm[T + gtid] = 0.f; }
}
namespace pg8 {
constexpr int BM = 256, BK = 64, HALF = 128, HTB = HALF * BK * 2, STAGE_BYTES = 8 * HTB, NXCD = 8, WGM = 8;
__device__ __forceinline__ int lds_byte(int r, int c) { const int st = (r >> 4) * 2 + (c >> 5), rr = r & 15, cc = c & 31, ob = rr * 64 + cc * 2; return st * 1024 + (ob ^ (((ob >> 9) & 1) << 5)); }
__device__ __forceinline__ void stage_rc(int b, int& R, int& C) { const int st = b / 1024, sb = b % 1024, swz = sb ^ (((sb >> 9) & 1) << 5); R = (st >> 1) * 16 + swz / 64; C = (st & 1) * 32 + (swz % 64) / 2; }

struct Unit { int pm, pn, e, r0, half, ro; };

struct PlainOrder {
    static constexpr bool DYN_A = false, HALF = false;
    const bf16_t* A; const bf16_t* Bt; int lda, K; int nM, nN, nwg, G, c, lo, cnt;
    __device__ __forceinline__ void init(const bf16_t* A_, int lda_, const bf16_t* Bt_, int K_, int M, int N, int G_, int c_) { A = A_; Bt = Bt_; lda = lda_; K = K_; nM = M / BM; nN = N / BM; nwg = nM * nN; G = G_; c = c_; lo = 0; cnt = nwg; }
    __device__ __forceinline__ void sub(int lo_, int cnt_, int G_, int c_) { lo = lo_; cnt = cnt_; G = G_; c = c_ < 0 ? cnt_ : c_; }
    __device__ __forceinline__ bool next(int i, Unit& u) const {
        const long L = (long)i * G + c; if (L >= cnt) return false;
        int wgid = lo + (int)L; { const int q = nwg / NXCD, r = nwg % NXCD, xcd = wgid % NXCD, off = wgid / NXCD; wgid = (xcd < r ? xcd * (q + 1) : r * (q + 1) + (xcd - r) * q) + off; }
        const int nig = WGM * nN, gid = wgid / nig, fm = gid * WGM, gsz = (nM - fm) < WGM ? (nM - fm) : WGM;
        u.pm = fm + ((wgid % nig) % gsz); u.pn = (wgid % nig) / gsz; u.e = 0; u.r0 = 0; u.half = 0; u.ro = 0; return true;
    }
    __device__ __forceinline__ const char* a_base(const Unit& u) const { return (const char*)(A + (size_t)u.pm * BM * lda); }
    __device__ __forceinline__ const char* b_base(const Unit& u) const { return (const char*)(Bt + (size_t)u.pn * BM * K); }
    __device__ __forceinline__ unsigned a_row_off(const Unit&, int r) const { return (unsigned)r * (unsigned)lda * 2u; }
};

struct HalfOrder {
    static constexpr bool DYN_A = false, HALF = true;
    const bf16_t* A; const bf16_t* Bt; int lda, nU, G, c;
    __device__ __forceinline__ bool next(int i, Unit& u) const { const long L = (long)i * G + c; if (L >= nU) return false; u.pm = (int)L; u.pn = 0; u.e = 0; u.r0 = (int)L * 128; u.half = 1; u.ro = 0; return true; }
    __device__ __forceinline__ const char* a_base(const Unit& u) const { return (const char*)(A + (size_t)u.pm * 128 * lda); }
    __device__ __forceinline__ const char* b_base(const Unit&) const { return (const char*)Bt; }
    __device__ __forceinline__ unsigned a_row_off(const Unit&, int r) const { return (unsigned)r * (unsigned)lda * 2u; }
};

template <bool GATHER, int NPN> struct MoeOrder {
    static constexpr bool DYN_A = GATHER, HALF = true;
    const bf16_t* A; const bf16_t* Bt; int lda, K; size_t bstride;
    const int* list; volatile LAS unsigned* tab; volatile LAS unsigned* cnt; volatile LAS unsigned* ord; int G, c, U;
    __device__ __forceinline__ bool next(int i, Unit& u) const {
        const int L = i * G + c; if (L >= U) return false;
        u.pn = L % NPN; const int w = __builtin_amdgcn_readfirstlane((int)ord[L / NPN]);
        const int rt = w & 255, e = (w >> 8) & 31, kind = w >> 16; u.half = kind != 0; u.ro = kind == 2 ? 128 : 0;
        u.e = e; u.pm = rt; u.r0 = __builtin_amdgcn_readfirstlane((rt - (int)tab[e]) * BM) + u.ro; return true;
    }
    __device__ __forceinline__ const char* a_base(const Unit& u) const { return GATHER ? (const char*)A : (const char*)(A + ((size_t)u.pm * BM + u.ro) * lda); }
    __device__ __forceinline__ const char* b_base(const Unit& u) const { return (const char*)(Bt + (size_t)u.e * bstride + (size_t)u.pn * BM * K); }
    __device__ __forceinline__ unsigned a_row_off(const Unit& u, int r) const {
        if (GATHER) { const int gr = u.r0 + r; const int tok = (gr < __builtin_amdgcn_readfirstlane((int)cnt[u.e])) ? list[(size_t)u.e * T + gr] : T; return (unsigned)tok * (unsigned)lda * 2u; }
        return (unsigned)r * (unsigned)lda * 2u;
    }
};

template <bool F8, class Epi, class Sched>
__device__ __forceinline__ void gemm_phase_t(LAS unsigned char* lds, const int K, const Sched& S, const Epi& E, const unsigned f8scale) {
    const int tid = threadIdx.x, wid = __builtin_amdgcn_readfirstlane(tid >> 6), lane = tid & 63, wr = wid >> 2, wc = wid & 3, fr = lane & 15, fq = lane >> 4;
    const int nt = K / BK;
    unsigned voffB[2];
#pragma unroll
    for (int i = 0; i < 2; ++i) { int R, C; stage_rc(tid * 16 + i * 8192, R, C); voffB[i] = (unsigned)(R * K + C) * 2u; }
    const size_t kstep = (size_t)(BK * 2);
    const size_t hstepB = (size_t)HALF * K * 2;
    const unsigned ldsw = (unsigned)wid * 1024u;
    const int aoff = lds_byte(wr * 64 + fr, fq * 8), boff = lds_byte(wc * 32 + fr, fq * 8);
#define PG8_SA(b, h) (((b) * 2 + (h)) * HTB)
#define PG8_SB(b, h) ((4 + (b) * 2 + (h)) * HTB)
#define PG8_STAGE(bufoff, gbase, voff) do { _Pragma("unroll") for (int _i = 0; _i < 2; ++_i) \
        __builtin_amdgcn_global_load_lds((const unsigned*)((const char*)(gbase) + (voff)[_i]), (LAS unsigned*)(lds + (bufoff) + ldsw + _i * 8192), 16, 0, 0); } while (0)
#define PG8_LD8(p) __builtin_shufflevector(*(const LAS i32x4*)(p), *(const LAS i32x4*)((p) + 1024), 0, 1, 2, 3, 4, 5, 6, 7)
#define PG8_LDA(dst, b, h) do { if (F8) { _Pragma("unroll") for (int m = 0; m < 4; ++m) dst##8[m] = PG8_LD8(lds + PG8_SA(b, h) + aoff + m * 2048); } else { \
        _Pragma("unroll") for (int m = 0; m < 4; ++m) _Pragma("unroll") for (int k = 0; k < 2; ++k) dst[m][k] = *(const LAS bf16x8*)(lds + PG8_SA(b, h) + aoff + m * 2048 + k * 1024); } } while (0)
#define PG8_LDB(dst, b, h) do { if (F8) { _Pragma("unroll") for (int n = 0; n < 2; ++n) dst##8[n] = PG8_LD8(lds + PG8_SB(b, h) + boff + n * 2048); } else { \
        _Pragma("unroll") for (int n = 0; n < 2; ++n) _Pragma("unroll") for (int k = 0; k < 2; ++k) dst[n][k] = *(const LAS bf16x8*)(lds + PG8_SB(b, h) + boff + n * 2048 + k * 1024); } } while (0)
#define PG8_MMA(ai, bj, At, Bt) do { __builtin_amdgcn_s_setprio(1); if (F8) { _Pragma("unroll") for (int m = 0; m < 4; ++m) _Pragma("unroll") for (int n = 0; n < 2; ++n) \
        acc[ai][bj][m][n] = __builtin_amdgcn_mfma_scale_f32_16x16x128_f8f6f4(Bt##8[n], At##8[m], acc[ai][bj][m][n], 0, 0, 0, (int)f8sc, 0, 0x7f7f7f7f); \
        _Pragma("unroll") for (int m = 0; m < 4; ++m) _Pragma("unroll") for (int n = 0; n < 2; ++n) asm volatile("" : "+v"(acc[ai][bj][m][n])); } else { \
        _Pragma("unroll") for (int m = 0; m < 4; ++m) _Pragma("unroll") for (int n = 0; n < 2; ++n) _Pragma("unroll") for (int k = 0; k < 2; ++k) \
        acc[ai][bj][m][n] = __builtin_amdgcn_mfma_f32_16x16x32_bf16(Bt[n][k], At[m][k], acc[ai][bj][m][n], 0, 0, 0); } __builtin_amdgcn_s_setprio(0); } while (0)
#define PG8_WAIT_V(n) asm volatile("s_waitcnt vmcnt(" #n ")" ::: "memory")
#define PG8_WAIT_L(n) asm volatile("s_waitcnt lgkmcnt(" #n ")" ::: "memory")
#define PG8_BAR __builtin_amdgcn_s_barrier()
#define PG8_SCHED __builtin_amdgcn_sched_barrier(0)
#define PG8_AOFF(dst, u) do { int _t = tid; asm volatile("" : "+v"(_t)); _Pragma("unroll") for (int _i = 0; _i < 2; ++_i) { int _R, _C; stage_rc(_t * 16 + _i * 8192, _R, _C); _Pragma("unroll") for (int _h = 0; _h < 2; ++_h) dst[_h][_i] = S.a_row_off(u, _h * HALF + _R) + (unsigned)_C * 2u; } } while (0)
    Unit cur, nxt; int ui = 0;
    if (!S.next(0, cur)) return;
    f32x4 acc[2][2][4][2];
#pragma unroll
    for (int a = 0; a < 2; ++a)
#pragma unroll
        for (int b = 0; b < 2; ++b)
#pragma unroll
            for (int m = 0; m < 4; ++m)
#pragma unroll
                for (int n = 0; n < 2; ++n) acc[a][b][m][n] = (f32x4){0.f, 0.f, 0.f, 0.f};
    bf16x8 At[4][2], B0[2][2], B1[2][2]; i32x8 At8[4], B08[2], B18[2]; const unsigned f8sc = f8scale * 0x01010101u;
    unsigned offA[2][2];
    PG8_AOFF(offA, cur);
    const char* cA = S.a_base(cur); const char* cB = S.b_base(cur);
    PG8_STAGE(PG8_SB(0, 0), cB, voffB); PG8_STAGE(PG8_SB(0, 1), cB + hstepB, voffB); PG8_STAGE(PG8_SA(0, 0), cA, offA[0]); PG8_STAGE(PG8_SA(0, 1), cA, offA[1]);
    if (wr == 1) PG8_BAR;
    PG8_WAIT_V(2); PG8_BAR;
    PG8_STAGE(PG8_SB(1, 0), cB + kstep, voffB); PG8_STAGE(PG8_SA(1, 0), cA + kstep, offA[0]); PG8_STAGE(PG8_SB(1, 1), cB + hstepB + kstep, voffB);
    PG8_WAIT_V(6); PG8_BAR;
#pragma unroll 1
    for (;;) {
        const bool has_next = S.next(ui + 1, nxt);
        const char* nA = has_next ? S.a_base(nxt) : cA; const char* nB = has_next ? S.b_base(nxt) : cB;
        const bool hf = Sched::HALF && cur.half != 0;
#pragma unroll 1
        for (int t = 0; t < nt; t += 2) {
            const bool last = (t == nt - 2);
            const char* a1 = cA + (size_t)(t + 1) * kstep;
            const char* a2 = last ? nA : cA + (size_t)(t + 2) * kstep; const char* b2 = last ? nB : cB + (size_t)(t + 2) * kstep;
            const char* a3 = a2 + kstep; const char* b3 = b2 + kstep;
            PG8_LDB(B0, 0, 0); PG8_LDB(B1, 0, 1); PG8_SCHED; PG8_LDA(At, 0, 0); PG8_STAGE(PG8_SA(1, 1), a1, offA[1]);
            PG8_WAIT_V(8); PG8_WAIT_L(0); PG8_BAR; PG8_MMA(0, 0, At, B0); PG8_MMA(0, 1, At, B1); PG8_BAR; PG8_SCHED;
            if (Sched::DYN_A && last && has_next) PG8_AOFF(offA, nxt);
            if (!hf) PG8_LDA(At, 0, 1); PG8_STAGE(PG8_SB(0, 0), b2, voffB); PG8_STAGE(PG8_SB(0, 1), b2 + hstepB, voffB); PG8_STAGE(PG8_SA(0, 0), a2, offA[0]);
            PG8_WAIT_V(8); PG8_WAIT_L(0); PG8_BAR; if (!hf) { PG8_MMA(1, 0, At, B0); PG8_MMA(1, 1, At, B1); } PG8_BAR; PG8_SCHED;
            PG8_LDB(B0, 1, 0); PG8_LDB(B1, 1, 1); PG8_SCHED; PG8_LDA(At, 1, 0); PG8_STAGE(PG8_SA(0, 1), a2, offA[1]);
            PG8_WAIT_V(8); PG8_WAIT_L(0); PG8_BAR; PG8_MMA(0, 0, At, B0); PG8_MMA(0, 1, At, B1); PG8_BAR; PG8_SCHED;
            if (!hf) PG8_LDA(At, 1, 1); PG8_STAGE(PG8_SB(1, 0), b3, voffB); PG8_STAGE(PG8_SB(1, 1), b3 + hstepB, voffB); PG8_STAGE(PG8_SA(1, 0), a3, offA[0]);
            PG8_WAIT_V(8); PG8_WAIT_L(0); PG8_BAR; if (!hf) { PG8_MMA(1, 0, At, B0); PG8_MMA(1, 1, At, B1); } PG8_BAR; PG8_SCHED;
        }
        if (wr == 0) PG8_BAR;
        { int efr = fr, efq = fq; asm volatile("" : "+v"(efr), "+v"(efq));
          E(acc, cur, wr, wc, efr, efq); }
        if (!has_next) break;
#pragma unroll
        for (int a = 0; a < 2; ++a)
#pragma unroll
            for (int b = 0; b < 2; ++b)
#pragma unroll
                for (int m = 0; m < 4; ++m)
#pragma unroll
                    for (int n = 0; n < 2; ++n) acc[a][b][m][n] = (f32x4){0.f, 0.f, 0.f, 0.f};
        cur = nxt; cA = nA; cB = nB; ++ui;
        if (wr == 1) PG8_BAR;
    }
    PG8_WAIT_V(0);
    PG8_BAR;
#undef PG8_SA
#undef PG8_SB
#undef PG8_STAGE
#undef PG8_LDA
#undef PG8_LD8
#undef PG8_LDB
#undef PG8_MMA
#undef PG8_WAIT_V
#undef PG8_WAIT_L
#undef PG8_BAR
#undef PG8_SCHED
#undef PG8_AOFF
}
template <class Epi, class Sched>
__device__ __forceinline__ void gemm_phase(LAS unsigned char* lds, const int K, const Sched& S, const Epi& E) { gemm_phase_t<false>(lds, K, S, E, 0u); }
template <class Epi, class Sched>
__device__ __forceinline__ void gemm_phase_f8(LAS unsigned char* lds, const int K2, const Sched& S, const Epi& E, const unsigned f8scale) { gemm_phase_t<true>(lds, K2, S, E, f8scale); }
}
namespace epi {
using pg8::Unit;
typedef const f32x4 (&Acc)[2][2][4][2];
#define EPI_ROWL(ai, m) ((ai) * 128 + wr * 64 + (m) * 16 + fr)
#define EPI_ROW(u, ai, m) ((u).pm * 256 + EPI_ROWL(ai, m))
#define EPI_GET8(v, ai, bj, m, sc) do { _Pragma("unroll") for (int _e = 0; _e < 4; ++_e) { v[_e] = acc[ai][bj][m][0][_e] * (sc); v[4 + _e] = acc[ai][bj][m][1][_e] * (sc); } } while (0)

template <class RD, class FL, class FC>
__device__ __forceinline__ void epi_pipe_n(int ng, FL load, FC comp) {
    RD d[2][2];
    load(0, 0, d[0][0]); load(0, 1, d[0][1]);
#pragma unroll
    for (int g = 0; g < 4; ++g) {
        if (g < ng) {
            if (g < 3 && g + 1 < ng) { const int g2 = g + 1; load(g2 >> 1, (g2 & 1) * 2, d[g2 & 1][0]); load(g2 >> 1, (g2 & 1) * 2 + 1, d[g2 & 1][1]); }
            __builtin_amdgcn_sched_barrier(0);
            comp(g >> 1, (g & 1) * 2, d[g & 1][0]); comp(g >> 1, (g & 1) * 2 + 1, d[g & 1][1]);
            __builtin_amdgcn_sched_barrier(0);
        }
    }
}
template <class RD, class FL, class FC>
__device__ __forceinline__ void epi_pipe(FL load, FC comp) {
    RD d[2][2];
    load(0, 0, d[0][0]); load(0, 1, d[0][1]);
#pragma unroll
    for (int g = 0; g < 4; ++g) {
        if (g < 3) { const int g2 = g + 1; load(g2 >> 1, (g2 & 1) * 2, d[g2 & 1][0]); load(g2 >> 1, (g2 & 1) * 2 + 1, d[g2 & 1][1]); }
        __builtin_amdgcn_sched_barrier(0);
        comp(g >> 1, (g & 1) * 2, d[g & 1][0]); comp(g >> 1, (g & 1) * 2 + 1, d[g & 1][1]);
        __builtin_amdgcn_sched_barrier(0);
    }
}
template <class RD, class FL, class FC>
__device__ __forceinline__ void epi_pipe1(FL load, FC comp) {
    RD d[2];
    load(0, 0, d[0]);
#pragma unroll
    for (int g = 0; g < 8; ++g) {
        if (g < 7) { const int g2 = g + 1; load(g2 >> 2, g2 & 3, d[g2 & 1]); }
        __builtin_amdgcn_sched_barrier(0);
        comp(g >> 2, g & 3, d[g & 1]);
        __builtin_amdgcn_sched_barrier(0);
    }
}
__device__ __forceinline__ void store8(bf16_t* p, const float (&v)[8]) { *(u32x4*)p = pack8(v); }

struct RdS { float rs; };
struct RdRope { float rs; f32x4 c0, c1, s0, s1; };
__device__ __forceinline__ void rope8(const float (&x1)[8], const float (&x2)[8], const RdRope& d, float (&y1)[8], float (&y2)[8]) {
#pragma unroll
    for (int e = 0; e < 8; ++e) { const float c = e < 4 ? d.c0[e] : d.c1[e - 4], s = e < 4 ? d.s0[e] : d.s1[e - 4]; y1[e] = x1[e] * c - x2[e] * s; y2[e] = x2[e] * c + x1[e] * s; }
}
__device__ __forceinline__ void ld_rope(RdRope& d, const float* cs, const float* sn) { d.c0 = *(const f32x4*)cs; d.c1 = *(const f32x4*)(cs + 4); d.s0 = *(const f32x4*)sn; d.s1 = *(const f32x4*)(sn + 4); }

__device__ __forceinline__ bf16_t* kvw(bf16_t* base, size_t el) { return (bf16_t*)((unsigned char*)base + el * (KV8 ? 1 : 2)); }
__device__ __forceinline__ void store8_f8(unsigned char* p, const float (&v)[8]) { *(u32x2*)p = pack8_f8(v); }
__device__ __forceinline__ void store16_f8w(unsigned char* p0, unsigned char* p1, int fq, const float (&v0)[8], const float (&v1)[8]) {
    const u32x2 a = pack8_f8(v0), b = pack8_f8(v1);
    const auto rx = __builtin_amdgcn_permlane16_swap(a.x, b.x, false, false); const auto ry = __builtin_amdgcn_permlane16_swap(a.y, b.y, false, false);
    *(u32x4*)((fq & 1) ? p1 - 8 : p0) = (u32x4){rx[0], ry[0], rx[1], ry[1]};
}
template <bool F8 = false, class RS>
__device__ __forceinline__ void rope128_tile(Acc acc, const Unit& u, int wr, int wc, int fr, int fq, RS rsf, const float* c128, const float* s128, bf16_t* dst, int ld) {
    const int qq = 32 * wc + 8 * fq, hl = qq >> 6, i0 = qq & 63;
    epi_pipe1<RdRope>([&](int ai, int m, RdRope& d) { const int row = EPI_ROW(u, ai, m); d.rs = rsf(ai, m, row); ld_rope(d, c128 + (size_t)row * 64 + i0, s128 + (size_t)row * 64 + i0); },
                     [&](int ai, int m, const RdRope& d) { const int row = EPI_ROW(u, ai, m);
                         float x1[8], x2[8], y1[8], y2[8]; EPI_GET8(x1, ai, 0, m, d.rs); EPI_GET8(x2, ai, 1, m, d.rs); rope8(x1, x2, d, y1, y2);
                         if (F8) { unsigned char* p = (unsigned char*)dst + (size_t)row * ld + hl * 128 + i0; store16_f8w(p, p + 64, fq, y1, y2); }
                         else { bf16_t* p = dst + (size_t)row * ld + hl * 128 + i0; store8(p, y1); store8(p + 64, y2); } });
}
template <bool F8 = false, class RS>
__device__ __forceinline__ void plain_tile(Acc acc, const Unit& u, int wr, int wc, int fr, int fq, RS rsf, bf16_t* dst, int ld) {
    const int q0 = 32 * wc + 8 * fq;
    epi_pipe<RdS>([&](int ai, int m, RdS& d) { d.rs = rsf(ai, m, EPI_ROW(u, ai, m)); },
                  [&](int ai, int m, const RdS& d) { const int row = EPI_ROW(u, ai, m);
                      if (F8) { float v0[8], v1[8]; EPI_GET8(v0, ai, 0, m, d.rs); EPI_GET8(v1, ai, 1, m, d.rs); unsigned char* p = (unsigned char*)dst + (size_t)row * ld + q0; store16_f8w(p, p + 128, fq, v0, v1); }
                      else {
#pragma unroll
                      for (int bj = 0; bj < 2; ++bj) { float v[8]; EPI_GET8(v, ai, bj, m, d.rs); store8(dst + (size_t)row * ld + bj * 128 + q0, v); } } });
}
template <class RS>
__device__ __forceinline__ void plain_ssq_tile(Acc acc, const Unit& u, int wr, int wc, int fr, int fq, RS rsf, bf16_t* dst, int ld, float* ssq, int nslot, int slot0) {
    const int q0 = 32 * wc + 8 * fq;
    epi_pipe<RdS>([&](int ai, int m, RdS& d) { d.rs = rsf(ai, m, EPI_ROW(u, ai, m)); },
                  [&](int ai, int m, const RdS& d) { const int row = EPI_ROW(u, ai, m); float ss = 0.f;
#pragma unroll
                      for (int bj = 0; bj < 2; ++bj) { float v[8]; EPI_GET8(v, ai, bj, m, d.rs);
#pragma unroll
                          for (int e = 0; e < 8; ++e) ss += v[e] * v[e];
                          store8(dst + (size_t)row * ld + bj * 128 + q0, v); }
                      ss += __shfl_xor(ss, 16); ss += __shfl_xor(ss, 32);
                      if (fq == 0) ssq[(size_t)row * nslot + slot0 + wc] = ss; });
}
template <class RS>
__device__ __forceinline__ void vt_tile(Acc acc, const Unit& u, int wr, int wc, int fr, int fq, RS rsf, bf16_t* vt, int nh) {
    const int q0 = 32 * wc + 8 * fq;
    epi_pipe<RdS>([&](int ai, int m, RdS& d) { d.rs = rsf(ai, m, EPI_ROW(u, ai, m)); },
                  [&](int ai, int m, const RdS& d) { const int row = EPI_ROW(u, ai, m); const int b = row >> 12, s = row & (S - 1), ps = vpos(s);
#pragma unroll
                      for (int bj = 0; bj < 2; ++bj) { float v[8]; EPI_GET8(v, ai, bj, m, d.rs);
                          bf16_t* p = vt + (((size_t)b * nh + bj) * 128 + q0) * S + ps;
#pragma unroll
                          for (int e = 0; e < 8; ++e) p[(size_t)e * S] = f2bf(v[e]); } });
}
template <class RS>
__device__ __forceinline__ void hm_tile(Acc acc, const Unit& u, int wr, int wc, int fr, int fq, RS rsf, bf16_t* dst) {
    const int q0 = 32 * wc + 8 * fq;
    epi_pipe<RdS>([&](int ai, int m, RdS& d) { d.rs = rsf(ai, m, EPI_ROW(u, ai, m)); },
                  [&](int ai, int m, const RdS& d) { const int row = EPI_ROW(u, ai, m); const int b = row >> 12, s = row & (S - 1);
                      if (F8_CMP) { float v0[8], v1[8]; EPI_GET8(v0, ai, 0, m, d.rs); EPI_GET8(v1, ai, 1, m, d.rs);
                          store16_f8w((unsigned char*)dst + (((size_t)b * 2) * S + s) * 128 + q0, (unsigned char*)dst + (((size_t)b * 2 + 1) * S + s) * 128 + q0, fq, v0, v1); }
                      else {
#pragma unroll
                      for (int bj = 0; bj < 2; ++bj) { float v[8]; EPI_GET8(v, ai, bj, m, d.rs); store8(dst + (((size_t)b * 2 + bj) * S + s) * 128 + q0, v); } } });
}

struct In0 {
    const float* rstd; const float *c128, *s128, *c64, *s64; bf16_t *QA, *KA, *VA, *QLAT, *KVLAT, *KR; float *SSQQ, *SSQKV;
    __device__ __forceinline__ void operator()(Acc acc, const Unit& u, int wr, int wc, int fr, int fq) const {
        const int pn = u.pn; const float* rp = rstd;
        auto rsf = [rp](int, int, int row) { return rp[row]; };
        if (pn < 4) rope128_tile<KV8>(acc, u, wr, wc, fr, fq, rsf, c128, s128, kvw(QA, pn * 256), 1024);
        else if (pn == 4) rope128_tile<KV8>(acc, u, wr, wc, fr, fq, rsf, c128, s128, KA, 256);
        else if (pn == 5) plain_tile<KV8>(acc, u, wr, wc, fr, fq, rsf, VA, 256);
        else if (pn < 8) plain_ssq_tile(acc, u, wr, wc, fr, fq, rsf, QLAT + (pn - 6) * 256, 512, SSQQ, 8, (pn - 6) * 4);
        else if (pn == 8) plain_ssq_tile(acc, u, wr, wc, fr, fq, rsf, KVLAT, 256, SSQKV, 4, 0);
        else if (wc == 0) {
            const int i0 = 8 * fq; const float* c64_ = c64; const float* s64_ = s64; bf16_t* KR_ = KR;
            epi_pipe<RdRope>([&](int ai, int m, RdRope& d) { const int row = EPI_ROW(u, ai, m); d.rs = rp[row]; ld_rope(d, c64_ + (size_t)row * 32 + i0, s64_ + (size_t)row * 32 + i0); },
                             [&](int ai, int m, const RdRope& d) { const int row = EPI_ROW(u, ai, m);
                                 float x1[8], x2[8], y1[8], y2[8]; EPI_GET8(x1, ai, 0, m, d.rs); EPI_GET8(x2, ai, 1, m, d.rs); rope8(x1, x2, d, y1, y2);
                                 if (KV8) { unsigned char* p = (unsigned char*)KR_ + (size_t)row * 64 + i0; store16_f8w(p, p + 32, fq, y1, y2); }
                                 else { bf16_t* p = KR_ + (size_t)row * 64 + i0; store8(p, y1); store8(p + 32, y2); } });
        }
    }
};
struct RdUq { f32x4 a, b, c0, c1, s0, s1; };
struct Uq {
    const float* ssq; const float *c64, *s64; bf16_t* QB;
    __device__ __forceinline__ void operator()(Acc acc, const Unit& u, int wr, int wc, int fr, int fq) const {
        const int pn = u.pn, qq = 32 * wc + 8 * fq; const float* ssq_ = ssq; const float* c64_ = c64; const float* s64_ = s64; bf16_t* QB_ = QB;
        const int head = 4 * (pn - 4) + (qq >> 5), i0 = qq & 31;
        epi_pipe1<RdUq>([&](int ai, int m, RdUq& d) { const int row = EPI_ROW(u, ai, m); d.a = *(const f32x4*)(ssq_ + (size_t)row * 8); d.b = *(const f32x4*)(ssq_ + (size_t)row * 8 + 4);
                           if (pn >= 4) { d.c0 = *(const f32x4*)(c64_ + (size_t)row * 32 + i0); d.c1 = *(const f32x4*)(c64_ + (size_t)row * 32 + i0 + 4); d.s0 = *(const f32x4*)(s64_ + (size_t)row * 32 + i0); d.s1 = *(const f32x4*)(s64_ + (size_t)row * 32 + i0 + 4); } },
                       [&](int ai, int m, const RdUq& d) { const int row = EPI_ROW(u, ai, m);
                           const float rs = __builtin_amdgcn_rsqf(((d.a[0] + d.a[1]) + (d.a[2] + d.a[3]) + (d.b[0] + d.b[1]) + (d.b[2] + d.b[3])) * (1.0f / 512.0f) + EPS);
                           if (pn < 4) {
                               if (KV8) { float v0[8], v1[8]; EPI_GET8(v0, ai, 0, m, rs); EPI_GET8(v1, ai, 1, m, rs); unsigned char* p = (unsigned char*)QB_ + (size_t)row * 1536 + (2 * pn) * 192 + qq; store16_f8w(p, p + 192, fq, v0, v1); }
                               else {
#pragma unroll
                               for (int bj = 0; bj < 2; ++bj) { float v[8]; EPI_GET8(v, ai, bj, m, rs); store8(QB_ + (size_t)row * 1536 + (2 * pn + bj) * 192 + qq, v); } }
                           } else { RdRope r; r.rs = rs; r.c0 = d.c0; r.c1 = d.c1; r.s0 = d.s0; r.s1 = d.s1;
                               float x1[8], x2[8], y1[8], y2[8]; EPI_GET8(x1, ai, 0, m, rs); EPI_GET8(x2, ai, 1, m, rs); rope8(x1, x2, r, y1, y2);
                               if (KV8) { unsigned char* p = (unsigned char*)QB_ + (size_t)row * 1536 + head * 192 + 128 + i0; store16_f8w(p, p + 32, fq, y1, y2); }
                               else { bf16_t* p = QB_ + (size_t)row * 1536 + head * 192 + 128 + i0; store8(p, y1); store8(p + 32, y2); } } });
    }
};
struct RdV4 { f32x4 a; };
struct Ukv {
    const float* ssq; bf16_t *KB, *VB;
    __device__ __forceinline__ void operator()(Acc acc, const Unit& u, int wr, int wc, int fr, int fq) const {
        const int pn = u.pn, qq = 32 * wc + 8 * fq; const float* ssq_ = ssq; bf16_t* KB_ = KB; bf16_t* VB_ = VB;
        epi_pipe<RdV4>([&](int ai, int m, RdV4& d) { d.a = *(const f32x4*)(ssq_ + (size_t)EPI_ROW(u, ai, m) * 4); },
                       [&](int ai, int m, const RdV4& d) { const int row = EPI_ROW(u, ai, m);
                           const float rs = __builtin_amdgcn_rsqf(((d.a[0] + d.a[1]) + (d.a[2] + d.a[3])) * (1.0f / 256.0f) + EPS);
                           if (KV8) { float v0[8], v1[8]; EPI_GET8(v0, ai, 0, m, rs); EPI_GET8(v1, ai, 1, m, rs);
                               unsigned char* p = (pn < 4 ? (unsigned char*)KB_ + (size_t)row * 1024 + (2 * pn) * 128 : (unsigned char*)VB_ + (size_t)row * 1024 + (2 * (pn - 4)) * 128) + qq; store16_f8w(p, p + 128, fq, v0, v1); }
                           else {
#pragma unroll
                           for (int bj = 0; bj < 2; ++bj) { float v[8]; EPI_GET8(v, ai, bj, m, rs);
                               if (pn < 4) store8(KB_ + (size_t)row * 1024 + (2 * pn + bj) * 128 + qq, v);
                               else store8(VB_ + (size_t)row * 1024 + (2 * (pn - 4) + bj) * 128 + qq, v); } } });
    }
};
struct RdWo { f32x4 r[4]; };
template <bool RF32> struct Wo {
    const void* resid; bf16_t* hb; unsigned char* h8;
    __device__ __forceinline__ void operator()(Acc acc, const Unit& u, int wr, int wc, int fr, int fq) const {
        const int q0 = u.pn * 256 + 32 * wc + 8 * fq; const float* rf = (const float*)resid; const bf16_t* rb = (const bf16_t*)resid; bf16_t* hb_ = hb; unsigned char* h8_ = h8;
        epi_pipe<RdWo>([&](int ai, int m, RdWo& d) { const size_t o = (size_t)EPI_ROW(u, ai, m) * D + q0;
                           if (RF32) { d.r[0] = *(const f32x4*)(rf + o); d.r[1] = *(const f32x4*)(rf + o + 4); d.r[2] = *(const f32x4*)(rf + o + 128); d.r[3] = *(const f32x4*)(rf + o + 132); }
                           else { const u32x4 a = *(const u32x4*)(rb + o), b = *(const u32x4*)(rb + o + 128); d.r[0] = __builtin_bit_cast(f32x4, a); d.r[2] = __builtin_bit_cast(f32x4, b); } },
                       [&](int ai, int m, const RdWo& d) { const size_t o0 = (size_t)EPI_ROW(u, ai, m) * D + q0; float vv[2][8];
#pragma unroll
                           for (int bj = 0; bj < 2; ++bj) { float (&v)[8] = vv[bj]; EPI_GET8(v, ai, bj, m, 1.0f); const size_t o = o0 + bj * 128;
                               if (RF32) {
#pragma unroll
                                   for (int e = 0; e < 4; ++e) { v[e] += d.r[2 * bj][e]; v[4 + e] += d.r[2 * bj + 1][e]; }
                               } else { float r8[8]; unpack8(__builtin_bit_cast(u32x4, d.r[2 * bj]), r8);
#pragma unroll
                                   for (int e = 0; e < 8; ++e) v[e] += r8[e]; }
                               store8(hb_ + o, v); }
                           if (h8_) store16_f8w(h8_ + o0, h8_ + o0 + 128, fq, vv[0], vv[1]); });
    }
};
struct PlainBf16 {
    bf16_t* O; int ldc;
    __device__ __forceinline__ void operator()(Acc acc, const Unit& u, int wr, int wc, int fr, int fq) const { plain_tile(acc, u, wr, wc, fr, fq, [](int, int, int) { return 1.0f; }, O + u.pn * 256, ldc); }
};
struct RdPle { float rs; u32x4 pp[2]; u32x4 r[2]; };
struct Ple {
    const float* rstd; const bf16_t* PP; const bf16_t* hin; bf16_t* hout; float* ssq; unsigned char* h8;
    __device__ __forceinline__ void operator()(Acc acc, const Unit& u, int wr, int wc, int fr, int fq) const {
        const int q0 = u.pn * 256 + 32 * wc + 8 * fq; const float* rstd_ = rstd; const bf16_t* PP_ = PP; const bf16_t* hin_ = hin; bf16_t* hout_ = hout; float* ssq_ = ssq; unsigned char* h8_ = h8;
        epi_pipe1<RdPle>([&](int ai, int m, RdPle& d) { const int row = EPI_ROW(u, ai, m); const size_t o = (size_t)row * D + q0; d.rs = rstd_[row];
                            d.pp[0] = *(const u32x4*)(PP_ + o); d.pp[1] = *(const u32x4*)(PP_ + o + 128); d.r[0] = *(const u32x4*)(hin_ + o); d.r[1] = *(const u32x4*)(hin_ + o + 128); },
                        [&](int ai, int m, const RdPle& d) { const int row = EPI_ROW(u, ai, m); const size_t o0 = (size_t)row * D + q0; float ss = 0.f; float vv[2][8];
#pragma unroll
                            for (int bj = 0; bj < 2; ++bj) { float (&v)[8] = vv[bj]; float pp[8], r8[8]; EPI_GET8(v, ai, bj, m, d.rs); unpack8(d.pp[bj], pp); unpack8(d.r[bj], r8);
#pragma unroll
                                for (int e = 0; e < 8; ++e) { const float hh = r8[e] + pp[e] * sigmoidf_(v[e]); v[e] = hh; ss += hh * hh; }
                                store8(hout_ + o0 + bj * 128, v); }
                            if (h8_) store16_f8w(h8_ + o0, h8_ + o0 + 128, fq, vv[0], vv[1]);
                            if (ssq_) { ss += __shfl_xor(ss, 16); ss += __shfl_xor(ss, 32);
                                if (fq == 0) ssq_[(size_t)row * 32 + u.pn * 4 + wc] = ss; } });
    }
};
template <bool F8> struct MoeGu {
    const float* rlist; volatile LAS unsigned* cnt; bf16_t* H;
    __device__ __forceinline__ void operator()(Acc acc, const Unit& u, int wr, int wc, int fr, int fq) const {
        const int q0 = 32 * wc + 8 * fq; const int cn = __builtin_amdgcn_readfirstlane((int)cnt[u.e]); const float* rl = rlist + (size_t)u.e * T; bf16_t* H_ = H;
        float gkeep[8]; unsigned char* pkeep = nullptr;
        epi_pipe_n<RdS>(u.half ? 2 : 4, [&](int ai, int m, RdS& d) { const int gr = u.r0 + EPI_ROWL(ai, m); d.rs = gr < cn ? rl[gr] : 0.f; },
                      [&](int ai, int m, const RdS& d) { const int lr = EPI_ROWL(ai, m);
                          float g[8], w[8]; EPI_GET8(g, ai, 0, m, d.rs); EPI_GET8(w, ai, 1, m, d.rs);
#pragma unroll
                          for (int e = 0; e < 8; ++e) g[e] = g[e] * sigmoidf_(g[e]) * w[e];
                          if (F8) { unsigned char* p = (unsigned char*)H_ + ((size_t)u.pm * 256 + u.ro + lr) * EH + u.pn * 128 + q0;
                              if (!(m & 1)) {
#pragma unroll
                                  for (int e = 0; e < 8; ++e) gkeep[e] = g[e];
                                  pkeep = p; }
                              else store16_f8w(pkeep, p, fq, gkeep, g); }
                          else store8(H_ + ((size_t)u.pm * 256 + u.ro + lr) * EH + u.pn * 128 + q0, g); });
    }
};
template <bool F8Y> struct MoeDn {
    const float* wlist; volatile LAS unsigned* cnt; bf16_t* Y;
    __device__ __forceinline__ void operator()(Acc acc, const Unit& u, int wr, int wc, int fr, int fq) const {
        const int q0 = u.pn * 256 + 32 * wc + 8 * fq; const int cn = __builtin_amdgcn_readfirstlane((int)cnt[u.e]); const float* wl = wlist + (size_t)u.e * T; bf16_t* Y_ = Y;
        epi_pipe_n<RdS>(u.half ? 2 : 4, [&](int ai, int m, RdS& d) { const int gr = u.r0 + EPI_ROWL(ai, m); d.rs = gr < cn ? wl[gr] * (F8Y ? F8_OSC : 1.0f) : 0.f; },
                      [&](int ai, int m, const RdS& d) { const int lr = EPI_ROWL(ai, m);
#pragma unroll
                          for (int bj = 0; bj < 2; ++bj) { if (F8Y) break; float v[8]; EPI_GET8(v, ai, bj, m, d.rs); store8(Y_ + ((size_t)u.pm * 256 + u.ro + lr) * D + q0 + bj * 128, v); }
                          if (F8Y) { float v0[8], v1[8]; EPI_GET8(v0, ai, 0, m, d.rs); EPI_GET8(v1, ai, 1, m, d.rs); unsigned char* p = (unsigned char*)Y_ + ((size_t)u.pm * 256 + u.ro + lr) * D + q0; store16_f8w(p, p + 128, fq, v0, v1); } });
    }
};
struct In1 {
    const float* ssqp;
    const float *c128, *s128; const float* fb; bf16_t *CQ, *CK, *CV, *DQ, *KC, *VC, *KS, *VS, *KW, *VW; float *LF, *DG;
    __device__ __forceinline__ void operator()(Acc acc, const Unit& u, int wr, int wc, int fr, int fq) const {
        float rsv[2][4];
        { const int tid = (wr * 4 + wc) * 64 + fq * 16 + fr, rr = tid >> 1, part = tid & 1;
          const float* sp = ssqp + (size_t)(u.pm * 256 + rr) * 32 + part * 16; float ss = 0.f;
#pragma unroll
          for (int j = 0; j < 4; ++j) { const f32x4 a = *(const f32x4*)(sp + 4 * j); ss += (a[0] + a[1]) + (a[2] + a[3]); }
          ss += __shfl_xor(ss, 1);
          LAS float* rsL = (LAS float*)(LDS_RS);
          if (part == 0) rsL[rr] = __builtin_amdgcn_rsqf(ss * (1.0f / D) + EPS);
          asm volatile("s_waitcnt lgkmcnt(0)" ::: "memory"); __builtin_amdgcn_s_barrier(); asm volatile("" ::: "memory");
#pragma unroll
          for (int ai = 0; ai < 2; ++ai)
#pragma unroll
              for (int m = 0; m < 4; ++m) rsv[ai][m] = rsL[ai * 128 + wr * 64 + m * 16 + fr]; }
        __builtin_amdgcn_sched_barrier(0);
        auto rsf = [&](int ai, int m, int) { return rsv[ai][m]; };
        const int pn = u.pn;
        if (pn < 4) plain_tile<KV8>(acc, u, wr, wc, fr, fq, rsf, kvw(CQ, pn * 256), 1024);
        else if (pn < 8) plain_tile<KV8>(acc, u, wr, wc, fr, fq, rsf, kvw(CK, (pn - 4) * 256), 1024);
        else if (pn < 12) plain_tile<KV8>(acc, u, wr, wc, fr, fq, rsf, kvw(CV, (pn - 8) * 256), 1024);
        else if (pn < 16) rope128_tile(acc, u, wr, wc, fr, fq, rsf, c128, s128, DQ + (pn - 12) * 256, 1024);
        else if (pn == 16) hm_tile(acc, u, wr, wc, fr, fq, rsf, KC);
        else if (pn == 17) hm_tile(acc, u, wr, wc, fr, fq, rsf, VC);
        else if (pn == 18) rope128_tile<KV8>(acc, u, wr, wc, fr, fq, rsf, c128, s128, KS, 256);
        else if (pn == 19) plain_tile<KV8>(acc, u, wr, wc, fr, fq, rsf, VS, 256);
        else if (pn == 20) rope128_tile<KV8>(acc, u, wr, wc, fr, fq, rsf, c128, s128, KW, 256);
        else if (pn == 21) plain_tile<KV8>(acc, u, wr, wc, fr, fq, rsf, VW, 256);
        else if (wc == 0) {
#pragma unroll
            for (int ai = 0; ai < 2; ++ai)
#pragma unroll
                for (int m = 0; m < 4; ++m) { const int row = EPI_ROW(u, ai, m); float v[8]; EPI_GET8(v, ai, 0, m, rsv[ai][m]);
                    if (fq == 0) {
#pragma unroll
                        for (int e = 0; e < 8; ++e) { const float z = v[e] + fb[e];
                            v[e] = fminf(z, 0.f) - __logf(1.0f + __expf(-fabsf(z))); }
                        *(f32x4*)(LF + (size_t)row * 8) = (f32x4){v[0], v[1], v[2], v[3]}; *(f32x4*)(LF + (size_t)row * 8 + 4) = (f32x4){v[4], v[5], v[6], v[7]};
                    } else {
#pragma unroll
                        for (int e = 0; e < 8; ++e) v[e] = sigmoidf_(v[e]);
                        float* p = DG + (size_t)row * 24 + 8 * (fq - 1); *(f32x4*)p = (f32x4){v[0], v[1], v[2], v[3]}; *(f32x4*)(p + 4) = (f32x4){v[4], v[5], v[6], v[7]};
                    } }
        }
    }
};
template <bool HU> struct Cmp1 {
    const float* bias; bf16_t* HID;
    __device__ __forceinline__ void operator()(Acc acc, const Unit& u, int wr, int wc, int fr, int fq) const {
        const int q0 = 32 * wc + 8 * fq;
        f32x4 bb[2][2];
#pragma unroll
        for (int bj = 0; bj < 2; ++bj) { bb[bj][0] = *(const f32x4*)(bias + bj * 128 + q0); bb[bj][1] = *(const f32x4*)(bias + bj * 128 + q0 + 4); }
#pragma unroll
        for (int ai = 0; ai < (HU ? 1 : 2); ++ai)
#pragma unroll
            for (int m = 0; m < 4; ++m) { const int row = HU ? u.r0 + EPI_ROWL(0, m) : EPI_ROW(u, ai, m);
#pragma unroll
                for (int bj = 0; bj < 2; ++bj) { float v[8]; EPI_GET8(v, ai, bj, m, 1.0f); const int c = bj * 128 + q0;
#pragma unroll
                    for (int e = 0; e < 8; ++e) { const float x = v[e] + (e < 4 ? bb[bj][0][e] : bb[bj][1][e - 4]); v[e] = x * sigmoidf_(1.5957691216057308f * (x + 0.044715f * x * x * x)); }
                    store8(HID + (size_t)row * 256 + c, v); } }
    }
};
template <bool ISK, bool HU> struct Cmp2 {
    const float *c128, *s128; bf16_t* OUT;
    __device__ __forceinline__ void operator()(Acc acc, const Unit& u, int wr, int wc, int fr, int fq) const {
        const int q0 = 32 * wc + 8 * fq; const float* c128_ = c128; const float* s128_ = s128; bf16_t* OUT_ = OUT;
        if (ISK) { if (wc < 2) {
            epi_pipe_n<RdRope>(HU ? 2 : 4, [&](int ai, int m, RdRope& d) { const int row = HU ? u.r0 + EPI_ROWL(0, m) : EPI_ROW(u, ai, m); const int grp = row >> 8, c = row & 255; const int tt = (grp >> 1) * S + 16 * (c < 255 ? c : 0) + 31; d.rs = 1.0f;
                                 ld_rope(d, c128_ + (size_t)tt * 64 + q0, s128_ + (size_t)tt * 64 + q0); },
                             [&](int ai, int m, const RdRope& d) { const int row = HU ? u.r0 + EPI_ROWL(0, m) : EPI_ROW(u, ai, m); const bool ok = (row & 255) < 255;
                                 float x1[8], x2[8], y1[8], y2[8]; EPI_GET8(x1, ai, 0, m, 1.0f); EPI_GET8(x2, ai, 1, m, 1.0f); rope8(x1, x2, d, y1, y2);
                                 if (!ok) {
#pragma unroll
                                     for (int e = 0; e < 8; ++e) { y1[e] = 0.f; y2[e] = 0.f; } }
                                 bf16_t* p = OUT_ + (size_t)row * 128 + q0; store8(p, y1); store8(p + 64, y2); }); } }
        else {
#pragma unroll
            for (int ai = 0; ai < (HU ? 1 : 2); ++ai)
#pragma unroll
                for (int m = 0; m < 4; ++m) { const int row = HU ? u.r0 + EPI_ROWL(0, m) : EPI_ROW(u, ai, m); const bool ok = (row & 255) < 255;
                    float v[8]; EPI_GET8(v, ai, 0, m, 1.0f);
                    if (!ok) {
#pragma unroll
                        for (int e = 0; e < 8; ++e) v[e] = 0.f; }
                    store8(OUT_ + (size_t)row * 128 + q0, v); }
        }
    }
};
#undef EPI_ROW
#undef EPI_ROWL
#undef EPI_GET8
}
namespace att {
enum { M_A = 0, M_B = 1, M_C = 2, M_W = 3, M_S = 4 };
template <int MODE> struct Cfg;
template <> struct Cfg<M_A> { static constexpr int DK = 128, WIN = 128; static constexpr bool GQA = true, CUM = false, SEL = false, Q8 = KV8; };
template <> struct Cfg<M_B> { static constexpr int DK = 192, WIN = 0;   static constexpr bool GQA = false, CUM = false, SEL = false, Q8 = KV8; };
template <> struct Cfg<M_C> { static constexpr int DK = 128, WIN = 0;   static constexpr bool GQA = false, CUM = true, SEL = false, Q8 = KV8; };
template <> struct Cfg<M_W> { static constexpr int DK = 128, WIN = 512; static constexpr bool GQA = true, CUM = false, SEL = false, Q8 = false; };
template <> struct Cfg<M_S> { static constexpr int DK = 128, WIN = 0;   static constexpr bool GQA = true, CUM = false, SEL = true, Q8 = false; };

constexpr int LK0 = 0, LK1 = 24576, LV0 = 49152, LV1 = 65536, LCUM = 81920;
constexpr bool FOLDC2 = true;
constexpr float THR = 8.0f;
#define KSWZ(RB, row, colB) ((row) * (RB) + ((colB) ^ (((row) & 7) << 4)))
#define VOFF(row, ch) (256 * (row) + 16 * ((ch) ^ ((((row) & 3) << 2) | (((row) >> 2) & 3))))

__device__ __forceinline__ int crow(int r) { return (r & 3) + 8 * (r >> 2); }
__device__ __forceinline__ bf16x8 pk8(const f32x16& p, int s) {
    u32x4 w; w.x = cvt_pk(p[8 * s + 0], p[8 * s + 1]); w.y = cvt_pk(p[8 * s + 2], p[8 * s + 3]); w.z = cvt_pk(p[8 * s + 4], p[8 * s + 5]); w.w = cvt_pk(p[8 * s + 6], p[8 * s + 7]);
    return *reinterpret_cast<bf16x8*>(&w);
}
template <int DK> __device__ __forceinline__ void kv_addr(int lane, int (&ka)[4], int (&va)[8]) {
    const int kr = lane & 31, hh = lane >> 5, blk = (lane >> 4) & 1, q = (lane & 15) >> 2, p = lane & 3;
#pragma unroll
    for (int i = 0; i < 4; ++i) ka[i] = KSWZ(DK * 2, kr, 32 * i + 16 * hh);
#pragma unroll
    for (int db = 0; db < 4; ++db)
#pragma unroll
        for (int t = 0; t < 2; ++t) va[2 * db + t] = VOFF(4 * hh + q + 8 * t, 4 * db + 2 * blk + (p >> 1)) + 8 * (p & 1);
}
template <int DK> __device__ __forceinline__ void qk_tile(const LAS unsigned char* kb, const int (&ka)[4], const bf16x8 (&qf)[DK / 16], f32x16& p0, f32x16& p1) {
#pragma unroll
    for (int r = 0; r < 16; ++r) { p0[r] = 0.f; p1[r] = 0.f; }
#pragma unroll
    for (int ks = 0; ks < DK / 16; ++ks) {
        const bf16x8 a0 = *(const LAS bf16x8*)(kb + ka[ks & 3] + (ks >> 2) * 128);
        const bf16x8 a1 = *(const LAS bf16x8*)(kb + ka[ks & 3] + (ks >> 2) * 128 + 32 * DK * 2);
        p0 = __builtin_amdgcn_mfma_f32_32x32x16_bf16(a0, qf[ks], p0, 0, 0, 0);
        p1 = __builtin_amdgcn_mfma_f32_32x32x16_bf16(a1, qf[ks], p1, 0, 0, 0);
    }
}
__device__ __forceinline__ u32x2 bf8_to_f8(const u32x4 w) {
    int a = (int)w.x, b = (int)w.z;
    a = __builtin_amdgcn_cvt_pk_fp8_f32(__uint_as_float(w.x << 16), __uint_as_float(w.x), a, false); a = __builtin_amdgcn_cvt_pk_fp8_f32(__uint_as_float(w.y << 16), __uint_as_float(w.y), a, true);
    b = __builtin_amdgcn_cvt_pk_fp8_f32(__uint_as_float(w.z << 16), __uint_as_float(w.z), b, false); b = __builtin_amdgcn_cvt_pk_fp8_f32(__uint_as_float(w.w << 16), __uint_as_float(w.w), b, true);
    u32x2 r; r.x = (unsigned)a; r.y = (unsigned)b; return r;
}
#define K8SWZ(row, colB) ((row) * 128 + ((colB) ^ (((row) & 7) << 4)))
#define K8SWZ2(row, colB) (8192 + (row) * 64 + ((colB) ^ ((((row) >> 1) & 3) << 4)))
__device__ __forceinline__ void k8_addr(int lane, int (&ka)[6]) {
    const int kr = lane & 31, hh = lane >> 5;
#pragma unroll
    for (int t = 0; t < 2; ++t)
#pragma unroll
        for (int u = 0; u < 2; ++u) ka[2 * t + u] = K8SWZ(kr, 64 * t + 32 * hh + 16 * u);
#pragma unroll
    for (int u = 0; u < 2; ++u) ka[4 + u] = K8SWZ2(kr, 32 * hh + 16 * u);
}
template <int DK> __device__ __forceinline__ void qk_tile8(const LAS unsigned char* kb, const int (&ka)[6], const i32x8 (&q8)[DK / 64], f32x16& p0, f32x16& p1) {
#pragma unroll
    for (int r = 0; r < 16; ++r) { p0[r] = 0.f; p1[r] = 0.f; }
#pragma unroll
    for (int t = 0; t < DK / 64; ++t) {
        const int rs = t < 2 ? 32 * 128 : 32 * 64;
        const i32x8 a0 = __builtin_shufflevector(*(const LAS i32x4*)(kb + ka[2 * t]), *(const LAS i32x4*)(kb + ka[2 * t + 1]), 0, 1, 2, 3, 4, 5, 6, 7);
        const i32x8 a1 = __builtin_shufflevector(*(const LAS i32x4*)(kb + ka[2 * t] + rs), *(const LAS i32x4*)(kb + ka[2 * t + 1] + rs), 0, 1, 2, 3, 4, 5, 6, 7);
        p0 = __builtin_amdgcn_mfma_scale_f32_32x32x64_f8f6f4(a0, q8[t], p0, 0, 0, 0, 0x7f7f7f7f, 0, 0x7f7f7f7f);
        p1 = __builtin_amdgcn_mfma_scale_f32_32x32x64_f8f6f4(a1, q8[t], p1, 0, 0, 0, 0x7f7f7f7f, 0, 0x7f7f7f7f);
    }
}
typedef short s16x4 __attribute__((ext_vector_type(4)));
__device__ __forceinline__ void pv_tile(const int vb, const int (&va)[8], const f32x16& p0, const f32x16& p1, f32x16 (&o)[4]) {
    const bf16x8 pb[4] = {pk8(p0, 0), pk8(p0, 1), pk8(p1, 0), pk8(p1, 1)};
#pragma unroll
    for (int db = 0; db < 4; ++db) {
        const LAS unsigned char* a0 = (const LAS unsigned char*)(unsigned)(va[2 * db] + vb); const LAS unsigned char* a1 = (const LAS unsigned char*)(unsigned)(va[2 * db + 1] + vb);
#pragma unroll
        for (int s4 = 0; s4 < 4; ++s4) {
            const s16x4 lo = __builtin_amdgcn_ds_read_tr16_b64_v4i16((LAS s16x4*)(a0 + 4096 * s4)), hi = __builtin_amdgcn_ds_read_tr16_b64_v4i16((LAS s16x4*)(a1 + 4096 * s4));
            o[db] = __builtin_amdgcn_mfma_f32_32x32x16_bf16((bf16x8){lo[0], lo[1], lo[2], lo[3], hi[0], hi[1], hi[2], hi[3]}, pb[s4], o[db], 0, 0, 0);
        }
    }
}
#define V8OFF(row, colB) ((row) * 128 + ((colB) ^ (((((row) >> 1) & 1) | ((((row) >> 3) & 1) << 1)) << 5)))
__device__ __forceinline__ void v8_addr(int lane, int (&va8)[4]) {
    const int hh = lane >> 5, blk = (lane >> 4) & 1, q = (lane & 15) >> 1, p = lane & 1;
    const int key0 = 8 * (q >> 2) + 4 * hh + (q & 3);
#pragma unroll
    for (int db = 0; db < 4; ++db) va8[db] = V8OFF(key0, 32 * db + 16 * blk + 8 * p);
}
typedef int i32x2 __attribute__((ext_vector_type(2)));
__device__ __forceinline__ float pv_tile8(const int vb, const int (&va8)[4], const f32x16& p0, const f32x16& p1, f32x16 (&o)[4], const i32x8& ones) {
    i32x8 pb;
#pragma unroll
    for (int s2 = 0; s2 < 2; ++s2) { float v[8];
#pragma unroll
        for (int e = 0; e < 8; ++e) v[e] = p0[8 * s2 + e];
        u32x2 w = pack8_f8(v); pb[2 * s2] = (int)w.x; pb[2 * s2 + 1] = (int)w.y;
#pragma unroll
        for (int e = 0; e < 8; ++e) v[e] = p1[8 * s2 + e];
        w = pack8_f8(v); pb[4 + 2 * s2] = (int)w.x; pb[4 + 2 * s2 + 1] = (int)w.y; }
#pragma unroll
    for (int db = 0; db < 4; ++db) {
        const LAS unsigned char* a = (const LAS unsigned char*)(unsigned)(va8[db] + vb);
        const i32x2 r0 = __builtin_amdgcn_ds_read_tr8_b64_v2i32((LAS i32x2*)(a)), r1 = __builtin_amdgcn_ds_read_tr8_b64_v2i32((LAS i32x2*)(a + 2048));
        const i32x2 r2 = __builtin_amdgcn_ds_read_tr8_b64_v2i32((LAS i32x2*)(a + 4096)), r3 = __builtin_amdgcn_ds_read_tr8_b64_v2i32((LAS i32x2*)(a + 6144));
        const i32x8 av = {r0[0], r0[1], r1[0], r1[1], r2[0], r2[1], r3[0], r3[1]};
        o[db] = __builtin_amdgcn_mfma_scale_f32_32x32x64_f8f6f4(av, pb, o[db], 0, 0, 0, 0x7f7f7f7f, 0, 0x7f7f7f7f);
    }
    f32x16 z;
#pragma unroll
    for (int r = 0; r < 16; ++r) z[r] = 0.f;
    const f32x16 lt = __builtin_amdgcn_mfma_scale_f32_32x32x64_f8f6f4(ones, pb, z, 0, 0, 0, 0x7f7f7f7f, 0, 0x7f7f7f7f);
    return lt[0];
}

template <int MODE>
__device__ __forceinline__ void flash(const Frame& F, const bf16_t* qrow, const bf16_t* kbase, int ldk, const bf16_t* krope, const bf16_t* vbase, int ldv, const float* cumk, float cumq,
                                      int tpos, int tw_lo, int tw_hi, int tlo, int thi, u64 sel, u64 selu, float c2, float& m_run, float& l_run, f32x16 (&o)[4]) {
    typedef Cfg<MODE> C; constexpr int DK = C::DK, NKC = DK / 64;
    const int tid = F.tid, lane = F.lane, hh = lane >> 5;
    LAS unsigned char* lds = F.lds;
    bf16x8 qf[QK8 ? 1 : DK / 16]; i32x8 q8[DK / 64];
    int ka[4], va[8]; kv_addr<DK>(lane, ka, va); int ka8[6], va8[4]; if (PV8) v8_addr(lane, va8);
    i32x8 ones8;
#pragma unroll
    for (int i = 0; i < 8; ++i) ones8[i] = 0x38383838;
    asm volatile("" : "+v"(ones8));
    if (QK8) {
        k8_addr(lane, ka8);
#pragma unroll
        for (int t = 0; t < DK / 64; ++t)
#pragma unroll
            for (int jq = 0; jq < 4; ++jq) {
                if (C::Q8) { if (jq < 2) { const u32x4 w = *(const u32x4*)((const unsigned char*)qrow + 64 * t + 32 * hh + 16 * jq); q8[t][4 * jq] = (int)w.x; q8[t][4 * jq + 1] = (int)w.y; q8[t][4 * jq + 2] = (int)w.z; q8[t][4 * jq + 3] = (int)w.w; } }
                else { const u32x2 w = bf8_to_f8(*(const u32x4*)(qrow + 64 * t + 32 * hh + 8 * jq)); q8[t][2 * jq] = (int)w.x; q8[t][2 * jq + 1] = (int)w.y; } }
    } else {
#pragma unroll
        for (int ks = 0; ks < DK / 16; ++ks) qf[ks] = *(const bf16x8*)(qrow + 16 * ks + 8 * hh);
    }
    auto next_tile = [&](int j) -> int {
        if (!C::SEL) return j + 1;
        const u64 mk = (j >= 63) ? 0ull : (selu & ~((2ull << j) - 1ull));
        const int n = mk ? (__ffsll((long long)mk) - 1) : 64;
        return n < thi ? n : thi;
    };
    int j = tlo;
    if (C::SEL) { if (!((selu >> tlo) & 1ull)) j = next_tile(tlo); }
    if (j >= thi) return;
    u32x4 kreg[NKC], vreg[2]; float creg = 0.f;
    u32x4 k8m, k8r, v8m;
    unsigned koff[NKC], voff[2];
#pragma unroll
    for (int i = 0; i < NKC; ++i) { const int c = tid + i * NTHR, row = c / (DK / 8), c8 = c % (DK / 8);
        koff[i] = (DK == 192 && c8 >= 16) ? (0x80000000u | (unsigned)(row * 64 + (c8 - 16) * 8) * 2u) : (unsigned)(row * ldk + c8 * 8) * 2u; }
#pragma unroll
    for (int i = 0; i < 2; ++i) { const int c = tid + i * NTHR, row = c >> 4, ch = c & 15; voff[i] = (unsigned)(row * ldv + ch * 8) * 2u; }
    const unsigned kso = (unsigned)((tid >> 3) * ldk + (((tid & 7) ^ ((tid >> 3) & 7)) * 16));
    const unsigned vso = (unsigned)((tid >> 3) * ldv + (((tid & 7) ^ (((((tid >> 3) >> 1) & 1) | ((((tid >> 3) >> 3) & 1) << 1)) << 1)) * 16));
    const unsigned rso = (unsigned)((tid >> 2) * 64 + (((tid & 3) ^ (((tid >> 2) >> 1) & 3)) * 16));
    const int wv = F.wave;
    auto dma = [&](int jt, int b) {
        LAS unsigned char* kb = lds + (b ? LK1 : LK0) + wv * 1024; LAS unsigned char* vb = lds + (b ? LV1 : LV0) + wv * 1024;
        const char* kt8 = (const char*)kbase + (size_t)jt * 64 * ldk; const char* vt8 = (const char*)vbase + (size_t)jt * 64 * ldv;
        __builtin_amdgcn_global_load_lds((const unsigned*)(kt8 + kso), (LAS unsigned*)kb, 16, 0, 0);
        __builtin_amdgcn_global_load_lds((const unsigned*)(vt8 + vso), (LAS unsigned*)vb, 16, 0, 0);
        if (DK == 192) { if (wv < 4) __builtin_amdgcn_global_load_lds((const unsigned*)((const char*)krope + (size_t)jt * 64 * 64 + rso), (LAS unsigned*)(kb + 8192), 16, 0, 0); }
        if (C::CUM) { if (tid < 64) creg = cumk[jt * 64 + tid]; }
    };
    auto dma_done = [&](int b) {
        if (C::CUM) { if (tid < 64) ((LAS float*)(lds + LCUM))[b * 64 + tid] = creg; }
        asm volatile("s_waitcnt vmcnt(0)" ::: "memory");
    };
    auto gload = [&](int jt) {
        if constexpr (KV8) {
            const char* kt8 = (const char*)kbase + (size_t)jt * 64 * ldk; const char* vt8 = (const char*)vbase + (size_t)jt * 64 * ldv;
            k8m = *(const u32x4*)(kt8 + (size_t)(tid >> 3) * ldk + (tid & 7) * 16); v8m = *(const u32x4*)(vt8 + (size_t)(tid >> 3) * ldv + (tid & 7) * 16);
            if (DK == 192) { if (tid < 256) k8r = *(const u32x4*)((const char*)krope + (size_t)jt * 64 * 64 + tid * 16); }
            if (C::CUM) { if (tid < 64) creg = cumk[jt * 64 + tid]; }
            return;
        }
        const char* kt = (const char*)kbase + (size_t)jt * 64 * ldk * 2; const char* vtt = (const char*)vbase + (size_t)jt * 64 * ldv * 2; const char* krt = (const char*)krope + (size_t)jt * 64 * 128;
#pragma unroll
        for (int i = 0; i < NKC; ++i) kreg[i] = (DK == 192 && (koff[i] & 0x80000000u)) ? *(const u32x4*)(krt + (koff[i] & 0x7fffffffu)) : *(const u32x4*)(kt + koff[i]);
#pragma unroll
        for (int i = 0; i < 2; ++i) vreg[i] = *(const u32x4*)(vtt + voff[i]);
        if (C::CUM) { if (tid < 64) creg = cumk[jt * 64 + tid]; }
    };
    auto lstore = [&](int buf) {
        LAS unsigned char* kb = lds + (buf ? LK1 : LK0); LAS unsigned char* vb = lds + (buf ? LV1 : LV0);
        if constexpr (KV8) {
            *(LAS u32x4*)(kb + K8SWZ(tid >> 3, (tid & 7) * 16)) = k8m; *(LAS u32x4*)(vb + V8OFF(tid >> 3, (tid & 7) * 16)) = v8m;
            if (DK == 192) { if (tid < 256) *(LAS u32x4*)(kb + K8SWZ2(tid >> 2, (tid & 3) * 16)) = k8r; }
            if (C::CUM) { if (tid < 64) ((LAS float*)(lds + LCUM))[buf * 64 + tid] = creg; }
            return;
        }
#pragma unroll
        for (int i = 0; i < NKC; ++i) { const int c = tid + i * NTHR, row = c / (DK / 8), c8 = c % (DK / 8);
            if (QK8) *(LAS u32x2*)(kb + (c8 < 16 ? K8SWZ(row, c8 * 8) : K8SWZ2(row, (c8 - 16) * 8))) = bf8_to_f8(kreg[i]);
            else *(LAS u32x4*)(kb + KSWZ(DK * 2, row, c8 * 16)) = kreg[i]; }
#pragma unroll
        for (int i = 0; i < 2; ++i) { const int c = tid + i * NTHR, row = c >> 4, ch = c & 15;
            if (PV8) *(LAS u32x2*)(vb + V8OFF(row, 8 * ch)) = bf8_to_f8(vreg[i]);
            else *(LAS u32x4*)(vb + VOFF(row, ch)) = vreg[i]; }
        if (C::CUM) { if (tid < 64) ((LAS float*)(lds + LCUM))[buf * 64 + tid] = creg; }
    };
    if constexpr (KVDMA) { dma(j, 0); dma_done(0); } else { gload(j); lstore(0); }
    __syncthreads();
    int buf = 0;
    constexpr unsigned WCMP = C::WIN ? (unsigned)C::WIN : 0x7fffffffu;
    while (j < thi) {
        const int jn = next_tile(j);
        if (jn < thi) { if constexpr (KVDMA) dma(jn, buf ^ 1); else gload(jn); }
        bool act = (64 * j <= tw_hi);
        if (C::WIN) act = act && (64 * j + 63 >= tw_lo - (C::WIN - 1));
        const bool selb = C::SEL ? (((sel >> j) & 1ull) != 0ull) : true;
        if (C::SEL) act = act && (__ballot(selb) != 0ull);
        if (act) {
            const LAS unsigned char* kb = lds + (buf ? LK1 : LK0);
            f32x16 p0, p1;
            if constexpr (QK8) qk_tile8<DK>(kb, ka8, q8, p0, p1); else qk_tile<DK>(kb, ka, qf, p0, p1);
            if (C::CUM) {
                const LAS float* cb = (const LAS float*)(lds + LCUM) + buf * 64 + 4 * hh;
#pragma unroll
                for (int g = 0; g < 4; ++g) { const f32x4 k0 = *(const LAS f32x4*)(cb + 8 * g), k1 = *(const LAS f32x4*)(cb + 32 + 8 * g);
#pragma unroll
                    for (int e = 0; e < 4; ++e) { p0[4 * g + e] = fmaf(p0[4 * g + e], c2, cumq - k0[e]); p1[4 * g + e] = fmaf(p1[4 * g + e], c2, cumq - k1[e]); } }
            } else if (!FOLDC2) {
#pragma unroll
                for (int r = 0; r < 16; ++r) { p0[r] *= c2; p1[r] *= c2; }
            }
            bool need = (64 * j + 63 > tw_lo);
            if (C::WIN) need = need || (tw_hi - 64 * j >= C::WIN);
            if (C::SEL) need = true;
            if (need) {
                const float NEG = -__builtin_inff();
                int dq = tpos - 64 * j - 4 * hh; if (C::SEL && !selb) dq = -1;
#pragma unroll
                for (int r = 0; r < 16; ++r) { const int c = crow(r);
                    if ((unsigned)(dq - c) >= WCMP) p0[r] = NEG;
                    if ((unsigned)(dq - c - 32) >= WCMP) p1[r] = NEG; }
            }
            float pmax = p0[0];
#pragma unroll
            for (int r = 1; r < 16; ++r) pmax = fmaxf(pmax, p0[r]);
#pragma unroll
            for (int r = 0; r < 16; ++r) pmax = fmaxf(pmax, p1[r]);
            pmax = fmaxf(pmax, __shfl_xor(pmax, 32));
            if (!C::CUM && FOLDC2) pmax *= c2;
            float mn = m_run;
            if (!__all(pmax - m_run <= THR)) {
                mn = fmaxf(m_run, pmax); const float alpha = fast_exp2(m_run - mn); m_run = mn; l_run *= alpha;
#pragma unroll
                for (int db = 0; db < 4; ++db)
#pragma unroll
                    for (int r = 0; r < 16; ++r) o[db][r] *= alpha;
            }
            float ps = 0.f;
#pragma unroll
            for (int r = 0; r < 16; ++r) {
                if (C::CUM || !FOLDC2) { p0[r] = fast_exp2(p0[r] - mn); p1[r] = fast_exp2(p1[r] - mn); }
                else { p0[r] = fast_exp2(fmaf(p0[r], c2, -mn)); p1[r] = fast_exp2(fmaf(p1[r], c2, -mn)); }
                if (!PV8) ps += p0[r] + p1[r]; }
            if (!PV8) { ps += __shfl_xor(ps, 32); l_run += ps; }
            if (PV8) l_run += pv_tile8(buf ? LV1 : LV0, va8, p0, p1, o, ones8); else pv_tile(buf ? LV1 : LV0, va, p0, p1, o);
        }
        if (jn < thi) { if constexpr (KVDMA) dma_done(buf ^ 1); else lstore(buf ^ 1); }
        __syncthreads();
        j = jn; buf ^= 1;
    }
}

template <bool ADD, bool IMG = false, bool NOBF = false>
__device__ __forceinline__ void out_row(bf16_t* orow, const f32x16 (&o)[4], float scale, int hh, unsigned char* o8 = nullptr) {
#pragma unroll
    for (int db = 0; db < 4; ++db) {
        u32x2 wb[4], wo[4]; unsigned qi[4];
        if (ADD) {
#pragma unroll
            for (int pr = 0; pr < 2; ++pr) { const u32x4 l = *(const u32x4*)(orow + 32 * db + 16 * pr + 8 * hh);
                const auto rx = __builtin_amdgcn_permlane32_swap(l.x, l.z, false, false); const auto ry = __builtin_amdgcn_permlane32_swap(l.y, l.w, false, false);
                wo[2 * pr].x = rx[0]; wo[2 * pr].y = ry[0]; wo[2 * pr + 1].x = rx[1]; wo[2 * pr + 1].y = ry[1]; }
        }
#pragma unroll
        for (int g = 0; g < 4; ++g) {
            float v0 = o[db][4 * g] * scale, v1 = o[db][4 * g + 1] * scale, v2 = o[db][4 * g + 2] * scale, v3 = o[db][4 * g + 3] * scale;
            if (ADD) { const u32x2 w = wo[g]; v0 += __uint_as_float(w.x << 16); v1 += __uint_as_float(w.x & 0xffff0000u); v2 += __uint_as_float(w.y << 16); v3 += __uint_as_float(w.y & 0xffff0000u); }
            if (!NOBF) { wb[g].x = cvt_pk(v0, v1); wb[g].y = cvt_pk(v2, v3); }
            if (IMG) { int q = __float_as_int(v0); q = __builtin_amdgcn_cvt_pk_fp8_f32(v0 * F8_OSC, v1 * F8_OSC, q, false); q = __builtin_amdgcn_cvt_pk_fp8_f32(v2 * F8_OSC, v3 * F8_OSC, q, true); qi[g] = (unsigned)q; }
        }
        if (!NOBF) {
#pragma unroll
            for (int pr = 0; pr < 2; ++pr) {
                const auto rx = __builtin_amdgcn_permlane32_swap(wb[2 * pr].x, wb[2 * pr + 1].x, false, false); const auto ry = __builtin_amdgcn_permlane32_swap(wb[2 * pr].y, wb[2 * pr + 1].y, false, false);
                *(u32x4*)(orow + 32 * db + 16 * pr + 8 * hh) = (u32x4){rx[0], ry[0], rx[1], ry[1]};
            }
        }
        if (IMG) {
            const auto a = __builtin_amdgcn_permlane32_swap(qi[0], qi[1], false, false); const auto b = __builtin_amdgcn_permlane32_swap(qi[2], qi[3], false, false);
            const auto x = __builtin_amdgcn_permlane32_swap(a[0], b[0], false, false); const auto y = __builtin_amdgcn_permlane32_swap(a[1], b[1], false, false);
            *(u32x4*)(o8 + 32 * db + 16 * hh) = (u32x4){x[0], y[0], x[1], y[1]};
        }
    }
}
__device__ __forceinline__ void zero_o(f32x16 (&o)[4]) {
#pragma unroll
    for (int db = 0; db < 4; ++db)
#pragma unroll
        for (int r = 0; r < 16; ++r) o[db][r] = 0.f;
}
constexpr float TINY = 1.17549435e-38f;

__device__ __forceinline__ const bf16_t* kvp(const bf16_t* base, size_t el) { return (const bf16_t*)((const unsigned char*)base + el * (KV8 ? 1 : 2)); }
struct L0Bufs { const bf16_t *QA, *KA, *VA, *QB, *KB, *KR, *VB; const float* sinks; bf16_t* O; };
__device__ __forceinline__ void item_A(const Frame& F, const L0Bufs& Bf, int b, int hk, int qt) {
    const int lane = F.lane, n = lane & 31, hh = lane >> 5, w = F.wave;
    const int tok = 64 * qt + 8 * w + (n & 7), head = 4 * hk + (n >> 3);
    const bf16_t* qrow = kvp(Bf.QA, ((size_t)b * S + tok) * 1024 + head * 128);
    float m = Bf.sinks[head] * LOG2E, l = 1.0f; f32x16 o[4]; zero_o(o);
    const int tlo = qt - 2 < 0 ? 0 : qt - 2;
    flash<M_A>(F, qrow, kvp(Bf.KA, (size_t)b * S * 256 + hk * 128), 256, nullptr, kvp(Bf.VA, (size_t)b * S * 256 + hk * 128), 256, nullptr, 0.f,
               tok, 64 * qt + 8 * w, 64 * qt + 8 * w + 7, tlo, qt + 1, 0ull, 0ull, 0.08838834764831845f * LOG2E, m, l, o);
    out_row<false, F8_WO0, F8_WO0>(Bf.O + ((size_t)b * S + tok) * D + head * 128, o, 1.0f / fmaxf(l, TINY), hh, F.ws + WS_O8 + ((size_t)b * S + tok) * D + head * 128);
}
__device__ __forceinline__ void item_B(const Frame& F, const L0Bufs& Bf, int b, int h, int qt) {
    const int lane = F.lane, n = lane & 31, hh = lane >> 5, w = F.wave;
    const int tok = 256 * qt + 32 * w + n;
    const bf16_t* qrow = kvp(Bf.QB, ((size_t)b * S + tok) * 1536 + h * 192);
    float m = -1e30f, l = 0.f; f32x16 o[4]; zero_o(o);
    flash<M_B>(F, qrow, kvp(Bf.KB, (size_t)b * S * 1024 + h * 128), 1024, kvp(Bf.KR, (size_t)b * S * 64), kvp(Bf.VB, (size_t)b * S * 1024 + h * 128), 1024, nullptr, 0.f,
               tok, 256 * qt + 32 * w, 256 * qt + 32 * w + 31, 0, 4 * (qt + 1), 0ull, 0ull, 0.07216878364870322f * LOG2E, m, l, o);
    out_row<false, F8_WO0, F8_WO0>(Bf.O + ((size_t)b * S + tok) * D + 1024 + h * 128, o, 1.0f / fmaxf(l, TINY), hh, F.ws + WS_O8 + ((size_t)b * S + tok) * D + 1024 + h * 128);
}
struct L1Bufs { const bf16_t *CQ, *CK, *CV, *DQ, *KS, *VS, *KW, *VW, *KCMP, *VCMP; const float *CUM, *DG; u64* SEL; bf16_t* O; };
__device__ __forceinline__ void item_C(const Frame& F, const L1Bufs& Bf, int b, int h, int qt) {
    const int lane = F.lane, n = lane & 31, hh = lane >> 5, w = F.wave;
    const int tok = 256 * qt + 32 * w + n;
    const bf16_t* qrow = kvp(Bf.CQ, ((size_t)b * S + tok) * 1024 + h * 128);
    const float* cumk = Bf.CUM + (size_t)(b * 8 + h) * S;
    float m = -1e30f, l = 0.f; f32x16 o[4]; zero_o(o);
    flash<M_C>(F, qrow, kvp(Bf.CK, (size_t)b * S * 1024 + h * 128), 1024, nullptr, kvp(Bf.CV, (size_t)b * S * 1024 + h * 128), 1024, cumk, cumk[tok],
               tok, 256 * qt + 32 * w, 256 * qt + 32 * w + 31, 0, 4 * (qt + 1), 0ull, 0ull, 0.08838834764831845f * LOG2E, m, l, o);
    out_row<false, F8_WO1, F8_WO1>(Bf.O + ((size_t)b * S + tok) * D + h * 128, o, 1.0f / fmaxf(l, TINY), hh, F.ws + WS_O8 + ((size_t)b * S + tok) * D + h * 128);
}
__device__ __forceinline__ void item_W(const Frame& F, const L1Bufs& Bf, int b, int hk, int qt) {
    const int lane = F.lane, n = lane & 31, hh = lane >> 5, w = F.wave;
    const int tok = 64 * qt + 8 * w + (n & 7), head = 4 * hk + (n >> 3);
    const bf16_t* qrow = Bf.DQ + ((size_t)b * S + tok) * 1024 + head * 128;
    float m = -1e30f, l = 0.f; f32x16 o[4]; zero_o(o);
    const int tlo = qt - 8 < 0 ? 0 : qt - 8;
    flash<M_W>(F, qrow, kvp(Bf.KW, (size_t)b * S * 256 + hk * 128), 256, nullptr, kvp(Bf.VW, (size_t)b * S * 256 + hk * 128), 256, nullptr, 0.f,
               tok, 64 * qt + 8 * w, 64 * qt + 8 * w + 7, tlo, qt + 1, 0ull, 0ull, 0.08838834764831845f * LOG2E, m, l, o);
    const float g2 = Bf.DG[((size_t)b * S + tok) * 24 + 16 + head];
    out_row<false>(Bf.O + ((size_t)b * S + tok) * D + 1024 + head * 128, o, g2 / fmaxf(l, TINY), hh);
}
__device__ __forceinline__ void item_S(const Frame& F, const L1Bufs& Bf, int b, int hk, int qt) {
    const int tid = F.tid, lane = F.lane, n = lane & 31, hh = lane >> 5, w = F.wave;
    const int tl = 8 * w + (n & 7), tok = 64 * qt + tl, gq = n >> 3, head = 4 * hk + gq;
    const bf16_t* qrow = Bf.DQ + ((size_t)b * S + tok) * 1024 + head * 128;
    LAS unsigned char* lds = F.lds;
    LAS float* imp = (LAS float*)(lds + LDS_IMP);
    LAS u64* selL = (LAS u64*)(lds + LDS_SEL);
    const float c2 = 0.08838834764831845f * LOG2E;
    bf16_t* orow = Bf.O + ((size_t)b * S + tok) * D + 1024 + head * 128;
    const int cmax = (64 * qt + 63 - 31) >> 4;
    const int ntile = (cmax >> 6) + 1;
    for (int i = tid; i < 64 * 64; i += NTHR) imp[i] = 0.f;
    {
        const bf16_t* kc = Bf.KCMP + (size_t)(b * 2 + hk) * 256 * 128; const bf16_t* vc = Bf.VCMP + (size_t)(b * 2 + hk) * 256 * 128;
        for (int c = tid; c < ntile * 1024; c += NTHR) { const int tt = c >> 10, cc = c & 1023, row = cc >> 4, c8 = cc & 15;
            *(LAS u32x4*)(lds + tt * 16384 + KSWZ(256, row, c8 * 16)) = *(const u32x4*)(kc + (size_t)(tt * 64 + row) * 128 + c8 * 8);
            *(LAS u32x4*)(lds + 65536 + tt * 16384 + VOFF(row, c8)) = *(const u32x4*)(vc + (size_t)(tt * 64 + row) * 128 + c8 * 8); }
    }
    __syncthreads();
    bf16x8 qf[8];
#pragma unroll
    for (int ks = 0; ks < 8; ++ks) qf[ks] = *(const bf16x8*)(qrow + 16 * ks + 8 * hh);
    int ka[4], va[8]; kv_addr<128>(lane, ka, va);
    const int cq = (tok - 31) >> 4;
    float m = -1e30f, l = 0.f;
    for (int tt = 0; tt < ntile; ++tt) {
        f32x16 p0, p1; qk_tile<128>(lds + tt * 16384, ka, qf, p0, p1);
        const int dq = cq - 64 * tt - 4 * hh; float pmax = -__builtin_inff();
#pragma unroll
        for (int r = 0; r < 16; ++r) { const int c = crow(r);
            p0[r] = (dq - c >= 0) ? p0[r] * c2 : -__builtin_inff(); p1[r] = (dq - c - 32 >= 0) ? p1[r] * c2 : -__builtin_inff(); pmax = fmaxf(pmax, fmaxf(p0[r], p1[r])); }
        pmax = fmaxf(pmax, __shfl_xor(pmax, 32));
        const float mn = fmaxf(m, pmax); float ps = 0.f;
#pragma unroll
        for (int r = 0; r < 16; ++r) ps += fast_exp2(p0[r] - mn) + fast_exp2(p1[r] - mn);
        ps += __shfl_xor(ps, 32);
        l = l * fast_exp2(m - mn) + ps; m = mn;
    }
    const float invl = 1.0f / fmaxf(l, TINY);
    f32x16 o[4]; zero_o(o);
    float carry = 0.f;
    for (int tt = 0; tt < ntile; ++tt) {
        f32x16 p0, p1; qk_tile<128>(lds + tt * 16384, ka, qf, p0, p1);
        const int dq = cq - 64 * tt - 4 * hh;
#pragma unroll
        for (int r = 0; r < 16; ++r) { const int c = crow(r);
            p0[r] = (dq - c >= 0) ? fast_exp2(p0[r] * c2 - m) * invl : 0.f; p1[r] = (dq - c - 32 >= 0) ? fast_exp2(p1[r] * c2 - m) * invl : 0.f; }
        float qs[8], e3[8];
#pragma unroll
        for (int q = 0; q < 4; ++q) { qs[q] = (p0[4 * q] + p0[4 * q + 1]) + (p0[4 * q + 2] + p0[4 * q + 3]); e3[q] = p0[4 * q + 3];
                                      qs[4 + q] = (p1[4 * q] + p1[4 * q + 1]) + (p1[4 * q + 2] + p1[4 * q + 3]); e3[4 + q] = p1[4 * q + 3]; }
        float pe[8];
#pragma unroll
        for (int q = 0; q < 8; ++q) pe[q] = __shfl_xor(e3[q], 32);
#pragma unroll
        for (int q = 0; q < 8; ++q) { const float add = hh ? pe[q] : (q > 0 ? pe[q - 1] : carry); float v = qs[q] + add;
            v += __shfl_xor(v, 8); v += __shfl_xor(v, 16);
            if (gq == 0) imp[tl * 64 + 16 * tt + 2 * q + hh] = v; }
        carry = pe[7];
        pv_tile(65536 + tt * 16384, va, p0, p1, o);
    }
    const float* dg = Bf.DG + ((size_t)b * S + tok) * 24;
    out_row<true>(orow, o, dg[head], hh);
    __syncthreads();
    {
        const int srow = tid >> 3, part = tid & 7, cur = qt;
        u64 mk = 1ull | (1ull << cur); if (cur >= 1) mk |= 1ull << (cur - 1);
        const int nvalid = cur + 1, ksel = nvalid < 8 ? nvalid : 8;
        const f32x4 i0 = *(const LAS f32x4*)(imp + srow * 64 + part * 8), i1 = *(const LAS f32x4*)(imp + srow * 64 + part * 8 + 4);
        const float iv[8] = {i0[0], i0[1], i0[2], i0[3], i1[0], i1[1], i1[2], i1[3]};
        unsigned lm = (unsigned)(mk >> (part * 8)) & 0xffu;
        unsigned vm = 0u;
#pragma unroll
        for (int i = 0; i < 8; ++i) vm |= (part * 8 + i <= cur) ? (1u << i) : 0u;
        for (int have = __popcll(mk); have < ksel; ++have) {
            float bv = -__builtin_inff(); int bi = 64;
#pragma unroll
            for (int i = 0; i < 8; ++i) if (((vm & ~lm) >> i) & 1u) { if (iv[i] > bv) { bv = iv[i]; bi = part * 8 + i; } }
#pragma unroll
            for (int off = 1; off < 8; off <<= 1) { const float ov = __shfl_xor(bv, off); const int oi = __shfl_xor(bi, off); if (ov > bv || (ov == bv && oi < bi)) { bv = ov; bi = oi; } }
            mk |= 1ull << bi; if ((bi >> 3) == part) lm |= 1u << (bi & 7);
        }
        if (part == 0) { selL[srow] = mk; Bf.SEL[(size_t)(b * 2 + hk) * S + 64 * qt + srow] = mk; }
    }
    __syncthreads();
    const u64 sel = selL[tl]; u64 selu = 0ull;
    for (int i = 0; i < 64; ++i) selu |= selL[i];
    __syncthreads();
    m = -1e30f; l = 0.f; zero_o(o);
    flash<M_S>(F, qrow, kvp(Bf.KS, (size_t)b * S * 256 + hk * 128), 256, nullptr, kvp(Bf.VS, (size_t)b * S * 256 + hk * 128), 256, nullptr, 0.f,
               tok, 64 * qt + 8 * w, 64 * qt + 8 * w + 7, 0, qt + 1, sel, selu, c2, m, l, o);
    out_row<true, F8_WO1>(orow, o, dg[8 + head] / fmaxf(l, TINY), hh, F.ws + WS_O8 + (size_t)(orow - Bf.O));
}
#undef KSWZ
#undef K8SWZ
#undef K8SWZ2
#undef V8OFF
#undef VOFF
}
__device__ __forceinline__ void router_phase(const Params& P, const Frame& F, int layer, const bf16_t* h) {
    unsigned char* ws = P.ws;
    const bf16_t* wrh = (const bf16_t*)(ws + WS_WRT) + (size_t)layer * 48 * 2048; const bf16_t* wrl = wrh + 2 * 48 * 2048;
    const float* gb = P.in[I_RGB] + layer * 4; const float* eb = P.in[I_REB] + layer * 32;
    float* rstdm = (float*)(ws + WS_RSTDM); int* slote = (int*)(ws + WS_SLOTE); int* slotr = (int*)(ws + WS_SLOTR);
    int* list = (int*)(ws + WS_LIST); float* wlist = (float*)(ws + WS_WLIST); float* rlist = (float*)(ws + WS_RLIST); unsigned* cntg = F.ctl + CW_CNT + layer * 32;
    LAS float* part = (LAS float*)F.lds;
    LAS float* ssqL = part + 2 * 64 * 48;
    LAS unsigned* cl = (LAS unsigned*)(ssqL + 128);
    LAS int* asg = (LAS int*)(cl + 64);
    LAS float* asw = (LAS float*)(asg + 256);
    const int tid = F.tid, lane = F.lane, w = F.wave, tg = w & 3, kh = w >> 2, li = lane & 15, kq = lane >> 4;
    for (int blk = F.bx; blk < T / 64; blk += F.G) {
        const int tok0 = blk * 64;
        if (tid < 32) cl[tid] = 0u;
        f32x4 acc[3]; acc[0] = acc[1] = acc[2] = (f32x4){0.f, 0.f, 0.f, 0.f}; float ss = 0.f;
        const bf16_t* hp = h + (size_t)(tok0 + 16 * tg + li) * D + kh * 1024 + 8 * kq;
        const bf16_t* wph = wrh + (size_t)li * 2048 + kh * 1024 + 8 * kq; const bf16_t* wpl = wrl + (size_t)li * 2048 + kh * 1024 + 8 * kq;
#pragma unroll 4
        for (int c = 0; c < 32; ++c) {
            const u32x4 au = *(const u32x4*)(hp + 32 * c); const bf16x8 a = __builtin_bit_cast(bf16x8, au);
            float av[8]; unpack8(au, av);
#pragma unroll
            for (int e = 0; e < 8; ++e) ss += av[e] * av[e];
#pragma unroll
            for (int nb = 0; nb < 3; ++nb) {
                const bf16x8 bh = *(const bf16x8*)(wph + (size_t)nb * 16 * 2048 + 32 * c), bl = *(const bf16x8*)(wpl + (size_t)nb * 16 * 2048 + 32 * c);
                acc[nb] = __builtin_amdgcn_mfma_f32_16x16x32_bf16(a, bh, acc[nb], 0, 0, 0);
                acc[nb] = __builtin_amdgcn_mfma_f32_16x16x32_bf16(a, bl, acc[nb], 0, 0, 0);
            }
        }
        ss += __shfl_xor(ss, 16); ss += __shfl_xor(ss, 32);
#pragma unroll
        for (int nb = 0; nb < 3; ++nb)
#pragma unroll
            for (int r = 0; r < 4; ++r) part[(kh * 64 + 16 * tg + 4 * kq + r) * 48 + 16 * nb + li] = acc[nb][r];
        if (kq == 0) ssqL[kh * 64 + 16 * tg + li] = ss;
        __syncthreads();
        if (tid < 64) {
            const int t = tok0 + tid;
            const float rs = __builtin_amdgcn_rsqf((ssqL[tid] + ssqL[64 + tid]) * (1.0f / D) + EPS);
            rstdm[t] = rs; asw[256 + tid] = rs;
            float lg[4]; int gi = 0;
#pragma unroll
            for (int c = 0; c < 4; ++c) lg[c] = rs * (part[tid * 48 + c] + part[(64 + tid) * 48 + c]) + gb[c];
#pragma unroll
            for (int c = 1; c < 4; ++c) gi = lg[c] > lg[gi] ? c : gi;
            float gden = 0.f;
#pragma unroll
            for (int c = 0; c < 4; ++c) gden += __expf(lg[c] - lg[gi]);
            const float gval = 1.0f / gden;
            float el[8];
#pragma unroll
            for (int c = 0; c < 8; ++c) el[c] = rs * (part[tid * 48 + 4 + gi * 8 + c] + part[(64 + tid) * 48 + 4 + gi * 8 + c]) + eb[gi * 8 + c];
            int e0 = 0;
#pragma unroll
            for (int c = 1; c < 8; ++c) e0 = el[c] > el[e0] ? c : e0;
            int e1 = e0 == 0 ? 1 : 0;
#pragma unroll
            for (int c = 0; c < 8; ++c) e1 = (c != e0 && el[c] > el[e1]) ? c : e1;
            const float x1 = __expf(el[e1] - el[e0]);
            const float w0 = gval / (1.0f + x1), w1 = gval * x1 / (1.0f + x1);
            const int E0 = gi * 8 + e0, E1 = gi * 8 + e1;
            asg[tid * 2] = E0; asg[tid * 2 + 1] = E1; asw[tid * 2] = w0; asw[tid * 2 + 1] = w1;
            asg[128 + tid * 2] = (int)atomicAdd((unsigned*)&cl[E0], 1u); asg[128 + tid * 2 + 1] = (int)atomicAdd((unsigned*)&cl[E1], 1u);
        }
        __syncthreads();
        if (tid < 32) { const unsigned n = cl[tid]; cl[32 + tid] = n ? atomicAdd(&cntg[tid], n) : 0u; }
        __syncthreads();
        if (tid < 128) { const int t = tok0 + (tid >> 1), e = asg[tid], r = (int)cl[32 + e] + asg[128 + tid];
            list[(size_t)e * T + r] = t; wlist[(size_t)e * T + r] = asw[tid]; rlist[(size_t)e * T + r] = asw[256 + (tid >> 1)]; slote[t * 2 + (tid & 1)] = e; slotr[t * 2 + (tid & 1)] = r; }
        __syncthreads();
    }
}
__device__ __forceinline__ int moe_tables(const Frame& F, int layer) {
    volatile LAS unsigned* ord = (volatile LAS unsigned*)(F.lds + LDS_ORD);
    __syncthreads();
    if (F.tid < 64) {
        const int e = F.tid & 31;
        const unsigned n = __hip_atomic_load(F.ctl + CW_CNT + layer * 32 + e, __ATOMIC_RELAXED, __HIP_MEMORY_SCOPE_AGENT);
        const int nt = (int)((n + 255u) >> 8), nfu = (int)(n >> 8), r = (int)(n & 255u), nh = (r > 0) + (r > 128);
        int pt = nt, pf = nfu, ph = nh;
#pragma unroll
        for (int o = 1; o < 32; o <<= 1) { const int a = __shfl_up(pt, o), b = __shfl_up(pf, o), c = __shfl_up(ph, o); if ((F.tid & 31) >= o) { pt += a; pf += b; ph += c; } }
        const int tot_f = __shfl(pf, 31), tot_h = __shfl(ph, 31), tot = __shfl(pt, 31);
        if (F.tid < 32) {
            const int t0 = pt - nt;
            F.misc[MW_CNT + e] = n; F.misc[MW_TAB + e] = (unsigned)t0; if (e == 31) { F.misc[MW_TAB + NEXP] = (unsigned)tot; F.misc[MW_NORD] = (unsigned)(tot_f + tot_h); }
            for (int k = 0; k < nfu; ++k) ord[(pf - nfu) + k] = (unsigned)(t0 + k) | ((unsigned)e << 8);
            if (nh > 0) ord[tot_f + (ph - nh)] = (unsigned)(t0 + nfu) | ((unsigned)e << 8) | (1u << 16);
            if (nh > 1) ord[tot_f + (ph - nh) + 1] = (unsigned)(t0 + nfu) | ((unsigned)e << 8) | (2u << 16);
        }
    }
    __syncthreads();
    return __builtin_amdgcn_readfirstlane((int)F.misc[MW_NORD]);
}
__device__ __forceinline__ void unpack8_f8(const u32x2 w, float (&v)[8]) {
    const f32x2 a = __builtin_amdgcn_cvt_pk_f32_fp8((int)w.x, false), b = __builtin_amdgcn_cvt_pk_f32_fp8((int)w.x, true), c = __builtin_amdgcn_cvt_pk_f32_fp8((int)w.y, false), d = __builtin_amdgcn_cvt_pk_f32_fp8((int)w.y, true);
    v[0] = a[0]; v[1] = a[1]; v[2] = b[0]; v[3] = b[1]; v[4] = c[0]; v[5] = c[1]; v[6] = d[0]; v[7] = d[1]; }
template <bool F8Y>
__device__ __forceinline__ void combine_phase(const Params& P, const Frame& F, const bf16_t* hin, bf16_t* hout, unsigned char* h8) {
    unsigned char* ws = P.ws; const bf16_t* Y = (const bf16_t*)(ws + SM_Y);
    const int* slote = (const int*)(ws + WS_SLOTE); const int* slotr = (const int*)(ws + WS_SLOTR); float* rstdp = (float*)(ws + WS_RSTDP);
    const int step = F.G * 8;
    for (int t0 = F.bx * 8 + F.wave; t0 < T; t0 += 2 * step) {
        const int t1 = t0 + step; const bool two = t1 < T; const int tb = two ? t1 : t0;
        const int ea0 = slote[t0 * 2], ea1 = slote[t0 * 2 + 1], eb0 = slote[tb * 2], eb1 = slote[tb * 2 + 1];
        const size_t ra0 = (size_t)F.misc[MW_TAB + ea0] * 256 + slotr[t0 * 2], ra1 = (size_t)F.misc[MW_TAB + ea1] * 256 + slotr[t0 * 2 + 1];
        const size_t rb0 = (size_t)F.misc[MW_TAB + eb0] * 256 + slotr[tb * 2], rb1 = (size_t)F.misc[MW_TAB + eb1] * 256 + slotr[tb * 2 + 1];
        u32x4 ya0[4], ya1[4], ha[4], yb0[4], yb1[4], hb_[4];
#pragma unroll
        for (int j = 0; j < 4; ++j) { const int c = 8 * (F.lane + 64 * j);
            if (F8Y) { const unsigned char* Y8 = (const unsigned char*)Y; ya0[j].x = ((const u32x2*)(Y8 + ra0 * D + c))->x; ya0[j].y = ((const u32x2*)(Y8 + ra0 * D + c))->y; ya1[j].x = ((const u32x2*)(Y8 + ra1 * D + c))->x; ya1[j].y = ((const u32x2*)(Y8 + ra1 * D + c))->y;
                       yb0[j].x = ((const u32x2*)(Y8 + rb0 * D + c))->x; yb0[j].y = ((const u32x2*)(Y8 + rb0 * D + c))->y; yb1[j].x = ((const u32x2*)(Y8 + rb1 * D + c))->x; yb1[j].y = ((const u32x2*)(Y8 + rb1 * D + c))->y; }
            else { ya0[j] = *(const u32x4*)(Y + ra0 * D + c); ya1[j] = *(const u32x4*)(Y + ra1 * D + c); yb0[j] = *(const u32x4*)(Y + rb0 * D + c); yb1[j] = *(const u32x4*)(Y + rb1 * D + c); }
            ha[j] = *(const u32x4*)(hin + (size_t)t0 * D + c); hb_[j] = *(const u32x4*)(hin + (size_t)tb * D + c); }
        float ssa = 0.f, ssb = 0.f;
#pragma unroll
        for (int j = 0; j < 4; ++j) { const int c = 8 * (F.lane + 64 * j); const size_t o = (size_t)t0 * D + c;
            float y0[8], y1[8], v[8]; if (F8Y) { unpack8_f8((u32x2){ya0[j].x, ya0[j].y}, y0); unpack8_f8((u32x2){ya1[j].x, ya1[j].y}, y1); } else { unpack8(ya0[j], y0); unpack8(ya1[j], y1); } unpack8(ha[j], v);
#pragma unroll
            for (int e = 0; e < 8; ++e) { v[e] = F8Y ? fmaf(y0[e] + y1[e], 1.0f / F8_OSC, v[e]) : v[e] + y0[e] + y1[e]; ssa += v[e] * v[e]; }
            *(u32x4*)(hout + o) = pack8(v); if (h8) *(u32x2*)(h8 + o) = pack8_f8(v); }
        if (two) {
#pragma unroll
            for (int j = 0; j < 4; ++j) { const int c = 8 * (F.lane + 64 * j); const size_t o = (size_t)t1 * D + c;
                float y0[8], y1[8], v[8]; if (F8Y) { unpack8_f8((u32x2){yb0[j].x, yb0[j].y}, y0); unpack8_f8((u32x2){yb1[j].x, yb1[j].y}, y1); } else { unpack8(yb0[j], y0); unpack8(yb1[j], y1); } unpack8(hb_[j], v);
#pragma unroll
                for (int e = 0; e < 8; ++e) { v[e] = F8Y ? fmaf(y0[e] + y1[e], 1.0f / F8_OSC, v[e]) : v[e] + y0[e] + y1[e]; ssb += v[e] * v[e]; }
                *(u32x4*)(hout + o) = pack8(v); if (h8) *(u32x2*)(h8 + o) = pack8_f8(v); }
        }
#pragma unroll
        for (int o = 32; o > 0; o >>= 1) { ssa += __shfl_xor(ssa, o); ssb += __shfl_xor(ssb, o); }
        if (F.lane == 0) { rstdp[t0] = __builtin_amdgcn_rsqf(ssa * (1.0f / D) + EPS); if (two) rstdp[t1] = __builtin_amdgcn_rsqf(ssb * (1.0f / D) + EPS); }
    }
}
__device__ __forceinline__ void final_norm_phase(const Params& P, const Frame& F, const bf16_t* hin) {
    float* out = P.out; const float* g = P.in[I_FINN];
    const int step = F.G * 8;
    f32x4 g0[4], g1[4];
#pragma unroll
    for (int j = 0; j < 4; ++j) { const int c = 8 * (F.lane + 64 * j); g0[j] = *(const f32x4*)(g + c); g1[j] = *(const f32x4*)(g + c + 4); }
    for (int t0 = F.bx * 8 + F.wave; t0 < T; t0 += 2 * step) {
        const int t1 = t0 + step; const bool two = t1 < T; const int tb = two ? t1 : t0;
        u32x4 wa[4], wb[4];
#pragma unroll
        for (int j = 0; j < 4; ++j) { wa[j] = *(const u32x4*)(hin + (size_t)t0 * D + 8 * (F.lane + 64 * j)); wb[j] = *(const u32x4*)(hin + (size_t)tb * D + 8 * (F.lane + 64 * j)); }
#pragma unroll
        for (int k = 0; k < 2; ++k) {
            if (k == 1 && !two) break;
            const int t = k ? t1 : t0;
            float v[4][8]; float ss = 0.f;
#pragma unroll
            for (int j = 0; j < 4; ++j) { unpack8(k ? wb[j] : wa[j], v[j]);
#pragma unroll
                for (int e = 0; e < 8; ++e) ss += v[j][e] * v[j][e]; }
#pragma unroll
            for (int o = 32; o > 0; o >>= 1) ss += __shfl_xor(ss, o);
            const float rs = __builtin_amdgcn_rsqf(ss * (1.0f / D) + EPS);
#pragma unroll
            for (int j = 0; j < 4; ++j) { const int c = 8 * (F.lane + 64 * j);
                __builtin_nontemporal_store((f32x4){v[j][0] * rs * g0[j][0], v[j][1] * rs * g0[j][1], v[j][2] * rs * g0[j][2], v[j][3] * rs * g0[j][3]}, (f32x4*)(out + (size_t)t * D + c));
                __builtin_nontemporal_store((f32x4){v[j][4] * rs * g1[j][0], v[j][5] * rs * g1[j][1], v[j][6] * rs * g1[j][2], v[j][7] * rs * g1[j][3]}, (f32x4*)(out + (size_t)t * D + c + 4)); }
        }
    }
}
__device__ __forceinline__ void cumsum_seq(const Params& P, const Frame& F, int seq) {
    const float* lf = (const float*)(P.ws + S1_LF); float* cum = (float*)(P.ws + S1_CUM);
    LAS float* sc = (LAS float*)F.lds;
    const int b = seq >> 3, hd = seq & 7, tid = F.tid;
    float v[8], run = 0.f;
#pragma unroll
    for (int i = 0; i < 8; ++i) { run += lf[((size_t)b * S + tid * 8 + i) * 8 + hd]; v[i] = run; }
    sc[tid] = run; __syncthreads();
    if (tid == 0) { float r = 0.f; for (int i = 0; i < NTHR; ++i) { const float x = sc[i]; sc[i] = r; r += x; } }
    __syncthreads();
    const float base = sc[tid];
#pragma unroll
    for (int i = 0; i < 8; ++i) cum[(size_t)seq * S + tid * 8 + i] = (base + v[i]) * LOG2E;
    __syncthreads();
}
__device__ __forceinline__ int queue_next(const Frame& F, int q) {
    __syncthreads();
    if (F.tid == 0) F.misc[MW_ITEM] = atomicAdd(F.ctl + CW_QUEUE + 64 * q, 1u);
    __syncthreads();
    return __builtin_amdgcn_readfirstlane((int)F.misc[MW_ITEM]);
}
constexpr int NPHASE = 21;
constexpr int PP1_GU_V0 = 160;
__device__ __forceinline__ int pp1_gu(int G) { return G == 256 ? 2 * (256 - PP1_GU_V0) : 0; }
__device__ __forceinline__ int pp1_tail(int G) { const int nfull = ((NIN1 / 256) * (T / 256)) % G; int n = 2 * (G - nfull); const int all = (T / 256) * (D / 256); return n < all ? n : all; }
__global__ void __launch_bounds__(NTHR, 2) mega_fwd(Params P) {
    extern __shared__ __attribute__((aligned(16))) unsigned char lds_raw[];
    Frame F;
    F.lds = (LAS unsigned char*)lds_raw; F.misc = (volatile LAS unsigned*)(F.lds + LDS_MISC);
    F.tid = threadIdx.x; F.lane = F.tid & 63; F.wave = __builtin_amdgcn_readfirstlane(F.tid >> 6);
    F.G = gridDim.x; F.bx = blockIdx.x; F.vcu = (F.G % 8 == 0) ? (F.bx % 8) * (F.G / 8) + F.bx / 8 : F.bx;
    F.ws = P.ws; F.ctl = (unsigned*)(P.ws + WS_CTL);
    unsigned char* ws = P.ws;
    for (int u = F.tid; u < 256; u += NTHR) F.misc[u] = 0u;
    __syncthreads();
    const int lo = P.ph_lo, hi = P.ph_hi;
    const bool fused = (hi - lo) > 1;
    XcdBarrier bar; bar.bar = F.ctl + CW_BAR; bar.x = 0; bar.st = F.misc + MW_BAR;
    if (fused) bar = xcd_barrier_post(F.ctl + CW_BAR, F.misc + MW_BAR);
#define IN(k) (lo <= (k) && (k) < hi)
#define SEAM(k) do { if (IN((k) + 1)) xcd_barrier(bar); } while (0)
    LAS unsigned char* stage = F.lds + LDS_STAGE;
    bf16_t* hbA = (bf16_t*)(ws + WS_HBA); bf16_t* hbB = (bf16_t*)(ws + WS_HBB); unsigned char* h8A = ws + WS_H8A; unsigned char* h8B = ws + WS_H8B;
    const float* c128 = (const float*)(ws + WS_COS128); const float* s128 = (const float*)(ws + WS_SIN128);
    const float* c64 = (const float*)(ws + WS_COS64); const float* s64 = (const float*)(ws + WS_SIN64);

    if (IN(0)) { p0_prologue(P, F); SEAM(0); }

    if (IN(1)) {
        pg8::PlainOrder S; S.init(F8_IN0 ? (const bf16_t*)h8A : hbA, F8_IN0 ? D / 2 : D, (const bf16_t*)(ws + WS_WIN0T), F8_IN0 ? D / 2 : D, T, NIN0, F.G, F.bx);
        epi::In0 E{(const float*)(ws + WS_RSTD0), c128, s128, c64, s64, (bf16_t*)(ws + S0_QA), (bf16_t*)(ws + S0_KA), (bf16_t*)(ws + S0_VTA), (bf16_t*)(ws + S0_QLAT), (bf16_t*)(ws + S0_KVLAT),
                   (bf16_t*)(ws + S0_KB + (size_t)T * 1024 * (KV8 ? 1 : 2)), (float*)(ws + WS_SSQQ), (float*)(ws + WS_SSQKV)};
        pg8::gemm_phase_t<F8_IN0>(stage, F8_IN0 ? D / 2 : D, S, E, F8_SC_IN1);
        if (F.bx >= F.G / 2) p0_rest(P, F, F.bx - F.G / 2, F.G - F.G / 2);
        for (;;) { const int i = queue_next(F, 4); if (i >= (NCONV_FG - 320 + 1) / 2) break;
            Frame Fi = F; asm volatile("" : "+v"(Fi.tid), "+v"(Fi.lane));
            const int t0 = 320 + 2 * i; conv_range(P, Fi.tid, t0, 1, t0 + 2 < NCONV_FG ? t0 + 2 : NCONV_FG, -1); }
        SEAM(1);
    }
    if (IN(2)) {
        { pg8::PlainOrder S; S.init((const bf16_t*)(ws + S0_QLAT), 512, (const bf16_t*)(ws + WS_WUQT), 512, T, 1536, F.G, F.bx);
          epi::Uq E{(const float*)(ws + WS_SSQQ), c64, s64, (bf16_t*)(ws + S0_QB)};
          pg8::gemm_phase(stage, 512, S, E); }
        { pg8::PlainOrder S; S.init((const bf16_t*)(ws + S0_KVLAT), 256, (const bf16_t*)(ws + WS_WUKVT), 256, T, 2048, F.G, F.bx);
          epi::Ukv E{(const float*)(ws + WS_SSQKV), (bf16_t*)(ws + S0_KB), (bf16_t*)(ws + S0_VTB)};
          pg8::gemm_phase(stage, 256, S, E); }
        {
          pg8::PlainOrder S; S.init((const bf16_t*)(ws + WS_PB), 256, (const bf16_t*)(ws + WS_WPPT), 256, T, D, F.G, F.bx);
          const int nlo = F.G / 2, nhi = F.G - nlo, chi = (S.nwg * 3) / 4;
          if (F.bx >= nlo) S.sub(0, chi, nhi, F.bx - nlo); else S.sub(chi, S.nwg - chi, nlo, F.bx);
          epi::PlainBf16 E{(bf16_t*)(ws + WS_PP), D};
          pg8::gemm_phase(stage, 256, S, E); }
        if (F.bx == 0) {
            const float* part = (const float*)(ws + WS_SSQP); float* cb = (float*)(ws + WS_CBIAS);
            float a = 0.f;
#pragma unroll
            for (int kp = 0; kp < 64; ++kp) a += part[kp * 512 + F.tid];
            cb[F.tid] = a;
        }
        SEAM(2);
    }
    if (IN(3)) {
        const att::L0Bufs Bf{(const bf16_t*)(ws + S0_QA), (const bf16_t*)(ws + S0_KA), (const bf16_t*)(ws + S0_VTA), (const bf16_t*)(ws + S0_QB), (const bf16_t*)(ws + S0_KB), (const bf16_t*)(ws + S0_KB + (size_t)T * 1024 * (KV8 ? 1 : 2)), (const bf16_t*)(ws + S0_VTB),
                             P.in[I_SINKS], (bf16_t*)(ws + S0_O)};
        for (;;) { const int p = queue_next(F, 0); if (p >= 2560) break;
            Frame Fi = F; asm volatile("" : "+v"(Fi.tid), "+v"(Fi.lane));
            if (p < 2048) { if ((p & 3) == 0) { const int idx = p >> 2, qt = 15 - (idx >> 5), bh = idx & 31; att::item_B(Fi, Bf, bh >> 3, bh & 7, qt); }
                            else { const int cc = (p >> 2) * 3 + (p & 3) - 1; conv_range(P, Fi.tid, 4 * cc, 1, 4 * cc + 4, 0); } }
            else { const int ia = p - 2048, qt = 63 - (ia >> 3), bhk = ia & 7; att::item_A(Fi, Bf, bhk >> 1, bhk & 1, qt); } }
        SEAM(3);
    }
    if (IN(4)) {
        { pg8::PlainOrder S; S.init(F8_WO0 ? (const bf16_t*)(ws + WS_O8) : (const bf16_t*)(ws + S0_O), F8_WO0 ? D / 2 : D, (const bf16_t*)(ws + WS_WO0T), F8_WO0 ? D / 2 : D, T, D, F.G, F.bx);
          epi::Wo<true> E{P.in[I_X], hbB, F8_MOE0 ? h8B : nullptr};
          pg8::gemm_phase_t<F8_WO0>(stage, F8_WO0 ? D / 2 : D, S, E, F8_SC_WO); }
        SEAM(4);
    }
#define MOE_PLE_PHASES(PH, LAYER, HB_IN, HB_MID, HB_OUT, H8_IN, H8_MID, H8_OUT, F8M, F8P, F8Y)                                                                             \
    if (IN((PH) + 0)) { router_phase(P, F, (LAYER), (HB_IN)); SEAM((PH) + 0); }                                                                                       \
    if (IN((PH) + 1)) { const int nrt = moe_tables(F, (LAYER));                                                                                                       \
        pg8::MoeOrder<true, 4> S{(F8M) ? (const bf16_t*)(H8_IN) : (HB_IN), (const bf16_t*)(ws + WS_WGU) + (size_t)(LAYER) * 32 * 1024 * 2048, (F8M) ? D / 2 : D, (F8M) ? D / 2 : D, \
                                 (F8M) ? (size_t)1024 * 1024 : (size_t)1024 * 2048, (const int*)(ws + WS_LIST), F.misc + MW_TAB, F.misc + MW_CNT, (volatile LAS unsigned*)(F.lds + LDS_ORD), F.G, F.vcu, nrt * 4};                             \
        epi::MoeGu<F8M> E{(const float*)(ws + WS_RLIST), F.misc + MW_CNT, (bf16_t*)(ws + SM_H)};                                                                      \
        pg8::gemm_phase_t<F8M>(stage, (F8M) ? D / 2 : D, S, E, F8_SC_GU);                                                                                              \
        if ((LAYER) == 0 && pp1_gu(F.G) > 0 && F.vcu >= PP1_GU_V0) { pg8::PlainOrder S2; S2.init((const bf16_t*)(ws + WS_PB) + (size_t)T * 256, 256, (const bf16_t*)(ws + WS_WPPT) + (size_t)2048 * 256, 256, T, D, F.G, F.bx); \
            S2.sub(0, pp1_gu(F.G), F.G - PP1_GU_V0, F.vcu - PP1_GU_V0); epi::PlainBf16 E2{(bf16_t*)(ws + WS_PP1), D}; pg8::gemm_phase(stage, 256, S2, E2); }                         \
        SEAM((PH) + 1); }                                                                           \
    if (IN((PH) + 2)) { const int nrt = moe_tables(F, (LAYER));                                                                                                       \
        pg8::MoeOrder<false, 8> S{(const bf16_t*)(ws + SM_H), (const bf16_t*)(ws + WS_WDN) + (size_t)(LAYER) * 32 * 2048 * 512, (F8M) ? EH / 2 : EH, (F8M) ? EH / 2 : EH, \
                                  (size_t)2048 * 512, (const int*)(ws + WS_LIST), F.misc + MW_TAB, F.misc + MW_CNT, (volatile LAS unsigned*)(F.lds + LDS_ORD), F.G, F.vcu, nrt * 8};                             \
        epi::MoeDn<F8Y> E{(const float*)(ws + WS_WLIST), F.misc + MW_CNT, (bf16_t*)(ws + SM_Y)};                                                                           \
        pg8::gemm_phase_t<F8M>(stage, (F8M) ? EH / 2 : EH, S, E, F8_SC_DN); SEAM((PH) + 2); }                                                                         \
    if (IN((PH) + 3)) { (void)moe_tables(F, (LAYER)); combine_phase<F8Y>(P, F, (HB_IN), (HB_MID), (F8P) ? (H8_MID) : nullptr); SEAM((PH) + 3); }                           \
    if (IN((PH) + 4)) { pg8::PlainOrder S; S.init((F8P) ? (const bf16_t*)(H8_MID) : (HB_MID), (F8P) ? D / 2 : D, (const bf16_t*)(ws + WS_WPGT) + (size_t)(LAYER) * 2048 * 2048, (F8P) ? D / 2 : D, T, D, F.G, F.bx); \
        epi::Ple E{(const float*)(ws + WS_RSTDP), (const bf16_t*)(ws + ((LAYER) ? WS_PP1 : WS_PP)), (HB_MID), (HB_OUT), (LAYER) == 0 ? (float*)(ws + WS_SSQP) : (float*)nullptr, (H8_OUT)};                                 \
        pg8::gemm_phase_t<F8P>(stage, (F8P) ? D / 2 : D, S, E, F8_SC_PG); SEAM((PH) + 4); }

    MOE_PLE_PHASES(5, 0, hbB, hbA, hbB, h8B, h8A, (F8_IN1 ? h8B : nullptr), F8_MOE0, F8_PLE0, false)

    if (IN(10)) {
        pg8::PlainOrder S; S.init(F8_IN1 ? (const bf16_t*)h8B : hbB, F8_IN1 ? D / 2 : D, (const bf16_t*)(ws + WS_WIN1T), F8_IN1 ? D / 2 : D, T, NIN1, F.G, F.bx);
        epi::In1 E{(const float*)(ws + WS_SSQP), c128, s128, P.in[I_FB], (bf16_t*)(ws + S1_CQ), (bf16_t*)(ws + S1_CK), (bf16_t*)(ws + S1_CVT), (bf16_t*)(ws + S1_DQ), (bf16_t*)(ws + S1_KC), (bf16_t*)(ws + S1_VC),
                   (bf16_t*)(ws + S1_KS), (bf16_t*)(ws + S1_VST), (bf16_t*)(ws + S1_KW), (bf16_t*)(ws + S1_VWT), (float*)(ws + S1_LF), (float*)(ws + S1_DG)};
        pg8::gemm_phase_t<F8_IN1>(stage, F8_IN1 ? D / 2 : D, S, E, F8_SC_IN1);
        {
          const int nfull = S.nwg % F.G;
          if (nfull > 0) {
              pg8::PlainOrder S2; S2.init((const bf16_t*)(ws + WS_PB) + (size_t)T * 256, 256, (const bf16_t*)(ws + WS_WPPT) + (size_t)2048 * 256, 256, T, D, F.G, F.bx);
              S2.sub(pp1_gu(F.G), pp1_tail(F.G), F.G - nfull, F.bx >= nfull ? F.bx - nfull : -1);
              epi::PlainBf16 E2{(bf16_t*)(ws + WS_PP1), D};
              pg8::gemm_phase(stage, 256, S2, E2); } }
        SEAM(10);
    }
    const att::L1Bufs B1{(const bf16_t*)(ws + S1_CQ), (const bf16_t*)(ws + S1_CK), (const bf16_t*)(ws + S1_CVT), (const bf16_t*)(ws + S1_DQ), (const bf16_t*)(ws + S1_KS), (const bf16_t*)(ws + S1_VST),
                         (const bf16_t*)(ws + S1_KW), (const bf16_t*)(ws + S1_VWT), (const bf16_t*)(ws + S1_KCMP), (const bf16_t*)(ws + S1_VCMPT), (const float*)(ws + S1_CUM), (const float*)(ws + S1_DG),
                         (u64*)(ws + S1_SEL), (bf16_t*)(ws + S1_O)};
    if (IN(11)) {
        const int cv = (F.bx + F.G - 16) % F.G;
        { pg8::HalfOrder S{(const bf16_t*)(ws + S1_KC), (const bf16_t*)(ws + WS_WC1KT), F8_CMP ? 1024 : 2048, 16, F.G, F.bx};
          epi::Cmp1<true> E{(const float*)(ws + WS_CBIAS), (bf16_t*)(ws + S1_HID)};
          pg8::gemm_phase_t<F8_CMP>(stage, F8_CMP ? 2048 : 4096, S, E, F8_SC_IN1); }
        { pg8::HalfOrder S{(const bf16_t*)(ws + S1_VC), (const bf16_t*)(ws + WS_WC1VT), F8_CMP ? 1024 : 2048, 16, F.G, cv};
          epi::Cmp1<true> E{(const float*)(ws + WS_CBIAS) + 256, (bf16_t*)(ws + S1_HID) + (size_t)2048 * 256};
          pg8::gemm_phase_t<F8_CMP>(stage, F8_CMP ? 2048 : 4096, S, E, F8_SC_IN1); }
        if (F.bx < 32) { asm volatile("s_waitcnt vmcnt(0)" ::: "memory"); __syncthreads(); __builtin_amdgcn_fence(__ATOMIC_ACQUIRE, "agent"); asm volatile("s_waitcnt vmcnt(0)" ::: "memory"); __syncthreads(); }
        { pg8::HalfOrder S{(const bf16_t*)(ws + S1_HID), (const bf16_t*)(ws + WS_WC2KT), 256, 16, F.G, F.bx};
          epi::Cmp2<true, true> E{c128, s128, (bf16_t*)(ws + S1_KCMP)};
          pg8::gemm_phase(stage, 256, S, E); }
        { pg8::HalfOrder S{(const bf16_t*)(ws + S1_HID) + (size_t)2048 * 256, (const bf16_t*)(ws + WS_WC2VT), 256, 16, F.G, cv};
          epi::Cmp2<false, true> E{c128, s128, (bf16_t*)(ws + S1_VCMPT)};
          pg8::gemm_phase(stage, 256, S, E); }
        if (F.bx >= 32 && F.bx < 64) cumsum_seq(P, F, F.bx - 32);
        if (F.bx >= 32) {
          pg8::PlainOrder S; S.init((const bf16_t*)(ws + WS_PB) + (size_t)T * 256, 256, (const bf16_t*)(ws + WS_WPPT) + (size_t)2048 * 256, 256, T, D, F.G - 32, F.bx - 32);
          { const int done = pp1_gu(F.G) + (((NIN1 / 256) * (T / 256)) % F.G > 0 ? pp1_tail(F.G) : 0); S.sub(done, S.nwg - done, F.G - 32, F.bx - 32); }
          epi::PlainBf16 E{(bf16_t*)(ws + WS_PP1), D};
          pg8::gemm_phase(stage, 256, S, E); }
        for (;;) { const int idx = queue_next(F, 1); if (idx >= 512) break;
            Frame Fi = F; asm volatile("" : "+v"(Fi.tid), "+v"(Fi.lane));
            const int qt = 63 - (idx >> 3), bhk = idx & 7; att::item_W(Fi, B1, bhk >> 1, bhk & 1, qt); }
        SEAM(11);
    }
    if (IN(13)) {
        for (;;) { const int p = queue_next(F, 2); if (p >= 2560) break;
            Frame Fi = F; asm volatile("" : "+v"(Fi.tid), "+v"(Fi.lane));
            if (p < 2048 && (p & 3) != 0) { const int cc = (p >> 2) * 3 + (p & 3) - 1; conv_range(P, Fi.tid, 4 * cc, 1, 4 * cc + 4, 1); }
            else { const int idx = p < 2048 ? (p >> 2) : 512 + (p - 2048); const int k = idx >> 1;
                if (!(idx & 1)) { const int qt = 15 - (k >> 5), bh = k & 31; att::item_C(Fi, B1, bh >> 3, bh & 7, qt); }
                else { const int qt = 63 - (k >> 3), bhk = k & 7; att::item_S(Fi, B1, bhk >> 1, bhk & 1, qt); } } }
        SEAM(13);
    }
    if (IN(14)) {
        { pg8::PlainOrder S; S.init(F8_WO1 ? (const bf16_t*)(ws + WS_O8) : (const bf16_t*)(ws + S1_O), F8_WO1 ? D / 2 : D, (const bf16_t*)(ws + WS_WO1T), F8_WO1 ? D / 2 : D, T, D, F.G, F.bx);
          epi::Wo<false> E{hbB, hbA, F8_MOE1 ? h8A : nullptr};
          pg8::gemm_phase_t<F8_WO1>(stage, F8_WO1 ? D / 2 : D, S, E, F8_SC_WO); }
        SEAM(14);
    }
    MOE_PLE_PHASES(15, 1, hbA, hbB, hbA, h8A, h8B, ((unsigned char*)nullptr), F8_MOE1, F8_PLE1, F8_Y1)
    if (IN(20)) { final_norm_phase(P, F, hbA); }
#undef IN
#undef SEAM
}

extern "C" void kernel_launch(void* const* d_in, const int* in_sizes, int n_in, void* d_out, int out_size, void* d_ws, size_t ws_size, hipStream_t stream) {
    static int grid = 0;
    if (grid == 0) {
        if (n_in != 32 || out_size != T * D || ws_size < WS_END) { fprintf(stderr, "kernel_launch: unexpected problem (n_in %d, out %d, ws %zu < %zu)\n", n_in, out_size, ws_size, (size_t)WS_END); grid = -1; return; }
        int dev = 0, cus = 0, per_cu = 0;
        if (hipGetDevice(&dev) != hipSuccess || hipDeviceGetAttribute(&cus, hipDeviceAttributeMultiprocessorCount, dev) != hipSuccess) { grid = -1; return; }
        if (hipFuncSetAttribute((const void*)mega_fwd, hipFuncAttributeMaxDynamicSharedMemorySize, LDS_BYTES) != hipSuccess) { fprintf(stderr, "kernel_launch: hipFuncSetAttribute failed\n"); grid = -1; return; }
        if (hipOccupancyMaxActiveBlocksPerMultiprocessor(&per_cu, (const void*)mega_fwd, NTHR, LDS_BYTES) != hipSuccess || per_cu < 1) fprintf(stderr, "kernel_launch: occupancy query says %d\n", per_cu);
        (void)hipGetLastError();
        grid = cus;
    }
    if (grid < 0) return;
    (void)in_sizes;
    if (hipMemsetAsync((char*)d_ws + WS_CTL, 0, CTL_BYTES, stream) != hipSuccess) return;
    Params p{};
    for (int i = 0; i < 32; ++i) p.in[i] = (const float*)d_in[i];
    p.out = (float*)d_out; p.ws = (unsigned char*)d_ws;
    p.ph_lo = 0; p.ph_hi = NPHASE;
    hipLaunchKernelGGL(mega_fwd, dim3(grid), dim3(NTHR), LDS_BYTES, stream, p);
}
```

```cpp
#include <hip/hip_runtime.h>
#include <stdint.h>
#include <stdio.h>

#define LAS __attribute__((address_space(3)))
typedef unsigned short bf16_t;
typedef short bf16x8 __attribute__((ext_vector_type(8)));
typedef float f32x4 __attribute__((ext_vector_type(4)));
typedef float f32x2 __attribute__((ext_vector_type(2)));
typedef float f32x16 __attribute__((ext_vector_type(16)));
typedef unsigned u32x4 __attribute__((ext_vector_type(4)));
typedef unsigned u32x2 __attribute__((ext_vector_type(2)));
typedef unsigned long long u64;
typedef int i32x4 __attribute__((ext_vector_type(4)));
typedef int i32x8 __attribute__((ext_vector_type(8)));

constexpr int T = 16384, D = 2048, NB = 4, S = 4096;
constexpr int EVEN_IN = 2368, ODD_IN = 5664;
constexpr int NIN0 = 2560, NIN1 = 5888;
constexpr int NEXP = 32, EH = 512;
constexpr int MAXRT = 160;
constexpr float EPS = 1e-6f;
constexpr bool F8_IN0 = true, F8_MOE0 = false, F8_PLE0 = true, F8_IN1 = true, F8_MOE1 = true, F8_PLE1 = true, F8_WO0 = true, F8_WO1 = true;
constexpr float F8_OSC = 16.f;
constexpr bool F8_CMP = true;
constexpr bool F8_Y1 = true;
constexpr bool KVDMA = true;
constexpr bool KV8 = true;
constexpr bool PV8 = true;
constexpr bool QK8 = true;
constexpr float LOG2E = 1.4426950408889634f;
constexpr int NTHR = 512;

constexpr size_t al256(size_t x) { return (x + 255) & ~(size_t)255; }
constexpr size_t WS_CTL = 0;
constexpr size_t CTL_BYTES = 65536;
constexpr size_t WS_WIN0T = WS_CTL + CTL_BYTES;
constexpr size_t WS_WUQT = WS_WIN0T + (size_t)NIN0 * 2048 * 2;
constexpr size_t WS_WUKVT = WS_WUQT + (size_t)1536 * 512 * 2;
constexpr size_t WS_WO0T = WS_WUKVT + (size_t)2048 * 256 * 2;
constexpr size_t WS_WIN1T = WS_WO0T + (size_t)2048 * 2048 * 2;
constexpr size_t WS_WC1KT = WS_WIN1T + (size_t)NIN1 * 2048 * 2;
constexpr size_t WS_WC1VT = WS_WC1KT + (size_t)256 * 4096 * 2;
constexpr size_t WS_WC2KT = WS_WC1VT + (size_t)256 * 4096 * 2;
constexpr size_t WS_WC2VT = WS_WC2KT + (size_t)256 * 256 * 2;
constexpr size_t WS_WO1T = WS_WC2VT + (size_t)256 * 256 * 2;
constexpr size_t WS_WPPT = WS_WO1T + (size_t)2048 * 2048 * 2;
constexpr size_t WS_WPGT = WS_WPPT + (size_t)2 * 2048 * 256 * 2;
constexpr size_t WS_WGU = WS_WPGT + (size_t)2 * 2048 * 2048 * 2;
constexpr size_t WS_WGU1 = WS_WGU + (size_t)32 * 1024 * 2048 * 2;
constexpr size_t WS_PP1 = WS_WGU1 + (size_t)32 * 1024 * 2048;
static_assert(F8_MOE1, "WS_PP1 lives in the space the fp8 layer-1 expert weights leave free");
constexpr size_t WS_WDN = WS_WGU + (size_t)2 * 32 * 1024 * 2048 * 2;
constexpr size_t WS_WRT = WS_WDN + (size_t)2 * 32 * 2048 * 512 * 2;
constexpr size_t WS_CBIAS = WS_WRT + (size_t)2 * 48 * 2048 * 4;
constexpr size_t WS_COS128 = WS_CBIAS + 2 * 256 * 4;
constexpr size_t WS_SIN128 = WS_COS128 + (size_t)T * 64 * 4;
constexpr size_t WS_COS64 = WS_SIN128 + (size_t)T * 64 * 4;
constexpr size_t WS_SIN64 = WS_COS64 + (size_t)T * 32 * 4;
constexpr size_t WS_HBA = WS_SIN64 + (size_t)T * 32 * 4;
constexpr size_t WS_HBB = WS_HBA + (size_t)(T + 256) * 2048 * 2;
constexpr size_t WS_PB = WS_HBB + (size_t)(T + 256) * 2048 * 2;
constexpr size_t WS_PP = WS_PB + (size_t)2 * T * 256 * 2;
constexpr size_t WS_RSTD0 = WS_PP + (size_t)T * 2048 * 2;
constexpr size_t WS_RSTDM = WS_RSTD0 + (size_t)T * 4;
constexpr size_t WS_RSTDP = WS_RSTDM + (size_t)(T + 64) * 4;
constexpr size_t WS_SSQP = WS_RSTDP + (size_t)T * 4;
constexpr size_t WS_SSQQ = WS_SSQP + (size_t)T * 32 * 4;
constexpr size_t WS_SSQKV = WS_SSQQ + (size_t)T * 8 * 4;
constexpr size_t WS_SLOTE = WS_SSQKV + (size_t)T * 4 * 4;
constexpr size_t WS_SLOTR = WS_SLOTE + (size_t)T * 2 * 4;
constexpr size_t WS_LIST = WS_SLOTR + (size_t)T * 2 * 4;
constexpr size_t WS_WLIST = WS_LIST + (size_t)32 * T * 4;
constexpr size_t WS_RLIST = WS_WLIST + (size_t)32 * T * 4;
constexpr size_t WS_H8A = al256(WS_RLIST + (size_t)32 * T * 4);
constexpr size_t WS_H8B = WS_H8A + (size_t)(T + 256) * 2048;
constexpr size_t WS_O8 = WS_H8B + (size_t)(T + 256) * 2048;
constexpr size_t WS_SCR = al256(WS_O8 + (size_t)T * 2048);
constexpr size_t S0_QA = WS_SCR;
constexpr size_t S0_KA = S0_QA + (size_t)T * 1024 * 2;
constexpr size_t S0_VTA = S0_KA + (size_t)T * 256 * 2;
constexpr size_t S0_QLAT = S0_VTA + (size_t)T * 256 * 2;
constexpr size_t S0_KVLAT = S0_QLAT + (size_t)T * 512 * 2;
constexpr size_t S0_QB = S0_KVLAT + (size_t)T * 256 * 2;
constexpr size_t S0_KB = S0_QB + (size_t)T * 1536 * 2;
constexpr size_t S0_VTB = S0_KB + (size_t)T * 1536 * 2;
constexpr size_t S0_O = S0_VTB + (size_t)T * 1024 * 2;
constexpr size_t S0_END = S0_O + (size_t)T * 2048 * 2;
constexpr size_t SM_H = WS_SCR;
constexpr size_t SM_Y = SM_H + (size_t)MAXRT * 256 * 512 * 2;
constexpr size_t SM_END = SM_Y + (size_t)MAXRT * 256 * 2048 * 2;
constexpr size_t S1_CQ = WS_SCR;
constexpr size_t S1_CK = S1_CQ + (size_t)T * 1024 * 2;
constexpr size_t S1_CVT = S1_CK + (size_t)T * 1024 * 2;
constexpr size_t S1_DQ = S1_CVT + (size_t)T * 1024 * 2;
constexpr size_t S1_KC = S1_DQ + (size_t)T * 1024 * 2;
constexpr size_t S1_VC = S1_KC + (size_t)T * 256 * 2 + 8192;
constexpr size_t S1_KS = S1_VC + (size_t)T * 256 * 2 + 8192;
constexpr size_t S1_VST = S1_KS + (size_t)T * 256 * 2;
constexpr size_t S1_KW = S1_VST + (size_t)T * 256 * 2;
constexpr size_t S1_VWT = S1_KW + (size_t)T * 256 * 2;
constexpr size_t S1_LF = S1_VWT + (size_t)T * 256 * 2;
constexpr size_t S1_CUM = S1_LF + (size_t)T * 8 * 4;
constexpr size_t S1_DG = S1_CUM + (size_t)T * 8 * 4;
constexpr size_t S1_HID = S1_DG + (size_t)T * 24 * 4;
constexpr size_t S1_KCMP = S1_HID + (size_t)2 * 2048 * 256 * 2;
constexpr size_t S1_VCMPT = S1_KCMP + (size_t)8 * 256 * 128 * 2;
constexpr size_t S1_SEL = S1_VCMPT + (size_t)8 * 128 * 256 * 2;
constexpr size_t S1_O = al256(S1_SEL + (size_t)8 * S * 8);
constexpr size_t S1_END = S1_O + (size_t)T * 2048 * 2;
constexpr size_t cmax3(size_t a, size_t b, size_t c) { return a > b ? (a > c ? a : c) : (b > c ? b : c); }
constexpr size_t WS_END = cmax3(S0_END, SM_END, S1_END);

constexpr int CW_BAR = 0;
constexpr int CW_CNT = 4096;
constexpr int CW_QUEUE = 4224;
constexpr int CW_DBG = 8192;

constexpr int LDS_STAGE = 0;
constexpr int LDS_IMP = 131072;
constexpr int LDS_SEL = LDS_IMP + 16384;
constexpr int LDS_MISC = LDS_SEL + 512;
constexpr int LDS_RS = LDS_MISC + 1024;
constexpr int LDS_ORD = LDS_RS + 1024;
constexpr int LDS_BYTES = LDS_ORD + 1024;
constexpr int MW_BAR = 0;
constexpr int MW_ITEM = 8;
constexpr int MW_TAB = 16;
constexpr int MW_CNT = 64;
constexpr int MW_NORD = 96;

struct Params { const float* in[32]; float* out; unsigned char* ws; int ph_lo, ph_hi; };

enum { I_X = 0, I_P, I_POS, I_ABWIN, I_SINKS, I_QLN, I_KVLN, I_WUQ, I_WUKV, I_ABWO, I_CDWIN, I_FB, I_PEK, I_W1K, I_W2K, I_PEV, I_W1V, I_W2V, I_CDWO,
       I_MIXN, I_MOEN, I_RGW, I_RGB, I_REW, I_REB, I_EWG, I_EWU, I_EWD, I_PLEP, I_PLEN, I_PLEG, I_FINN };

__device__ __forceinline__ unsigned cvt_pk(float lo, float hi) { unsigned r; asm volatile("v_cvt_pk_bf16_f32 %0, %1, %2" : "=v"(r) : "v"(lo), "v"(hi)); return r; }
__device__ __forceinline__ u32x4 pack8(const float (&v)[8]) { u32x4 w; w.x = cvt_pk(v[0], v[1]); w.y = cvt_pk(v[2], v[3]); w.z = cvt_pk(v[4], v[5]); w.w = cvt_pk(v[6], v[7]); return w; }
__device__ __forceinline__ u32x2 pack8_f8(const float (&v)[8]) {
    int a = __builtin_amdgcn_cvt_pk_fp8_f32(v[0], v[1], __float_as_int(v[0]), false); a = __builtin_amdgcn_cvt_pk_fp8_f32(v[2], v[3], a, true);
    int b = __builtin_amdgcn_cvt_pk_fp8_f32(v[4], v[5], __float_as_int(v[4]), false); b = __builtin_amdgcn_cvt_pk_fp8_f32(v[6], v[7], b, true); u32x2 w; w.x = (unsigned)a; w.y = (unsigned)b; return w; }
__device__ __forceinline__ float bf2f(unsigned short b) { return __uint_as_float(((unsigned)b) << 16); }
__device__ __forceinline__ bf16_t f2bf(float f) { return (bf16_t)(cvt_pk(f, 0.f) & 0xffffu); }
__device__ __forceinline__ void unpack8(const u32x4 w, float (&v)[8]) {
    v[0] = __uint_as_float(w.x << 16); v[1] = __uint_as_float(w.x & 0xffff0000u); v[2] = __uint_as_float(w.y << 16); v[3] = __uint_as_float(w.y & 0xffff0000u);
    v[4] = __uint_as_float(w.z << 16); v[5] = __uint_as_float(w.z & 0xffff0000u); v[6] = __uint_as_float(w.w << 16); v[7] = __uint_as_float(w.w & 0xffff0000u); }
__device__ __forceinline__ float fast_exp2(float x) { return __builtin_amdgcn_exp2f(x); }
__device__ __forceinline__ float fast_rcp(float x) { return __builtin_amdgcn_rcpf(x); }
__device__ __forceinline__ float sigmoidf_(float x) { return fast_rcp(1.0f + fast_exp2(-x * LOG2E)); }
__device__ __forceinline__ int perm32(int rho) { const int n = rho >> 4, i = rho & 15; return 8 * (i >> 2) + 4 * n + (i & 3); }
__device__ __forceinline__ int kperm16(int x) { return (x & 3) | ((x & 4) << 1) | ((x & 8) >> 1); }
__device__ __forceinline__ int vpos(int s) { return (s & ~15) | kperm16(s & 15); }

struct Frame {
    LAS unsigned char* lds; volatile LAS unsigned* misc; unsigned* ctl; unsigned char* ws;
    int tid, lane, wave, G, bx, vcu;
};
#define XB_TMO      128
#define XB_XCNT(j)  (256  + 64 * (j))
#define XB_XSUB(j)  (1280 + 64 * (j))
#define XB_XGEN(j)  (2304 + 64 * (j))
#define XB_TOP      3328
#define XB_TOPGEN   3392
#define XCD_BAR_WORDS 3456
#define XB_SPIN_CAP (1u << 18)

__device__ __forceinline__ unsigned xb_ld(unsigned* p)              { return __hip_atomic_load(p, __ATOMIC_RELAXED, __HIP_MEMORY_SCOPE_AGENT); }
__device__ __forceinline__ unsigned xb_add(unsigned* p, unsigned v) { return __hip_atomic_fetch_add(p, v, __ATOMIC_RELAXED, __HIP_MEMORY_SCOPE_AGENT); }
__device__ __forceinline__ unsigned xb_xcc_id() { return (unsigned)__builtin_amdgcn_s_getreg((3 << 11) | 20) & 0xFu; }
#define XB_SPIN(cond, bar) do { unsigned _sp = 0; while (cond) { __builtin_amdgcn_s_sleep(1); \
    if ((++_sp & 255u) == 0u) { if (xb_ld(&(bar)[XB_TMO])) break; if (_sp > XB_SPIN_CAP) { atomicAdd(&(bar)[XB_TMO], 1u); break; } } } } while (0)

struct XcdBarrier {
    unsigned* bar; unsigned x;
    volatile LAS unsigned* st;
};

__device__ __forceinline__ XcdBarrier xcd_barrier_post(unsigned* bar, volatile LAS unsigned* st) {
    XcdBarrier b; b.bar = bar; b.x = xb_xcc_id(); b.st = st;
    if (threadIdx.x == 0) (void)xb_add(&bar[XB_XCNT(b.x)], 1u);
    return b;
}
__device__ __forceinline__ void xcd_barrier_complete(unsigned* bar, unsigned x, unsigned& nloc, unsigned& nx) {
    const unsigned G = gridDim.x * gridDim.y * gridDim.z;
    unsigned sum, cnt, mine, sp = 0u;
    for (;;) {
        sum = 0u; cnt = 0u; mine = 0u;
#pragma unroll
        for (unsigned j = 0; j < 16; ++j) { const unsigned c = xb_ld(&bar[XB_XCNT(j)]); sum += c; cnt += (c > 0u) ? 1u : 0u; mine = (j == x) ? c : mine; }
        if (sum == G) break;
        __builtin_amdgcn_s_sleep(1);
        if ((++sp & 255u) == 0u) { if (xb_ld(&bar[XB_TMO])) break; if (sp > XB_SPIN_CAP) { atomicAdd(&bar[XB_TMO], 1u); break; } }
    }
    nloc = mine > 0u ? mine : 1u; nx = cnt > 0u ? cnt : 1u;
}

__device__ __forceinline__ void xcd_barrier(const XcdBarrier& b) {
    asm volatile("s_waitcnt vmcnt(0)" ::: "memory");
    __syncthreads();
    if (threadIdx.x == 0) {
        unsigned* bar = b.bar;
        __builtin_amdgcn_s_waitcnt(0);
        unsigned nloc = b.st[0], nx = b.st[1];
        if (nloc == 0u) { xcd_barrier_complete(bar, b.x, nloc, nx); b.st[0] = nloc; b.st[1] = nx; }
        const unsigned old = xb_add(&bar[XB_XSUB(b.x)], 1u);
        const unsigned gen = old / nloc;
        if (old + 1u == (gen + 1u) * nloc) {
            __builtin_amdgcn_fence(__ATOMIC_RELEASE, "agent");
            asm volatile("s_waitcnt vmcnt(0)" ::: "memory");
            const unsigned og = xb_add(&bar[XB_TOP], 1u);
            const unsigned tg = og / nx;
            if (og + 1u == (tg + 1u) * nx) xb_add(&bar[XB_TOPGEN], 1u);
            else XB_SPIN(xb_ld(&bar[XB_TOPGEN]) == tg, bar);
            __builtin_amdgcn_fence(__ATOMIC_ACQUIRE, "agent");
            xb_add(&bar[XB_XGEN(b.x)], 1u);
            asm volatile("s_waitcnt vmcnt(0)" ::: "memory");
        } else {
            XB_SPIN(xb_ld(&bar[XB_XGEN(b.x)]) == gen, bar);
            __builtin_amdgcn_fence(__ATOMIC_ACQUIRE, "agent");
            asm volatile("s_waitcnt vmcnt(0)" ::: "memory");
        }
    }
    __syncthreads();
}

enum { CK_PLAIN = 0, CK_IN0, CK_UQ, CK_UKV, CK_IN1, CK_CMP2K, CK_GU, CK_PLAIN128 };
struct ConvJob { const float* src; const float* src2; const float* gain; bf16_t* dst; int K, ldn, nrows, kind; float f8; };

__device__ __forceinline__ int rope_pair_col(int q, int base, int pl) { const int bj = q >> 7, qq = q & 127; return base + (2 * pl + (qq >> 6)) * 128 + (qq & 63) + 64 * bj; }
__device__ __forceinline__ int colmap(int kind, int n) {
    const int pn = n >> 8, q = n & 255;
    switch (kind) {
    case CK_PLAIN: return n;
    case CK_PLAIN128: return n < 128 ? n : -1;
    case CK_IN0:
        if (pn < 4) return rope_pair_col(q, 0, pn);
        if (pn == 4) return rope_pair_col(q, 1024, 0);
        if (pn == 5) return 1280 + q;
        if (pn < 8) return 1536 + (pn - 6) * 256 + q;
        if (pn == 8) return 2048 + q;
        { const int bj = q >> 7, qq = q & 127; return qq < 32 ? 2304 + qq + 32 * bj : -1; }
    case CK_UQ:
        if (n < 1024) return (n >> 7) * 192 + (n & 127);
        { const int n2 = n - 1024, r = n2 >> 8, q2 = n2 & 255, bj = q2 >> 7, qq = q2 & 127; return (4 * r + (qq >> 5)) * 192 + 128 + (qq & 31) + 32 * bj; }
    case CK_UKV:
        if (n < 1024) return (n >> 7) * 256 + (n & 127);
        { const int n2 = n - 1024; return (n2 >> 7) * 256 + 128 + (n2 & 127); }
    case CK_IN1:
        if (pn < 12) return n;
        if (pn < 16) return rope_pair_col(q, 3080, pn - 12);
        if (pn == 16) return 4104 + q;
        if (pn == 17) return 4360 + q;
        if (pn == 18) return rope_pair_col(q, 4616, 0);
        if (pn == 19) return 4872 + q;
        if (pn == 20) return rope_pair_col(q, 5128, 0);
        if (pn == 21) return 5384 + q;
        return q < 8 ? 3072 + q : (q < 32 ? 5640 + q - 8 : -1);
    case CK_CMP2K: { const int bj = q >> 7, qq = q & 127; return (n < 256 && qq < 64) ? qq + 64 * bj : -1; }
    case CK_GU: return q < 128 ? 128 * pn + q : ((128 * pn + q - 128) | (1 << 20));
    }
    return -1;
}

constexpr float F8_WGU = 64.f, F8_WDN = 32.f, F8_WPG = 64.f, F8_WIN1 = 64.f;
constexpr unsigned F8_SC_GU = 127 - 6, F8_SC_DN = 127 - 5, F8_SC_PG = 127 - 6, F8_SC_IN1 = 127 - 6, F8_SC_WO = 127 - 6 - 4;
constexpr int NFIXJOB = 14, NFIXTILE = 2360, NGUTILE = 128, NDNTILE = 64, NCONVTILE = NFIXTILE + 64 * NGUTILE + 64 * NDNTILE;
__device__ __forceinline__ void get_job(const Params& P, int tile, ConvJob& J, int& lt) {
    unsigned char* ws = P.ws;
    J.src2 = nullptr; J.gain = nullptr; J.f8 = 0.f;
    if (tile >= NFIXTILE) {
        int t2 = tile - NFIXTILE;
        if (t2 < 64 * NGUTILE) { const int le = t2 / NGUTILE; lt = t2 % NGUTILE; const int l = le >> 5;
            J.src = P.in[I_EWG] + (size_t)le * 2048 * 512; J.src2 = P.in[I_EWU] + (size_t)le * 2048 * 512; J.gain = P.in[I_MOEN] + l * 2048;
            J.dst = l ? (bf16_t*)(ws + WS_WGU1 + (size_t)(le - 32) * 1024 * 2048) : (bf16_t*)(ws + WS_WGU) + (size_t)le * 1024 * 2048; J.K = 2048; J.ldn = 512; J.nrows = 1024; J.kind = CK_GU; J.f8 = (l ? F8_MOE1 : F8_MOE0) ? F8_WGU : 0.f; return; }
        t2 -= 64 * NGUTILE; { const int le = t2 / NDNTILE; lt = t2 % NDNTILE;
            J.src = P.in[I_EWD] + (size_t)le * 512 * 2048; J.dst = (bf16_t*)(ws + WS_WDN) + (size_t)le * 2048 * 512; J.K = 512; J.ldn = 2048; J.nrows = 2048; J.kind = CK_PLAIN; J.f8 = ((le >> 5) ? F8_MOE1 : F8_MOE0) ? F8_WDN : 0.f; return; }
    }
    const int ft[NFIXJOB] = {320, 48, 32, 256, 736, 64, 64, 4, 4, 256, 32, 32, 256, 256};
    int j = 0, base = 0; bool found = false;
#pragma unroll
    for (int i = 0; i < NFIXJOB; ++i) { if (!found) { if (tile < base + ft[i]) { found = true; j = i; } else base += ft[i]; } }
    lt = tile - base;
    switch (j) {
    case 0: J.src = P.in[I_ABWIN]; J.gain = P.in[I_MIXN]; J.dst = (bf16_t*)(ws + WS_WIN0T); J.K = 2048; J.ldn = EVEN_IN; J.nrows = NIN0; J.kind = CK_IN0; J.f8 = F8_IN0 ? F8_WIN1 : 0.f; break;
    case 1: J.src = P.in[I_WUQ]; J.gain = P.in[I_QLN]; J.dst = (bf16_t*)(ws + WS_WUQT); J.K = 512; J.ldn = 1536; J.nrows = 1536; J.kind = CK_UQ; break;
    case 2: J.src = P.in[I_WUKV]; J.gain = P.in[I_KVLN]; J.dst = (bf16_t*)(ws + WS_WUKVT); J.K = 256; J.ldn = 2048; J.nrows = 2048; J.kind = CK_UKV; break;
    case 3: J.src = P.in[I_ABWO]; J.dst = (bf16_t*)(ws + WS_WO0T); J.K = 2048; J.ldn = 2048; J.nrows = 2048; J.kind = CK_PLAIN; J.f8 = F8_WO0 ? F8_WIN1 : 0.f; break;
    case 4: J.src = P.in[I_CDWIN]; J.gain = P.in[I_MIXN] + 2048; J.dst = (bf16_t*)(ws + WS_WIN1T); J.K = 2048; J.ldn = ODD_IN; J.nrows = NIN1; J.kind = CK_IN1; J.f8 = F8_IN1 ? F8_WIN1 : 0.f; break;
    case 5: J.src = P.in[I_W1K]; J.dst = (bf16_t*)(ws + WS_WC1KT); J.K = 4096; J.ldn = 256; J.nrows = 256; J.kind = CK_PLAIN; J.f8 = F8_CMP ? F8_WIN1 : 0.f; break;
    case 6: J.src = P.in[I_W1V]; J.dst = (bf16_t*)(ws + WS_WC1VT); J.K = 4096; J.ldn = 256; J.nrows = 256; J.kind = CK_PLAIN; J.f8 = F8_CMP ? F8_WIN1 : 0.f; break;
    case 7: J.src = P.in[I_W2K]; J.dst = (bf16_t*)(ws + WS_WC2KT); J.K = 256; J.ldn = 128; J.nrows = 256; J.kind = CK_CMP2K; break;
    case 8: J.src = P.in[I_W2V]; J.dst = (bf16_t*)(ws + WS_WC2VT); J.K = 256; J.ldn = 128; J.nrows = 256; J.kind = CK_PLAIN128; break;
    case 9: J.src = P.in[I_CDWO]; J.dst = (bf16_t*)(ws + WS_WO1T); J.K = 2048; J.ldn = 2048; J.nrows = 2048; J.kind = CK_PLAIN; J.f8 = F8_WO1 ? F8_WIN1 : 0.f; break;
    case 10: case 11: J.src = P.in[I_PLEP] + (size_t)(j - 10) * 256 * 2048; J.dst = (bf16_t*)(ws + WS_WPPT) + (size_t)(j - 10) * 2048 * 256; J.K = 256; J.ldn = 2048; J.nrows = 2048; J.kind = CK_PLAIN; break;
    default: J.src = P.in[I_PLEG] + (size_t)(j - 12) * 2048 * 2048; J.gain = P.in[I_PLEN] + (j - 12) * 2048; J.dst = (bf16_t*)(ws + WS_WPGT) + (size_t)(j - 12) * 2048 * 2048; J.K = 2048; J.ldn = 2048; J.nrows = 2048; J.kind = CK_PLAIN; J.f8 = ((j == 13) ? F8_PLE1 : F8_PLE0) ? F8_WPG : 0.f; break;
    }
}

struct ConvRegs { f32x4 v[8]; f32x4 g0, g1; };
__device__ __forceinline__ void conv_load(const ConvJob& J, int lt, int tid, ConvRegs& R) {
    const int kt = J.K >> 8, tn = lt / kt, tk = lt % kt;
    const int n0 = tn * 64, k0 = tk * 256;
    const int g = tid & 15, kc = tid >> 4;
    const int r = n0 + 4 * g;
    const int nat = (r & ~31) + perm32(r & 31);
    int col = colmap(J.kind, nat);
    const float* src = J.src;
    if (col >= 0 && (col & (1 << 20))) { src = J.src2; col &= ~(1 << 20); }
    const int kb = k0 + 8 * kc;
#pragma unroll
    for (int e = 0; e < 8; ++e) R.v[e] = (col >= 0) ? __builtin_nontemporal_load((const f32x4*)(src + (size_t)(kb + e) * J.ldn + col)) : (f32x4){0.f, 0.f, 0.f, 0.f};
    if (J.gain) { R.g0 = *(const f32x4*)(J.gain + kb); R.g1 = *(const f32x4*)(J.gain + kb + 4); } else { R.g0 = (f32x4){1.f, 1.f, 1.f, 1.f}; R.g1 = R.g0; }
}
__device__ __forceinline__ void conv_store(const ConvJob& J, int lt, int tid, const ConvRegs& R) {
    const int kt = J.K >> 8, tn = lt / kt, tk = lt % kt;
    const int n0 = tn * 64, k0 = tk * 256;
    const int g = tid & 15, kc = tid >> 4;
    const int r = n0 + 4 * g, kb = k0 + 8 * kc;
    if (J.f8 != 0.f) {
#pragma unroll
        for (int i = 0; i < 4; i += 2) {
            float o0[8], o1[8];
#pragma unroll
            for (int e = 0; e < 4; ++e) { o0[e] = R.v[e][i] * R.g0[e] * J.f8; o0[e + 4] = R.v[e + 4][i] * R.g1[e] * J.f8; o1[e] = R.v[e][i + 1] * R.g0[e] * J.f8; o1[e + 4] = R.v[e + 4][i + 1] * R.g1[e] * J.f8; }
            const u32x2 pa = pack8_f8(o0), pb = pack8_f8(o1);
            const auto rx = __builtin_amdgcn_permlane16_swap(pa.x, pb.x, false, false); const auto ry = __builtin_amdgcn_permlane16_swap(pa.y, pb.y, false, false);
            unsigned char* d0 = (unsigned char*)J.dst + (size_t)(r + i) * J.K + kb;
            *(u32x4*)((kc & 1) ? d0 + J.K - 8 : d0) = (u32x4){rx[0], ry[0], rx[1], ry[1]};
        }
        return;
    }
#pragma unroll
    for (int i = 0; i < 4; ++i) {
        float o[8];
#pragma unroll
        for (int e = 0; e < 4; ++e) { o[e] = R.v[e][i] * R.g0[e]; o[e + 4] = R.v[e + 4][i] * R.g1[e]; }
        *(u32x4*)(J.dst + (size_t)(r + i) * J.K + kb) = pack8(o);
    }
}

__device__ __forceinline__ void sincos_rev(float ang, float& c, float& s) {
    const double rev = (double)ang * 0.15915494309189535;
    const float fr = (float)(rev - __builtin_rint(rev));
    c = __builtin_amdgcn_cosf(fr); s = __builtin_amdgcn_sinf(fr);
}

constexpr int NCONV_FG = NFIXTILE, NCHUNK_L = (32 * NGUTILE + 32 * NDNTILE) / 4;
__device__ __forceinline__ int conv_tile_id(int i, int layer) {
    if (layer < 0) return i;
    return i < 32 * NGUTILE ? NFIXTILE + layer * 32 * NGUTILE + i : NFIXTILE + 64 * NGUTILE + layer * 32 * NDNTILE + (i - 32 * NGUTILE);
}
__device__ __forceinline__ void conv_range(const Params& P, int tid, int first, int stride, int n, int layer) {
    for (int i = first; i < n; i += 2 * stride) {
        ConvJob J0, J1; int lt0, lt1 = 0; ConvRegs R0, R1; const bool two = i + stride < n;
        get_job(P, conv_tile_id(i, layer), J0, lt0); conv_load(J0, lt0, tid, R0);
        if (two) { get_job(P, conv_tile_id(i + stride, layer), J1, lt1); conv_load(J1, lt1, tid, R1); }
        conv_store(J0, lt0, tid, R0);
        if (two) conv_store(J1, lt1, tid, R1);
    }
}
__device__ __forceinline__ void p0_prologue(const Params& P, const Frame& F) {
    unsigned char* ws = P.ws;
    const int tid = F.tid, G = F.G;
    conv_range(P, tid, F.bx, G, 320, -1);
    {
        const float* x = P.in[I_X]; bf16_t* hb = (bf16_t*)(ws + WS_HBA); float* rstd0 = (float*)(ws + WS_RSTD0);
        const int step = G * 8;
        for (int t0 = F.bx * 8 + F.wave; t0 < T; t0 += 2 * step) {
            const int t1 = t0 + step; const bool two = t1 < T; const int tb = two ? t1 : t0;
            f32x4 va[8], vb[8];
#pragma unroll
            for (int j = 0; j < 8; ++j) { const int c = 4 * (F.lane + 64 * j); va[j] = *(const f32x4*)(x + (size_t)t0 * D + c); vb[j] = *(const f32x4*)(x + (size_t)tb * D + c); }
            float ssa = 0.f, ssb = 0.f;
#pragma unroll
            for (int j = 0; j < 8; ++j) { const int c = 4 * (F.lane + 64 * j);
                { const f32x4 v = va[j]; ssa += v[0] * v[0] + v[1] * v[1] + v[2] * v[2] + v[3] * v[3];
                  if (!F8_IN0) { u32x2 w; w.x = cvt_pk(v[0], v[1]); w.y = cvt_pk(v[2], v[3]); *(u32x2*)(hb + (size_t)t0 * D + c) = w; }
                  if (F8_IN0) { int q = __float_as_int(v[0]); q = __builtin_amdgcn_cvt_pk_fp8_f32(v[0], v[1], q, false); q = __builtin_amdgcn_cvt_pk_fp8_f32(v[2], v[3], q, true); *(int*)(ws + WS_H8A + (size_t)t0 * D + c) = q; } }
                if (two) { const f32x4 v = vb[j]; ssb += v[0] * v[0] + v[1] * v[1] + v[2] * v[2] + v[3] * v[3];
                  if (!F8_IN0) { u32x2 w; w.x = cvt_pk(v[0], v[1]); w.y = cvt_pk(v[2], v[3]); *(u32x2*)(hb + (size_t)t1 * D + c) = w; }
                  if (F8_IN0) { int q = __float_as_int(v[0]); q = __builtin_amdgcn_cvt_pk_fp8_f32(v[0], v[1], q, false); q = __builtin_amdgcn_cvt_pk_fp8_f32(v[2], v[3], q, true); *(int*)(ws + WS_H8A + (size_t)t1 * D + c) = q; } } }
#pragma unroll
            for (int o = 32; o > 0; o >>= 1) { ssa += __shfl_xor(ssa, o); ssb += __shfl_xor(ssb, o); }
            if (F.lane == 0) { rstd0[t0] = __builtin_amdgcn_rsqf(ssa * (1.0f / D) + EPS); if (two) rstd0[t1] = __builtin_amdgcn_rsqf(ssb * (1.0f / D) + EPS); }
        }
    }
    const int gtid = F.bx * NTHR + tid, gn = G * NTHR;
    { const int* pos = (const int*)P.in[I_POS]; float* c128 = (float*)(ws + WS_COS128); float* s128 = (float*)(ws + WS_SIN128); float* c64 = (float*)(ws + WS_COS64); float* s64 = (float*)(ws + WS_SIN64);
      for (int i = gtid; i < T * 96; i += gn) {
          const int t = i / 96, r = i % 96; const float pf = (float)pos[t];
          if (r < 64) { const float inv = 1.0f / fast_exp2((float)(2 * r) * (1.0f / 128.0f) * 13.287712379549449f); float c, s; sincos_rev(pf * inv, c, s); c128[t * 64 + r] = c; s128[t * 64 + r] = s; }
          else { const int q = r - 64; const float inv = 1.0f / fast_exp2((float)(2 * q) * (1.0f / 64.0f) * 13.287712379549449f); float c, s; sincos_rev(pf * inv, c, s); c64[t * 32 + q] = c; s64[t * 32 + q] = s; }
      } }
}
__device__ __forceinline__ void p0_rest(const Params& P, const Frame& F, int w, int nw) {
    unsigned char* ws = P.ws; const int tid = F.tid;
    const int gtid = w * NTHR + tid, gn = nw * NTHR;
    { const float* p = P.in[I_P]; bf16_t* pb = (bf16_t*)(ws + WS_PB);
      for (int i = gtid; i < 2 * T * 256 / 4; i += gn) { const f32x4 v = *(const f32x4*)(p + (size_t)i * 4); u32x2 w; w.x = cvt_pk(v[0], v[1]); w.y = cvt_pk(v[2], v[3]); *(u32x2*)(pb + (size_t)i * 4) = w; } }
    { bf16_t* wh = (bf16_t*)(ws + WS_WRT); bf16_t* wl = wh + 2 * 48 * 2048;
      for (int i = gtid; i < 2 * 48 * 2048; i += gn) { const int l = i / (48 * 2048), c = (i / 2048) % 48, k = i % 2048; const float g = P.in[I_MOEN][l * 2048 + k];
          float w = 0.f; if (c < 4) w = P.in[I_RGW][((size_t)l * 2048 + k) * 4 + c]; else if (c < 36) w = P.in[I_REW][((size_t)l * 2048 + k) * 32 + (c - 4)];
          w *= g; const bf16_t h = f2bf(w); wh[i] = h; wl[i] = f2bf(w - bf2f(h)); } }
    { float* part = (float*)(ws + WS_SSQP);
      for (int i = gtid; i < 64 * 512; i += gn) { const int kp = i >> 9, z = (i >> 8) & 1, n = i & 255; const float* pe = P.in[z ? I_PEV : I_PEK]; const float* w1 = P.in[z ? I_W1V : I_W1K];
          float a = 0.f;
#pragma unroll 16
          for (int k = kp * 64; k < kp * 64 + 64; ++k) a += pe[k] * w1[(size_t)k * 256 + n];
          part[i] = a; } }
    { u32x4* z0 = (u32x4*)(ws + WS_HBA + (size_t)T * D * 2); u32x4* z1 = (u32x4*)(ws + WS_HBB + (size_t)T * D * 2);
      for (int i = gtid; i < 256 * D * 2 / 16; i += gn) { z0[i] = (u32x4){0u, 0u, 0u, 0u}; z1[i] = (u32x4){0u, 0u, 0u, 0u}; }
      u32x4* z8a = (u32x4*)(ws + WS_H8A + (size_t)T * D); u32x4* z8b = (u32x4*)(ws + WS_H8B + (size_t)T * D);
      for (int i = gtid; i < 256 * D / 16; i += gn) { z8a[i] = (u32x4){0u, 0u, 0u, 0u}; z8b[i] = (u32x4){0u, 0u, 0u, 0u}; }
      float* rm = (float*)(ws + WS_RSTDM); if (gtid < 64) rm[T + gtid] = 0.f; }
}
namespace pg8 {
constexpr int BM = 256, BK = 64, HALF = 128, HTB = HALF * BK * 2, STAGE_BYTES = 8 * HTB, NXCD = 8, WGM = 8;
__device__ __forceinline__ int lds_byte(int r, int c) { const int st = (r >> 4) * 2 + (c >> 5), rr = r & 15, cc = c & 31, ob = rr * 64 + cc * 2; return st * 1024 + (ob ^ (((ob >> 9) & 1) << 5)); }
__device__ __forceinline__ void stage_rc(int b, int& R, int& C) { const int st = b / 1024, sb = b % 1024, swz = sb ^ (((sb >> 9) & 1) << 5); R = (st >> 1) * 16 + swz / 64; C = (st & 1) * 32 + (swz % 64) / 2; }

struct Unit { int pm, pn, e, r0, half, ro; };

struct PlainOrder {
    static constexpr bool DYN_A = false, HALF = false;
    const bf16_t* A; const bf16_t* Bt; int lda, K; int nM, nN, nwg, G, c, lo, cnt;
    __device__ __forceinline__ void init(const bf16_t* A_, int lda_, const bf16_t* Bt_, int K_, int M, int N, int G_, int c_) { A = A_; Bt = Bt_; lda = lda_; K = K_; nM = M / BM; nN = N / BM; nwg = nM * nN; G = G_; c = c_; lo = 0; cnt = nwg; }
    __device__ __forceinline__ void sub(int lo_, int cnt_, int G_, int c_) { lo = lo_; cnt = cnt_; G = G_; c = c_ < 0 ? cnt_ : c_; }
    __device__ __forceinline__ bool next(int i, Unit& u) const {
        const long L = (long)i * G + c; if (L >= cnt) return false;
        int wgid = lo + (int)L; { const int q = nwg / NXCD, r = nwg % NXCD, xcd = wgid % NXCD, off = wgid / NXCD; wgid = (xcd < r ? xcd * (q + 1) : r * (q + 1) + (xcd - r) * q) + off; }
        const int nig = WGM * nN, gid = wgid / nig, fm = gid * WGM, gsz = (nM - fm) < WGM ? (nM - fm) : WGM;
        u.pm = fm + ((wgid % nig) % gsz); u.pn = (wgid % nig) / gsz; u.e = 0; u.r0 = 0; u.half = 0; u.ro = 0; return true;
    }
    __device__ __forceinline__ const char* a_base(const Unit& u) const { return (const char*)(A + (size_t)u.pm * BM * lda); }
    __device__ __forceinline__ const char* b_base(const Unit& u) const { return (const char*)(Bt + (size_t)u.pn * BM * K); }
    __device__ __forceinline__ unsigned a_row_off(const Unit&, int r) const { return (unsigned)r * (unsigned)lda * 2u; }
};

struct HalfOrder {
    static constexpr bool DYN_A = false, HALF = true;
    const bf16_t* A; const bf16_t* Bt; int lda, nU, G, c;
    __device__ __forceinline__ bool next(int i, Unit& u) const { const long L = (long)i * G + c; if (L >= nU) return false; u.pm = (int)L; u.pn = 0; u.e = 0; u.r0 = (int)L * 128; u.half = 1; u.ro = 0; return true; }
    __device__ __forceinline__ const char* a_base(const Unit& u) const { return (const char*)(A + (size_t)u.pm * 128 * lda); }
    __device__ __forceinline__ const char* b_base(const Unit&) const { return (const char*)Bt; }
    __device__ __forceinline__ unsigned a_row_off(const Unit&, int r) const { return (unsigned)r * (unsigned)lda * 2u; }
};

template <bool GATHER, int NPN> struct MoeOrder {
    static constexpr bool DYN_A = GATHER, HALF = true;
    const bf16_t* A; const bf16_t* Bt; int lda, K; size_t bstride;
    const int* list; volatile LAS unsigned* tab; volatile LAS unsigned* cnt; volatile LAS unsigned* ord; int G, c, U;
    __device__ __forceinline__ bool next(int i, Unit& u) const {
        const int L = i * G + c; if (L >= U) return false;
        u.pn = L % NPN; const int w = __builtin_amdgcn_readfirstlane((int)ord[L / NPN]);
        const int rt = w & 255, e = (w >> 8) & 31, kind = w >> 16; u.half = kind != 0; u.ro = kind == 2 ? 128 : 0;
        u.e = e; u.pm = rt; u.r0 = __builtin_amdgcn_readfirstlane((rt - (int)tab[e]) * BM) + u.ro; return true;
    }
    __device__ __forceinline__ const char* a_base(const Unit& u) const { return GATHER ? (const char*)A : (const char*)(A + ((size_t)u.pm * BM + u.ro) * lda); }
    __device__ __forceinline__ const char* b_base(const Unit& u) const { return (const char*)(Bt + (size_t)u.e * bstride + (size_t)u.pn * BM * K); }
    __device__ __forceinline__ unsigned a_row_off(const Unit& u, int r) const {
        if (GATHER) { const int gr = u.r0 + r; const int tok = (gr < __builtin_amdgcn_readfirstlane((int)cnt[u.e])) ? list[(size_t)u.e * T + gr] : T; return (unsigned)tok * (unsigned)lda * 2u; }
        return (unsigned)r * (unsigned)lda * 2u;
    }
};

template <bool F8, class Epi, class Sched>
__device__ __forceinline__ void gemm_phase_t(LAS unsigned char* lds, const int K, const Sched& S, const Epi& E, const unsigned f8scale) {
    const int tid = threadIdx.x, wid = __builtin_amdgcn_readfirstlane(tid >> 6), lane = tid & 63, wr = wid >> 2, wc = wid & 3, fr = lane & 15, fq = lane >> 4;
    const int nt = K / BK;
    unsigned voffB[2];
#pragma unroll
    for (int i = 0; i < 2; ++i) { int R, C; stage_rc(tid * 16 + i * 8192, R, C); voffB[i] = (unsigned)(R * K + C) * 2u; }
    const size_t kstep = (size_t)(BK * 2);
    const size_t hstepB = (size_t)HALF * K * 2;
    const unsigned ldsw = (unsigned)wid * 1024u;
    const int aoff = lds_byte(wr * 64 + fr, fq * 8), boff = lds_byte(wc * 32 + fr, fq * 8);
#define PG8_SA(b, h) (((b) * 2 + (h)) * HTB)
#define PG8_SB(b, h) ((4 + (b) * 2 + (h)) * HTB)
#define PG8_STAGE(bufoff, gbase, voff) do { _Pragma("unroll") for (int _i = 0; _i < 2; ++_i) \
        __builtin_amdgcn_global_load_lds((const unsigned*)((const char*)(gbase) + (voff)[_i]), (LAS unsigned*)(lds + (bufoff) + ldsw + _i * 8192), 16, 0, 0); } while (0)
#define PG8_LD8(p) __builtin_shufflevector(*(const LAS i32x4*)(p), *(const LAS i32x4*)((p) + 1024), 0, 1, 2, 3, 4, 5, 6, 7)
#define PG8_LDA(dst, b, h) do { if (F8) { _Pragma("unroll") for (int m = 0; m < 4; ++m) dst##8[m] = PG8_LD8(lds + PG8_SA(b, h) + aoff + m * 2048); } else { \
        _Pragma("unroll") for (int m = 0; m < 4; ++m) _Pragma("unroll") for (int k = 0; k < 2; ++k) dst[m][k] = *(const LAS bf16x8*)(lds + PG8_SA(b, h) + aoff + m * 2048 + k * 1024); } } while (0)
#define PG8_LDB(dst, b, h) do { if (F8) { _Pragma("unroll") for (int n = 0; n < 2; ++n) dst##8[n] = PG8_LD8(lds + PG8_SB(b, h) + boff + n * 2048); } else { \
        _Pragma("unroll") for (int n = 0; n < 2; ++n) _Pragma("unroll") for (int k = 0; k < 2; ++k) dst[n][k] = *(const LAS bf16x8*)(lds + PG8_SB(b, h) + boff + n * 2048 + k * 1024); } } while (0)
#define PG8_MMA(ai, bj, At, Bt) do { __builtin_amdgcn_s_setprio(1); if (F8) { _Pragma("unroll") for (int m = 0; m < 4; ++m) _Pragma("unroll") for (int n = 0; n < 2; ++n) \
        acc[ai][bj][m][n] = __builtin_amdgcn_mfma_scale_f32_16x16x128_f8f6f4(Bt##8[n], At##8[m], acc[ai][bj][m][n], 0, 0, 0, (int)f8sc, 0, 0x7f7f7f7f); \
        _Pragma("unroll") for (int m = 0; m < 4; ++m) _Pragma("unroll") for (int n = 0; n < 2; ++n) asm volatile("" : "+v"(acc[ai][bj][m][n])); } else { \
        _Pragma("unroll") for (int m = 0; m < 4; ++m) _Pragma("unroll") for (int n = 0; n < 2; ++n) _Pragma("unroll") for (int k = 0; k < 2; ++k) \
        acc[ai][bj][m][n] = __builtin_amdgcn_mfma_f32_16x16x32_bf16(Bt[n][k], At[m][k], acc[ai][bj][m][n], 0, 0, 0); } __builtin_amdgcn_s_setprio(0); } while (0)
#define PG8_WAIT_V(n) asm volatile("s_waitcnt vmcnt(" #n ")" ::: "memory")
#define PG8_WAIT_L(n) asm volatile("s_waitcnt lgkmcnt(" #n ")" ::: "memory")
#define PG8_BAR __builtin_amdgcn_s_barrier()
#define PG8_SCHED __builtin_amdgcn_sched_barrier(0)
#define PG8_AOFF(dst, u) do { int _t = tid; asm volatile("" : "+v"(_t)); _Pragma("unroll") for (int _i = 0; _i < 2; ++_i) { int _R, _C; stage_rc(_t * 16 + _i * 8192, _R, _C); _Pragma("unroll") for (int _h = 0; _h < 2; ++_h) dst[_h][_i] = S.a_row_off(u, _h * HALF + _R) + (unsigned)_C * 2u; } } while (0)
    Unit cur, nxt; int ui = 0;
    if (!S.next(0, cur)) return;
    f32x4 acc[2][2][4][2];
#pragma unroll
    for (int a = 0; a < 2; ++a)
#pragma unroll
        for (int b = 0; b < 2; ++b)
#pragma unroll
            for (int m = 0; m < 4; ++m)
#pragma unroll
                for (int n = 0; n < 2; ++n) acc[a][b][m][n] = (f32x4){0.f, 0.f, 0.f, 0.f};
    bf16x8 At[4][2], B0[2][2], B1[2][2]; i32x8 At8[4], B08[2], B18[2]; const unsigned f8sc = f8scale * 0x01010101u;
    unsigned offA[2][2];
    PG8_AOFF(offA, cur);
    const char* cA = S.a_base(cur); const char* cB = S.b_base(cur);
    PG8_STAGE(PG8_SB(0, 0), cB, voffB); PG8_STAGE(PG8_SB(0, 1), cB + hstepB, voffB); PG8_STAGE(PG8_SA(0, 0), cA, offA[0]); PG8_STAGE(PG8_SA(0, 1), cA, offA[1]);
    if (wr == 1) PG8_BAR;
    PG8_WAIT_V(2); PG8_BAR;
    PG8_STAGE(PG8_SB(1, 0), cB + kstep, voffB); PG8_STAGE(PG8_SA(1, 0), cA + kstep, offA[0]); PG8_STAGE(PG8_SB(1, 1), cB + hstepB + kstep, voffB);
    PG8_WAIT_V(6); PG8_BAR;
#pragma unroll 1
    for (;;) {
        const bool has_next = S.next(ui + 1, nxt);
        const char* nA = has_next ? S.a_base(nxt) : cA; const char* nB = has_next ? S.b_base(nxt) : cB;
        const bool hf = Sched::HALF && cur.half != 0;
#pragma unroll 1
        for (int t = 0; t < nt; t += 2) {
            const bool last = (t == nt - 2);
            const char* a1 = cA + (size_t)(t + 1) * kstep;
            const char* a2 = last ? nA : cA + (size_t)(t + 2) * kstep; const char* b2 = last ? nB : cB + (size_t)(t + 2) * kstep;
            const char* a3 = a2 + kstep; const char* b3 = b2 + kstep;
            PG8_LDB(B0, 0, 0); PG8_LDB(B1, 0, 1); PG8_SCHED; PG8_LDA(At, 0, 0); PG8_STAGE(PG8_SA(1, 1), a1, offA[1]);
            PG8_WAIT_V(8); PG8_WAIT_L(0); PG8_BAR; PG8_MMA(0, 0, At, B0); PG8_MMA(0, 1, At, B1); PG8_BAR; PG8_SCHED;
            if (Sched::DYN_A && last && has_next) PG8_AOFF(offA, nxt);
            if (!hf) PG8_LDA(At, 0, 1); PG8_STAGE(PG8_SB(0, 0), b2, voffB); PG8_STAGE(PG8_SB(0, 1), b2 + hstepB, voffB); PG8_STAGE(PG8_SA(0, 0), a2, offA[0]);
            PG8_WAIT_V(8); PG8_WAIT_L(0); PG8_BAR; if (!hf) { PG8_MMA(1, 0, At, B0); PG8_MMA(1, 1, At, B1); } PG8_BAR; PG8_SCHED;
            PG8_LDB(B0, 1, 0); PG8_LDB(B1, 1, 1); PG8_SCHED; PG8_LDA(At, 1, 0); PG8_STAGE(PG8_SA(0, 1), a2, offA[1]);
            PG8_WAIT_V(8); PG8_WAIT_L(0); PG8_BAR; PG8_MMA(0, 0, At, B0); PG8_MMA(0, 1, At, B1); PG8_BAR; PG8_SCHED;
            if (!hf) PG8_LDA(At, 1, 1); PG8_STAGE(PG8_SB(1, 0), b3, voffB); PG8_STAGE(PG8_SB(1, 1), b3 + hstepB, voffB); PG8_STAGE(PG8_SA(1, 0), a3, offA[0]);
            PG8_WAIT_V(8); PG8_WAIT_L(0); PG8_BAR; if (!hf) { PG8_MMA(1, 0, At, B0); PG8_MMA(1, 1, At, B1); } PG8_BAR; PG8_SCHED;
        }
        if (wr == 0) PG8_BAR;
        { int efr = fr, efq = fq; asm volatile("" : "+v"(efr), "+v"(efq));
          E(acc, cur, wr, wc, efr, efq); }
        if (!has_next) break;
#pragma unroll
        for (int a = 0; a < 2; ++a)
#pragma unroll
            for (int b = 0; b < 2; ++b)
#pragma unroll
                for (int m = 0; m < 4; ++m)
#pragma unroll
                    for (int n = 0; n < 2; ++n) acc[a][b][m][n] = (f32x4){0.f, 0.f, 0.f, 0.f};
        cur = nxt; cA = nA; cB = nB; ++ui;
        if (wr == 1) PG8_BAR;
    }
    PG8_WAIT_V(0);
    PG8_BAR;
#undef PG8_SA
#undef PG8_SB
#undef PG8_STAGE
#undef PG8_LDA
#undef PG8_LD8
#undef PG8_LDB
#undef PG8_MMA
#undef PG8_WAIT_V
#undef PG8_WAIT_L
#undef PG8_BAR
#undef PG8_SCHED
#undef PG8_AOFF
}
template <class Epi, class Sched>
__device__ __forceinline__ void gemm_phase(LAS unsigned char* lds, const int K, const Sched& S, const Epi& E) { gemm_phase_t<false>(lds, K, S, E, 0u); }
template <class Epi, class Sched>
__device__ __forceinline__ void gemm_phase_f8(LAS unsigned char* lds, const int K2, const Sched& S, const Epi& E, const unsigned f8scale) { gemm_phase_t<true>(lds, K2, S, E, f8scale); }
}
namespace epi {
using pg8::Unit;
typedef const f32x4 (&Acc)[2][2][4][2];
#define EPI_ROWL(ai, m) ((ai) * 128 + wr * 64 + (m) * 16 + fr)
#define EPI_ROW(u, ai, m) ((u).pm * 256 + EPI_ROWL(ai, m))
#define EPI_GET8(v, ai, bj, m, sc) do { _Pragma("unroll") for (int _e = 0; _e < 4; ++_e) { v[_e] = acc[ai][bj][m][0][_e] * (sc); v[4 + _e] = acc[ai][bj][m][1][_e] * (sc); } } while (0)

template <class RD, class FL, class FC>
__device__ __forceinline__ void epi_pipe_n(int ng, FL load, FC comp) {
    RD d[2][2];
    load(0, 0, d[0][0]); load(0, 1, d[0][1]);
#pragma unroll
    for (int g = 0; g < 4; ++g) {
        if (g < ng) {
            if (g < 3 && g + 1 < ng) { const int g2 = g + 1; load(g2 >> 1, (g2 & 1) * 2, d[g2 & 1][0]); load(g2 >> 1, (g2 & 1) * 2 + 1, d[g2 & 1][1]); }
            __builtin_amdgcn_sched_barrier(0);
            comp(g >> 1, (g & 1) * 2, d[g & 1][0]); comp(g >> 1, (g & 1) * 2 + 1, d[g & 1][1]);
            __builtin_amdgcn_sched_barrier(0);
        }
    }
}
template <class RD, class FL, class FC>
__device__ __forceinline__ void epi_pipe(FL load, FC comp) {
    RD d[2][2];
    load(0, 0, d[0][0]); load(0, 1, d[0][1]);
#pragma unroll
    for (int g = 0; g < 4; ++g) {
        if (g < 3) { const int g2 = g + 1; load(g2 >> 1, (g2 & 1) * 2, d[g2 & 1][0]); load(g2 >> 1, (g2 & 1) * 2 + 1, d[g2 & 1][1]); }
        __builtin_amdgcn_sched_barrier(0);
        comp(g >> 1, (g & 1) * 2, d[g & 1][0]); comp(g >> 1, (g & 1) * 2 + 1, d[g & 1][1]);
        __builtin_amdgcn_sched_barrier(0);
    }
}
template <class RD, class FL, class FC>
__device__ __forceinline__ void epi_pipe1(FL load, FC comp) {
    RD d[2];
    load(0, 0, d[0]);
#pragma unroll
    for (int g = 0; g < 8; ++g) {
        if (g < 7) { const int g2 = g + 1; load(g2 >> 2, g2 & 3, d[g2 & 1]); }
        __builtin_amdgcn_sched_barrier(0);
        comp(g >> 2, g & 3, d[g & 1]);
        __builtin_amdgcn_sched_barrier(0);
    }
}
__device__ __forceinline__ void store8(bf16_t* p, const float (&v)[8]) { *(u32x4*)p = pack8(v); }

struct RdS { float rs; };
struct RdRope { float rs; f32x4 c0, c1, s0, s1; };
__device__ __forceinline__ void rope8(const float (&x1)[8], const float (&x2)[8], const RdRope& d, float (&y1)[8], float (&y2)[8]) {
#pragma unroll
    for (int e = 0; e < 8; ++e) { const float c = e < 4 ? d.c0[e] : d.c1[e - 4], s = e < 4 ? d.s0[e] : d.s1[e - 4]; y1[e] = x1[e] * c - x2[e] * s; y2[e] = x2[e] * c + x1[e] * s; }
}
__device__ __forceinline__ void ld_rope(RdRope& d, const float* cs, const float* sn) { d.c0 = *(const f32x4*)cs; d.c1 = *(const f32x4*)(cs + 4); d.s0 = *(const f32x4*)sn; d.s1 = *(const f32x4*)(sn + 4); }

__device__ __forceinline__ bf16_t* kvw(bf16_t* base, size_t el) { return (bf16_t*)((unsigned char*)base + el * (KV8 ? 1 : 2)); }
__device__ __forceinline__ void store8_f8(unsigned char* p, const float (&v)[8]) { *(u32x2*)p = pack8_f8(v); }
__device__ __forceinline__ void store16_f8w(unsigned char* p0, unsigned char* p1, int fq, const float (&v0)[8], const float (&v1)[8]) {
    const u32x2 a = pack8_f8(v0), b = pack8_f8(v1);
    const auto rx = __builtin_amdgcn_permlane16_swap(a.x, b.x, false, false); const auto ry = __builtin_amdgcn_permlane16_swap(a.y, b.y, false, false);
    *(u32x4*)((fq & 1) ? p1 - 8 : p0) = (u32x4){rx[0], ry[0], rx[1], ry[1]};
}
template <bool F8 = false, class RS>
__device__ __forceinline__ void rope128_tile(Acc acc, const Unit& u, int wr, int wc, int fr, int fq, RS rsf, const float* c128, const float* s128, bf16_t* dst, int ld) {
    const int qq = 32 * wc + 8 * fq, hl = qq >> 6, i0 = qq & 63;
    epi_pipe1<RdRope>([&](int ai, int m, RdRope& d) { const int row = EPI_ROW(u, ai, m); d.rs = rsf(ai, m, row); ld_rope(d, c128 + (size_t)row * 64 + i0, s128 + (size_t)row * 64 + i0); },
                     [&](int ai, int m, const RdRope& d) { const int row = EPI_ROW(u, ai, m);
                         float x1[8], x2[8], y1[8], y2[8]; EPI_GET8(x1, ai, 0, m, d.rs); EPI_GET8(x2, ai, 1, m, d.rs); rope8(x1, x2, d, y1, y2);
                         if (F8) { unsigned char* p = (unsigned char*)dst + (size_t)row * ld + hl * 128 + i0; store16_f8w(p, p + 64, fq, y1, y2); }
                         else { bf16_t* p = dst + (size_t)row * ld + hl * 128 + i0; store8(p, y1); store8(p + 64, y2); } });
}
template <bool F8 = false, class RS>
__device__ __forceinline__ void plain_tile(Acc acc, const Unit& u, int wr, int wc, int fr, int fq, RS rsf, bf16_t* dst, int ld) {
    const int q0 = 32 * wc + 8 * fq;
    epi_pipe<RdS>([&](int ai, int m, RdS& d) { d.rs = rsf(ai, m, EPI_ROW(u, ai, m)); },
                  [&](int ai, int m, const RdS& d) { const int row = EPI_ROW(u, ai, m);
                      if (F8) { float v0[8], v1[8]; EPI_GET8(v0, ai, 0, m, d.rs); EPI_GET8(v1, ai, 1, m, d.rs); unsigned char* p = (unsigned char*)dst + (size_t)row * ld + q0; store16_f8w(p, p + 128, fq, v0, v1); }
                      else {
#pragma unroll
                      for (int bj = 0; bj < 2; ++bj) { float v[8]; EPI_GET8(v, ai, bj, m, d.rs); store8(dst + (size_t)row * ld + bj * 128 + q0, v); } } });
}
template <class RS>
__device__ __forceinline__ void plain_ssq_tile(Acc acc, const Unit& u, int wr, int wc, int fr, int fq, RS rsf, bf16_t* dst, int ld, float* ssq, int nslot, int slot0) {
    const int q0 = 32 * wc + 8 * fq;
    epi_pipe<RdS>([&](int ai, int m, RdS& d) { d.rs = rsf(ai, m, EPI_ROW(u, ai, m)); },
                  [&](int ai, int m, const RdS& d) { const int row = EPI_ROW(u, ai, m); float ss = 0.f;
#pragma unroll
                      for (int bj = 0; bj < 2; ++bj) { float v[8]; EPI_GET8(v, ai, bj, m, d.rs);
#pragma unroll
                          for (int e = 0; e < 8; ++e) ss += v[e] * v[e];
                          store8(dst + (size_t)row * ld + bj * 128 + q0, v); }
                      ss += __shfl_xor(ss, 16); ss += __shfl_xor(ss, 32);
                      if (fq == 0) ssq[(size_t)row * nslot + slot0 + wc] = ss; });
}
template <class RS>
__device__ __forceinline__ void vt_tile(Acc acc, const Unit& u, int wr, int wc, int fr, int fq, RS rsf, bf16_t* vt, int nh) {
    const int q0 = 32 * wc + 8 * fq;
    epi_pipe<RdS>([&](int ai, int m, RdS& d) { d.rs = rsf(ai, m, EPI_ROW(u, ai, m)); },
                  [&](int ai, int m, const RdS& d) { const int row = EPI_ROW(u, ai, m); const int b = row >> 12, s = row & (S - 1), ps = vpos(s);
#pragma unroll
                      for (int bj = 0; bj < 2; ++bj) { float v[8]; EPI_GET8(v, ai, bj, m, d.rs);
                          bf16_t* p = vt + (((size_t)b * nh + bj) * 128 + q0) * S + ps;
#pragma unroll
                          for (int e = 0; e < 8; ++e) p[(size_t)e * S] = f2bf(v[e]); } });
}
template <class RS>
__device__ __forceinline__ void hm_tile(Acc acc, const Unit& u, int wr, int wc, int fr, int fq, RS rsf, bf16_t* dst) {
    const int q0 = 32 * wc + 8 * fq;
    epi_pipe<RdS>([&](int ai, int m, RdS& d) { d.rs = rsf(ai, m, EPI_ROW(u, ai, m)); },
                  [&](int ai, int m, const RdS& d) { const int row = EPI_ROW(u, ai, m); const int b = row >> 12, s = row & (S - 1);
                      if (F8_CMP) { float v0[8], v1[8]; EPI_GET8(v0, ai, 0, m, d.rs); EPI_GET8(v1, ai, 1, m, d.rs);
                          store16_f8w((unsigned char*)dst + (((size_t)b * 2) * S + s) * 128 + q0, (unsigned char*)dst + (((size_t)b * 2 + 1) * S + s) * 128 + q0, fq, v0, v1); }
                      else {
#pragma unroll
                      for (int bj = 0; bj < 2; ++bj) { float v[8]; EPI_GET8(v, ai, bj, m, d.rs); store8(dst + (((size_t)b * 2 + bj) * S + s) * 128 + q0, v); } } });
}

struct In0 {
    const float* rstd; const float *c128, *s128, *c64, *s64; bf16_t *QA, *KA, *VA, *QLAT, *KVLAT, *KR; float *SSQQ, *SSQKV;
    __device__ __forceinline__ void operator()(Acc acc, const Unit& u, int wr, int wc, int fr, int fq) const {
        const int pn = u.pn; const float* rp = rstd;
        auto rsf = [rp](int, int, int row) { return rp[row]; };
        if (pn < 4) rope128_tile<KV8>(acc, u, wr, wc, fr, fq, rsf, c128, s128, kvw(QA, pn * 256), 1024);
        else if (pn == 4) rope128_tile<KV8>(acc, u, wr, wc, fr, fq, rsf, c128, s128, KA, 256);
        else if (pn == 5) plain_tile<KV8>(acc, u, wr, wc, fr, fq, rsf, VA, 256);
        else if (pn < 8) plain_ssq_tile(acc, u, wr, wc, fr, fq, rsf, QLAT + (pn - 6) * 256, 512, SSQQ, 8, (pn - 6) * 4);
        else if (pn == 8) plain_ssq_tile(acc, u, wr, wc, fr, fq, rsf, KVLAT, 256, SSQKV, 4, 0);
        else if (wc == 0) {
            const int i0 = 8 * fq; const float* c64_ = c64; const float* s64_ = s64; bf16_t* KR_ = KR;
            epi_pipe<RdRope>([&](int ai, int m, RdRope& d) { const int row = EPI_ROW(u, ai, m); d.rs = rp[row]; ld_rope(d, c64_ + (size_t)row * 32 + i0, s64_ + (size_t)row * 32 + i0); },
                             [&](int ai, int m, const RdRope& d) { const int row = EPI_ROW(u, ai, m);
                                 float x1[8], x2[8], y1[8], y2[8]; EPI_GET8(x1, ai, 0, m, d.rs); EPI_GET8(x2, ai, 1, m, d.rs); rope8(x1, x2, d, y1, y2);
                                 if (KV8) { unsigned char* p = (unsigned char*)KR_ + (size_t)row * 64 + i0; store16_f8w(p, p + 32, fq, y1, y2); }
                                 else { bf16_t* p = KR_ + (size_t)row * 64 + i0; store8(p, y1); store8(p + 32, y2); } });
        }
    }
};
struct RdUq { f32x4 a, b, c0, c1, s0, s1; };
struct Uq {
    const float* ssq; const float *c64, *s64; bf16_t* QB;
    __device__ __forceinline__ void operator()(Acc acc, const Unit& u, int wr, int wc, int fr, int fq) const {
        const int pn = u.pn, qq = 32 * wc + 8 * fq; const float* ssq_ = ssq; const float* c64_ = c64; const float* s64_ = s64; bf16_t* QB_ = QB;
        const int head = 4 * (pn - 4) + (qq >> 5), i0 = qq & 31;
        epi_pipe1<RdUq>([&](int ai, int m, RdUq& d) { const int row = EPI_ROW(u, ai, m); d.a = *(const f32x4*)(ssq_ + (size_t)row * 8); d.b = *(const f32x4*)(ssq_ + (size_t)row * 8 + 4);
                           if (pn >= 4) { d.c0 = *(const f32x4*)(c64_ + (size_t)row * 32 + i0); d.c1 = *(const f32x4*)(c64_ + (size_t)row * 32 + i0 + 4); d.s0 = *(const f32x4*)(s64_ + (size_t)row * 32 + i0); d.s1 = *(const f32x4*)(s64_ + (size_t)row * 32 + i0 + 4); } },
                       [&](int ai, int m, const RdUq& d) { const int row = EPI_ROW(u, ai, m);
                           const float rs = __builtin_amdgcn_rsqf(((d.a[0] + d.a[1]) + (d.a[2] + d.a[3]) + (d.b[0] + d.b[1]) + (d.b[2] + d.b[3])) * (1.0f / 512.0f) + EPS);
                           if (pn < 4) {
                               if (KV8) { float v0[8], v1[8]; EPI_GET8(v0, ai, 0, m, rs); EPI_GET8(v1, ai, 1, m, rs); unsigned char* p = (unsigned char*)QB_ + (size_t)row * 1536 + (2 * pn) * 192 + qq; store16_f8w(p, p + 192, fq, v0, v1); }
                               else {
#pragma unroll
                               for (int bj = 0; bj < 2; ++bj) { float v[8]; EPI_GET8(v, ai, bj, m, rs); store8(QB_ + (size_t)row * 1536 + (2 * pn + bj) * 192 + qq, v); } }
                           } else { RdRope r; r.rs = rs; r.c0 = d.c0; r.c1 = d.c1; r.s0 = d.s0; r.s1 = d.s1;
                               float x1[8], x2[8], y1[8], y2[8]; EPI_GET8(x1, ai, 0, m, rs); EPI_GET8(x2, ai, 1, m, rs); rope8(x1, x2, r, y1, y2);
                               if (KV8) { unsigned char* p = (unsigned char*)QB_ + (size_t)row * 1536 + head * 192 + 128 + i0; store16_f8w(p, p + 32, fq, y1, y2); }
                               else { bf16_t* p = QB_ + (size_t)row * 1536 + head * 192 + 128 + i0; store8(p, y1); store8(p + 32, y2); } } });
    }
};
struct RdV4 { f32x4 a; };
struct Ukv {
    const float* ssq; bf16_t *KB, *VB;
    __device__ __forceinline__ void operator()(Acc acc, const Unit& u, int wr, int wc, int fr, int fq) const {
        const int pn = u.pn, qq = 32 * wc + 8 * fq; const float* ssq_ = ssq; bf16_t* KB_ = KB; bf16_t* VB_ = VB;
        epi_pipe<RdV4>([&](int ai, int m, RdV4& d) { d.a = *(const f32x4*)(ssq_ + (size_t)EPI_ROW(u, ai, m) * 4); },
                       [&](int ai, int m, const RdV4& d) { const int row = EPI_ROW(u, ai, m);
                           const float rs = __builtin_amdgcn_rsqf(((d.a[0] + d.a[1]) + (d.a[2] + d.a[3])) * (1.0f / 256.0f) + EPS);
                           if (KV8) { float v0[8], v1[8]; EPI_GET8(v0, ai, 0, m, rs); EPI_GET8(v1, ai, 1, m, rs);
                               unsigned char* p = (pn < 4 ? (unsigned char*)KB_ + (size_t)row * 1024 + (2 * pn) * 128 : (unsigned char*)VB_ + (size_t)row * 1024 + (2 * (pn - 4)) * 128) + qq; store16_f8w(p, p + 128, fq, v0, v1); }
                           else {
#pragma unroll
                           for (int bj = 0; bj < 2; ++bj) { float v[8]; EPI_GET8(v, ai, bj, m, rs);
                               if (pn < 4) store8(KB_ + (size_t)row * 1024 + (2 * pn + bj) * 128 + qq, v);
                               else store8(VB_ + (size_t)row * 1024 + (2 * (pn - 4) + bj) * 128 + qq, v); } } });
    }
};
struct RdWo { f32x4 r[4]; };
template <bool RF32> struct Wo {
    const void* resid; bf16_t* hb; unsigned char* h8;
    __device__ __forceinline__ void operator()(Acc acc, const Unit& u, int wr, int wc, int fr, int fq) const {
        const int q0 = u.pn * 256 + 32 * wc + 8 * fq; const float* rf = (const float*)resid; const bf16_t* rb = (const bf16_t*)resid; bf16_t* hb_ = hb; unsigned char* h8_ = h8;
        epi_pipe<RdWo>([&](int ai, int m, RdWo& d) { const size_t o = (size_t)EPI_ROW(u, ai, m) * D + q0;
                           if (RF32) { d.r[0] = *(const f32x4*)(rf + o); d.r[1] = *(const f32x4*)(rf + o + 4); d.r[2] = *(const f32x4*)(rf + o + 128); d.r[3] = *(const f32x4*)(rf + o + 132); }
                           else { const u32x4 a = *(const u32x4*)(rb + o), b = *(const u32x4*)(rb + o + 128); d.r[0] = __builtin_bit_cast(f32x4, a); d.r[2] = __builtin_bit_cast(f32x4, b); } },
                       [&](int ai, int m, const RdWo& d) { const size_t o0 = (size_t)EPI_ROW(u, ai, m) * D + q0; float vv[2][8];
#pragma unroll
                           for (int bj = 0; bj < 2; ++bj) { float (&v)[8] = vv[bj]; EPI_GET8(v, ai, bj, m, 1.0f); const size_t o = o0 + bj * 128;
                               if (RF32) {
#pragma unroll
                                   for (int e = 0; e < 4; ++e) { v[e] += d.r[2 * bj][e]; v[4 + e] += d.r[2 * bj + 1][e]; }
                               } else { float r8[8]; unpack8(__builtin_bit_cast(u32x4, d.r[2 * bj]), r8);
#pragma unroll
                                   for (int e = 0; e < 8; ++e) v[e] += r8[e]; }
                               store8(hb_ + o, v); }
                           if (h8_) store16_f8w(h8_ + o0, h8_ + o0 + 128, fq, vv[0], vv[1]); });
    }
};
struct PlainBf16 {
    bf16_t* O; int ldc;
    __device__ __forceinline__ void operator()(Acc acc, const Unit& u, int wr, int wc, int fr, int fq) const { plain_tile(acc, u, wr, wc, fr, fq, [](int, int, int) { return 1.0f; }, O + u.pn * 256, ldc); }
};
struct RdPle { float rs; u32x4 pp[2]; u32x4 r[2]; };
struct Ple {
    const float* rstd; const bf16_t* PP; const bf16_t* hin; bf16_t* hout; float* ssq; unsigned char* h8;
    __device__ __forceinline__ void operator()(Acc acc, const Unit& u, int wr, int wc, int fr, int fq) const {
        const int q0 = u.pn * 256 + 32 * wc + 8 * fq; const float* rstd_ = rstd; const bf16_t* PP_ = PP; const bf16_t* hin_ = hin; bf16_t* hout_ = hout; float* ssq_ = ssq; unsigned char* h8_ = h8;
        epi_pipe1<RdPle>([&](int ai, int m, RdPle& d) { const int row = EPI_ROW(u, ai, m); const size_t o = (size_t)row * D + q0; d.rs = rstd_[row];
                            d.pp[0] = *(const u32x4*)(PP_ + o); d.pp[1] = *(const u32x4*)(PP_ + o + 128); d.r[0] = *(const u32x4*)(hin_ + o); d.r[1] = *(const u32x4*)(hin_ + o + 128); },
                        [&](int ai, int m, const RdPle& d) { const int row = EPI_ROW(u, ai, m); const size_t o0 = (size_t)row * D + q0; float ss = 0.f; float vv[2][8];
#pragma unroll
                            for (int bj = 0; bj < 2; ++bj) { float (&v)[8] = vv[bj]; float pp[8], r8[8]; EPI_GET8(v, ai, bj, m, d.rs); unpack8(d.pp[bj], pp); unpack8(d.r[bj], r8);
#pragma unroll
                                for (int e = 0; e < 8; ++e) { const float hh = r8[e] + pp[e] * sigmoidf_(v[e]); v[e] = hh; ss += hh * hh; }
                                store8(hout_ + o0 + bj * 128, v); }
                            if (h8_) store16_f8w(h8_ + o0, h8_ + o0 + 128, fq, vv[0], vv[1]);
                            if (ssq_) { ss += __shfl_xor(ss, 16); ss += __shfl_xor(ss, 32);
                                if (fq == 0) ssq_[(size_t)row * 32 + u.pn * 4 + wc] = ss; } });
    }
};
template <bool F8> struct MoeGu {
    const float* rlist; volatile LAS unsigned* cnt; bf16_t* H;
    __device__ __forceinline__ void operator()(Acc acc, const Unit& u, int wr, int wc, int fr, int fq) const {
        const int q0 = 32 * wc + 8 * fq; const int cn = __builtin_amdgcn_readfirstlane((int)cnt[u.e]); const float* rl = rlist + (size_t)u.e * T; bf16_t* H_ = H;
        float gkeep[8]; unsigned char* pkeep = nullptr;
        epi_pipe_n<RdS>(u.half ? 2 : 4, [&](int ai, int m, RdS& d) { const int gr = u.r0 + EPI_ROWL(ai, m); d.rs = gr < cn ? rl[gr] : 0.f; },
                      [&](int ai, int m, const RdS& d) { const int lr = EPI_ROWL(ai, m);
                          float g[8], w[8]; EPI_GET8(g, ai, 0, m, d.rs); EPI_GET8(w, ai, 1, m, d.rs);
#pragma unroll
                          for (int e = 0; e < 8; ++e) g[e] = g[e] * sigmoidf_(g[e]) * w[e];
                          if (F8) { unsigned char* p = (unsigned char*)H_ + ((size_t)u.pm * 256 + u.ro + lr) * EH + u.pn * 128 + q0;
                              if (!(m & 1)) {
#pragma unroll
                                  for (int e = 0; e < 8; ++e) gkeep[e] = g[e];
                                  pkeep = p; }
                              else store16_f8w(pkeep, p, fq, gkeep, g); }
                          else store8(H_ + ((size_t)u.pm * 256 + u.ro + lr) * EH + u.pn * 128 + q0, g); });
    }
};
template <bool F8Y> struct MoeDn {
    const float* wlist; volatile LAS unsigned* cnt; bf16_t* Y;
    __device__ __forceinline__ void operator()(Acc acc, const Unit& u, int wr, int wc, int fr, int fq) const {
        const int q0 = u.pn * 256 + 32 * wc + 8 * fq; const int cn = __builtin_amdgcn_readfirstlane((int)cnt[u.e]); const float* wl = wlist + (size_t)u.e * T; bf16_t* Y_ = Y;
        epi_pipe_n<RdS>(u.half ? 2 : 4, [&](int ai, int m, RdS& d) { const int gr = u.r0 + EPI_ROWL(ai, m); d.rs = gr < cn ? wl[gr] * (F8Y ? F8_OSC : 1.0f) : 0.f; },
                      [&](int ai, int m, const RdS& d) { const int lr = EPI_ROWL(ai, m);
#pragma unroll
                          for (int bj = 0; bj < 2; ++bj) { if (F8Y) break; float v[8]; EPI_GET8(v, ai, bj, m, d.rs); store8(Y_ + ((size_t)u.pm * 256 + u.ro + lr) * D + q0 + bj * 128, v); }
                          if (F8Y) { float v0[8], v1[8]; EPI_GET8(v0, ai, 0, m, d.rs); EPI_GET8(v1, ai, 1, m, d.rs); unsigned char* p = (unsigned char*)Y_ + ((size_t)u.pm * 256 + u.ro + lr) * D + q0; store16_f8w(p, p + 128, fq, v0, v1); } });
    }
};
struct In1 {
    const float* ssqp;
    const float *c128, *s128; const float* fb; bf16_t *CQ, *CK, *CV, *DQ, *KC, *VC, *KS, *VS, *KW, *VW; float *LF, *DG;
    __device__ __forceinline__ void operator()(Acc acc, const Unit& u, int wr, int wc, int fr, int fq) const {
        float rsv[2][4];
        { const int tid = (wr * 4 + wc) * 64 + fq * 16 + fr, rr = tid >> 1, part = tid & 1;
          const float* sp = ssqp + (size_t)(u.pm * 256 + rr) * 32 + part * 16; float ss = 0.f;
#pragma unroll
          for (int j = 0; j < 4; ++j) { const f32x4 a = *(const f32x4*)(sp + 4 * j); ss += (a[0] + a[1]) + (a[2] + a[3]); }
          ss += __shfl_xor(ss, 1);
          LAS float* rsL = (LAS float*)(LDS_RS);
          if (part == 0) rsL[rr] = __builtin_amdgcn_rsqf(ss * (1.0f / D) + EPS);
          asm volatile("s_waitcnt lgkmcnt(0)" ::: "memory"); __builtin_amdgcn_s_barrier(); asm volatile("" ::: "memory");
#pragma unroll
          for (int ai = 0; ai < 2; ++ai)
#pragma unroll
              for (int m = 0; m < 4; ++m) rsv[ai][m] = rsL[ai * 128 + wr * 64 + m * 16 + fr]; }
        __builtin_amdgcn_sched_barrier(0);
        auto rsf = [&](int ai, int m, int) { return rsv[ai][m]; };
        const int pn = u.pn;
        if (pn < 4) plain_tile<KV8>(acc, u, wr, wc, fr, fq, rsf, kvw(CQ, pn * 256), 1024);
        else if (pn < 8) plain_tile<KV8>(acc, u, wr, wc, fr, fq, rsf, kvw(CK, (pn - 4) * 256), 1024);
        else if (pn < 12) plain_tile<KV8>(acc, u, wr, wc, fr, fq, rsf, kvw(CV, (pn - 8) * 256), 1024);
        else if (pn < 16) rope128_tile(acc, u, wr, wc, fr, fq, rsf, c128, s128, DQ + (pn - 12) * 256, 1024);
        else if (pn == 16) hm_tile(acc, u, wr, wc, fr, fq, rsf, KC);
        else if (pn == 17) hm_tile(acc, u, wr, wc, fr, fq, rsf, VC);
        else if (pn == 18) rope128_tile<KV8>(acc, u, wr, wc, fr, fq, rsf, c128, s128, KS, 256);
        else if (pn == 19) plain_tile<KV8>(acc, u, wr, wc, fr, fq, rsf, VS, 256);
        else if (pn == 20) rope128_tile<KV8>(acc, u, wr, wc, fr, fq, rsf, c128, s128, KW, 256);
        else if (pn == 21) plain_tile<KV8>(acc, u, wr, wc, fr, fq, rsf, VW, 256);
        else if (wc == 0) {
#pragma unroll
            for (int ai = 0; ai < 2; ++ai)
#pragma unroll
                for (int m = 0; m < 4; ++m) { const int row = EPI_ROW(u, ai, m); float v[8]; EPI_GET8(v, ai, 0, m, rsv[ai][m]);
                    if (fq == 0) {
#pragma unroll
                        for (int e = 0; e < 8; ++e) { const float z = v[e] + fb[e];
                            v[e] = fminf(z, 0.f) - __logf(1.0f + __expf(-fabsf(z))); }
                        *(f32x4*)(LF + (size_t)row * 8) = (f32x4){v[0], v[1], v[2], v[3]}; *(f32x4*)(LF + (size_t)row * 8 + 4) = (f32x4){v[4], v[5], v[6], v[7]};
                    } else {
#pragma unroll
                        for (int e = 0; e < 8; ++e) v[e] = sigmoidf_(v[e]);
                        float* p = DG + (size_t)row * 24 + 8 * (fq - 1); *(f32x4*)p = (f32x4){v[0], v[1], v[2], v[3]}; *(f32x4*)(p + 4) = (f32x4){v[4], v[5], v[6], v[7]};
                    } }
        }
    }
};
template <bool HU> struct Cmp1 {
    const float* bias; bf16_t* HID;
    __device__ __forceinline__ void operator()(Acc acc, const Unit& u, int wr, int wc, int fr, int fq) const {
        const int q0 = 32 * wc + 8 * fq;
        f32x4 bb[2][2];
#pragma unroll
        for (int bj = 0; bj < 2; ++bj) { bb[bj][0] = *(const f32x4*)(bias + bj * 128 + q0); bb[bj][1] = *(const f32x4*)(bias + bj * 128 + q0 + 4); }
#pragma unroll
        for (int ai = 0; ai < (HU ? 1 : 2); ++ai)
#pragma unroll
            for (int m = 0; m < 4; ++m) { const int row = HU ? u.r0 + EPI_ROWL(0, m) : EPI_ROW(u, ai, m);
#pragma unroll
                for (int bj = 0; bj < 2; ++bj) { float v[8]; EPI_GET8(v, ai, bj, m, 1.0f); const int c = bj * 128 + q0;
#pragma unroll
                    for (int e = 0; e < 8; ++e) { const float x = v[e] + (e < 4 ? bb[bj][0][e] : bb[bj][1][e - 4]); v[e] = x * sigmoidf_(1.5957691216057308f * (x + 0.044715f * x * x * x)); }
                    store8(HID + (size_t)row * 256 + c, v); } }
    }
};
template <bool ISK, bool HU> struct Cmp2 {
    const float *c128, *s128; bf16_t* OUT;
    __device__ __forceinline__ void operator()(Acc acc, const Unit& u, int wr, int wc, int fr, int fq) const {
        const int q0 = 32 * wc + 8 * fq; const float* c128_ = c128; const float* s128_ = s128; bf16_t* OUT_ = OUT;
        if (ISK) { if (wc < 2) {
            epi_pipe_n<RdRope>(HU ? 2 : 4, [&](int ai, int m, RdRope& d) { const int row = HU ? u.r0 + EPI_ROWL(0, m) : EPI_ROW(u, ai, m); const int grp = row >> 8, c = row & 255; const int tt = (grp >> 1) * S + 16 * (c < 255 ? c : 0) + 31; d.rs = 1.0f;
                                 ld_rope(d, c128_ + (size_t)tt * 64 + q0, s128_ + (size_t)tt * 64 + q0); },
                             [&](int ai, int m, const RdRope& d) { const int row = HU ? u.r0 + EPI_ROWL(0, m) : EPI_ROW(u, ai, m); const bool ok = (row & 255) < 255;
                                 float x1[8], x2[8], y1[8], y2[8]; EPI_GET8(x1, ai, 0, m, 1.0f); EPI_GET8(x2, ai, 1, m, 1.0f); rope8(x1, x2, d, y1, y2);
                                 if (!ok) {
#pragma unroll
                                     for (int e = 0; e < 8; ++e) { y1[e] = 0.f; y2[e] = 0.f; } }
                                 bf16_t* p = OUT_ + (size_t)row * 128 + q0; store8(p, y1); store8(p + 64, y2); }); } }
        else {
#pragma unroll
            for (int ai = 0; ai < (HU ? 1 : 2); ++ai)
#pragma unroll
                for (int m = 0; m < 4; ++m) { const int row = HU ? u.r0 + EPI_ROWL(0, m) : EPI_ROW(u, ai, m); const bool ok = (row & 255) < 255;
                    float v[8]; EPI_GET8(v, ai, 0, m, 1.0f);
                    if (!ok) {
#pragma unroll
                        for (int e = 0; e < 8; ++e) v[e] = 0.f; }
                    store8(OUT_ + (size_t)row * 128 + q0, v); }
        }
    }
};
#undef EPI_ROW
#undef EPI_ROWL
#undef EPI_GET8
}
namespace att {
enum { M_A = 0, M_B = 1, M_C = 2, M_W = 3, M_S = 4 };
template <int MODE> struct Cfg;
template <> struct Cfg<M_A> { static constexpr int DK = 128, WIN = 128; static constexpr bool GQA = true, CUM = false, SEL = false, Q8 = KV8; };
template <> struct Cfg<M_B> { static constexpr int DK = 192, WIN = 0;   static constexpr bool GQA = false, CUM = false, SEL = false, Q8 = KV8; };
template <> struct Cfg<M_C> { static constexpr int DK = 128, WIN = 0;   static constexpr bool GQA = false, CUM = true, SEL = false, Q8 = KV8; };
template <> struct Cfg<M_W> { static constexpr int DK = 128, WIN = 512; static constexpr bool GQA = true, CUM = false, SEL = false, Q8 = false; };
template <> struct Cfg<M_S> { static constexpr int DK = 128, WIN = 0;   static constexpr bool GQA = true, CUM = false, SEL = true, Q8 = false; };

constexpr int LK0 = 0, LK1 = 24576, LV0 = 49152, LV1 = 65536, LCUM = 81920;
constexpr bool FOLDC2 = true;
constexpr float THR = 8.0f;
#define KSWZ(RB, row, colB) ((row) * (RB) + ((colB) ^ (((row) & 7) << 4)))
#define VOFF(row, ch) (256 * (row) + 16 * ((ch) ^ ((((row) & 3) << 2) | (((row) >> 2) & 3))))

__device__ __forceinline__ int crow(int r) { return (r & 3) + 8 * (r >> 2); }
__device__ __forceinline__ bf16x8 pk8(const f32x16& p, int s) {
    u32x4 w; w.x = cvt_pk(p[8 * s + 0], p[8 * s + 1]); w.y = cvt_pk(p[8 * s + 2], p[8 * s + 3]); w.z = cvt_pk(p[8 * s + 4], p[8 * s + 5]); w.w = cvt_pk(p[8 * s + 6], p[8 * s + 7]);
    return *reinterpret_cast<bf16x8*>(&w);
}
template <int DK> __device__ __forceinline__ void kv_addr(int lane, int (&ka)[4], int (&va)[8]) {
    const int kr = lane & 31, hh = lane >> 5, blk = (lane >> 4) & 1, q = (lane & 15) >> 2, p = lane & 3;
#pragma unroll
    for (int i = 0; i < 4; ++i) ka[i] = KSWZ(DK * 2, kr, 32 * i + 16 * hh);
#pragma unroll
    for (int db = 0; db < 4; ++db)
#pragma unroll
        for (int t = 0; t < 2; ++t) va[2 * db + t] = VOFF(4 * hh + q + 8 * t, 4 * db + 2 * blk + (p >> 1)) + 8 * (p & 1);
}
template <int DK> __device__ __forceinline__ void qk_tile(const LAS unsigned char* kb, const int (&ka)[4], const bf16x8 (&qf)[DK / 16], f32x16& p0, f32x16& p1) {
#pragma unroll
    for (int r = 0; r < 16; ++r) { p0[r] = 0.f; p1[r] = 0.f; }
#pragma unroll
    for (int ks = 0; ks < DK / 16; ++ks) {
        const bf16x8 a0 = *(const LAS bf16x8*)(kb + ka[ks & 3] + (ks >> 2) * 128);
        const bf16x8 a1 = *(const LAS bf16x8*)(kb + ka[ks & 3] + (ks >> 2) * 128 + 32 * DK * 2);
        p0 = __builtin_amdgcn_mfma_f32_32x32x16_bf16(a0, qf[ks], p0, 0, 0, 0);
        p1 = __builtin_amdgcn_mfma_f32_32x32x16_bf16(a1, qf[ks], p1, 0, 0, 0);
    }
}
__device__ __forceinline__ u32x2 bf8_to_f8(const u32x4 w) {
    int a = (int)w.x, b = (int)w.z;
    a = __builtin_amdgcn_cvt_pk_fp8_f32(__uint_as_float(w.x << 16), __uint_as_float(w.x), a, false); a = __builtin_amdgcn_cvt_pk_fp8_f32(__uint_as_float(w.y << 16), __uint_as_float(w.y), a, true);
    b = __builtin_amdgcn_cvt_pk_fp8_f32(__uint_as_float(w.z << 16), __uint_as_float(w.z), b, false); b = __builtin_amdgcn_cvt_pk_fp8_f32(__uint_as_float(w.w << 16), __uint_as_float(w.w), b, true);
    u32x2 r; r.x = (unsigned)a; r.y = (unsigned)b; return r;
}
#define K8SWZ(row, colB) ((row) * 128 + ((colB) ^ (((row) & 7) << 4)))
#define K8SWZ2(row, colB) (8192 + (row) * 64 + ((colB) ^ ((((row) >> 1) & 3) << 4)))
__device__ __forceinline__ void k8_addr(int lane, int (&ka)[6]) {
    const int kr = lane & 31, hh = lane >> 5;
#pragma unroll
    for (int t = 0; t < 2; ++t)
#pragma unroll
        for (int u = 0; u < 2; ++u) ka[2 * t + u] = K8SWZ(kr, 64 * t + 32 * hh + 16 * u);
#pragma unroll
    for (int u = 0; u < 2; ++u) ka[4 + u] = K8SWZ2(kr, 32 * hh + 16 * u);
}
template <int DK> __device__ __forceinline__ void qk_tile8(const LAS unsigned char* kb, const int (&ka)[6], const i32x8 (&q8)[DK / 64], f32x16& p0, f32x16& p1) {
#pragma unroll
    for (int r = 0; r < 16; ++r) { p0[r] = 0.f; p1[r] = 0.f; }
#pragma unroll
    for (int t = 0; t < DK / 64; ++t) {
        const int rs = t < 2 ? 32 * 128 : 32 * 64;
        const i32x8 a0 = __builtin_shufflevector(*(const LAS i32x4*)(kb + ka[2 * t]), *(const LAS i32x4*)(kb + ka[2 * t + 1]), 0, 1, 2, 3, 4, 5, 6, 7);
        const i32x8 a1 = __builtin_shufflevector(*(const LAS i32x4*)(kb + ka[2 * t] + rs), *(const LAS i32x4*)(kb + ka[2 * t + 1] + rs), 0, 1, 2, 3, 4, 5, 6, 7);
        p0 = __builtin_amdgcn_mfma_scale_f32_32x32x64_f8f6f4(a0, q8[t], p0, 0, 0, 0, 0x7f7f7f7f, 0, 0x7f7f7f7f);
        p1 = __builtin_amdgcn_mfma_scale_f32_32x32x64_f8f6f4(a1, q8[t], p1, 0, 0, 0, 0x7f7f7f7f, 0, 0x7f7f7f7f);
    }
}
typedef short s16x4 __attribute__((ext_vector_type(4)));
__device__ __forceinline__ void pv_tile(const int vb, const int (&va)[8], const f32x16& p0, const f32x16& p1, f32x16 (&o)[4]) {
    const bf16x8 pb[4] = {pk8(p0, 0), pk8(p0, 1), pk8(p1, 0), pk8(p1, 1)};
#define TRRD(dst, a, off) asm volatile("ds_read_b64_tr_b16 %0, %1 offset:%2" : "=&v"(dst) : "v"(a), "i"(off) : "memory")
#pragma unroll
    for (int db = 0; db < 4; ++db) {
        s16x4 l0, l1, l2, l3, h0, h1, h2, h3; const int a0 = va[2 * db] + vb, a1 = va[2 * db + 1] + vb;
        TRRD(l0, a0, 0); TRRD(h0, a1, 0); TRRD(l1, a0, 4096); TRRD(h1, a1, 4096); TRRD(l2, a0, 8192); TRRD(h2, a1, 8192); TRRD(l3, a0, 12288); TRRD(h3, a1, 12288);
        asm volatile("s_waitcnt lgkmcnt(0)" ::: "memory"); __builtin_amdgcn_sched_barrier(0);
        o[db] = __builtin_amdgcn_mfma_f32_32x32x16_bf16((bf16x8){l0[0], l0[1], l0[2], l0[3], h0[0], h0[1], h0[2], h0[3]}, pb[0], o[db], 0, 0, 0);
        o[db] = __builtin_amdgcn_mfma_f32_32x32x16_bf16((bf16x8){l1[0], l1[1], l1[2], l1[3], h1[0], h1[1], h1[2], h1[3]}, pb[1], o[db], 0, 0, 0);
        o[db] = __builtin_amdgcn_mfma_f32_32x32x16_bf16((bf16x8){l2[0], l2[1], l2[2], l2[3], h2[0], h2[1], h2[2], h2[3]}, pb[2], o[db], 0, 0, 0);
        o[db] = __builtin_amdgcn_mfma_f32_32x32x16_bf16((bf16x8){l3[0], l3[1], l3[2], l3[3], h3[0], h3[1], h3[2], h3[3]}, pb[3], o[db], 0, 0, 0);
    }
#undef TRRD
}
#define V8OFF(row, colB) ((row) * 128 + ((colB) ^ (((((row) >> 1) & 1) | ((((row) >> 3) & 1) << 1)) << 5)))
__device__ __forceinline__ void v8_addr(int lane, int (&va8)[4]) {
    const int hh = lane >> 5, blk = (lane >> 4) & 1, q = (lane & 15) >> 1, p = lane & 1;
    const int key0 = 8 * (q >> 2) + 4 * hh + (q & 3);
#pragma unroll
    for (int db = 0; db < 4; ++db) va8[db] = V8OFF(key0, 32 * db + 16 * blk + 8 * p);
}
typedef int i32x2 __attribute__((ext_vector_type(2)));
__device__ __forceinline__ float pv_tile8(const int vb, const int (&va8)[4], const f32x16& p0, const f32x16& p1, f32x16 (&o)[4], const i32x8& ones) {
    i32x8 pb;
#pragma unroll
    for (int s2 = 0; s2 < 2; ++s2) { float v[8];
#pragma unroll
        for (int e = 0; e < 8; ++e) v[e] = p0[8 * s2 + e];
        u32x2 w = pack8_f8(v); pb[2 * s2] = (int)w.x; pb[2 * s2 + 1] = (int)w.y;
#pragma unroll
        for (int e = 0; e < 8; ++e) v[e] = p1[8 * s2 + e];
        w = pack8_f8(v); pb[4 + 2 * s2] = (int)w.x; pb[4 + 2 * s2 + 1] = (int)w.y; }
#pragma unroll
    for (int db = 0; db < 4; ++db) {
        const LAS unsigned char* a = (const LAS unsigned char*)(unsigned)(va8[db] + vb);
        const i32x2 r0 = __builtin_amdgcn_ds_read_tr8_b64_v2i32((LAS i32x2*)(a)), r1 = __builtin_amdgcn_ds_read_tr8_b64_v2i32((LAS i32x2*)(a + 2048));
        const i32x2 r2 = __builtin_amdgcn_ds_read_tr8_b64_v2i32((LAS i32x2*)(a + 4096)), r3 = __builtin_amdgcn_ds_read_tr8_b64_v2i32((LAS i32x2*)(a + 6144));
        const i32x8 av = {r0[0], r0[1], r1[0], r1[1], r2[0], r2[1], r3[0], r3[1]};
        o[db] = __builtin_amdgcn_mfma_scale_f32_32x32x64_f8f6f4(av, pb, o[db], 0, 0, 0, 0x7f7f7f7f, 0, 0x7f7f7f7f);
    }
    f32x16 z;
#pragma unroll
    for (int r = 0; r < 16; ++r) z[r] = 0.f;
    const f32x16 lt = __builtin_amdgcn_mfma_scale_f32_32x32x64_f8f6f4(ones, pb, z, 0, 0, 0, 0x7f7f7f7f, 0, 0x7f7f7f7f);
    return lt[0];
}

template <int MODE>
__device__ __forceinline__ void flash(const Frame& F, const bf16_t* qrow, const bf16_t* kbase, int ldk, const bf16_t* krope, const bf16_t* vbase, int ldv, const float* cumk, float cumq,
                                      int tpos, int tw_lo, int tw_hi, int tlo, int thi, u64 sel, u64 selu, float c2, float& m_run, float& l_run, f32x16 (&o)[4]) {
    typedef Cfg<MODE> C; constexpr int DK = C::DK, NKC = DK / 64;
    const int tid = F.tid, lane = F.lane, hh = lane >> 5;
    LAS unsigned char* lds = F.lds;
    bf16x8 qf[QK8 ? 1 : DK / 16]; i32x8 q8[DK / 64];
    int ka[4], va[8]; kv_addr<DK>(lane, ka, va); int ka8[6], va8[4]; if (PV8) v8_addr(lane, va8);
    i32x8 ones8;
#pragma unroll
    for (int i = 0; i < 8; ++i) ones8[i] = 0x38383838;
    asm volatile("" : "+v"(ones8));
    if (QK8) {
        k8_addr(lane, ka8);
#pragma unroll
        for (int t = 0; t < DK / 64; ++t)
#pragma unroll
            for (int jq = 0; jq < 4; ++jq) {
                if (C::Q8) { if (jq < 2) { const u32x4 w = *(const u32x4*)((const unsigned char*)qrow + 64 * t + 32 * hh + 16 * jq); q8[t][4 * jq] = (int)w.x; q8[t][4 * jq + 1] = (int)w.y; q8[t][4 * jq + 2] = (int)w.z; q8[t][4 * jq + 3] = (int)w.w; } }
                else { const u32x2 w = bf8_to_f8(*(const u32x4*)(qrow + 64 * t + 32 * hh + 8 * jq)); q8[t][2 * jq] = (int)w.x; q8[t][2 * jq + 1] = (int)w.y; } }
    } else {
#pragma unroll
        for (int ks = 0; ks < DK / 16; ++ks) qf[ks] = *(const bf16x8*)(qrow + 16 * ks + 8 * hh);
    }
    auto next_tile = [&](int j) -> int {
        if (!C::SEL) return j + 1;
        const u64 mk = (j >= 63) ? 0ull : (selu & ~((2ull << j) - 1ull));
        const int n = mk ? (__ffsll((long long)mk) - 1) : 64;
        return n < thi ? n : thi;
    };
    int j = tlo;
    if (C::SEL) { if (!((selu >> tlo) & 1ull)) j = next_tile(tlo); }
    if (j >= thi) return;
    u32x4 kreg[NKC], vreg[2]; float creg = 0.f;
    u32x4 k8m, k8r, v8m;
    unsigned koff[NKC], voff[2];
#pragma unroll
    for (int i = 0; i < NKC; ++i) { const int c = tid + i * NTHR, row = c / (DK / 8), c8 = c % (DK / 8);
        koff[i] = (DK == 192 && c8 >= 16) ? (0x80000000u | (unsigned)(row * 64 + (c8 - 16) * 8) * 2u) : (unsigned)(row * ldk + c8 * 8) * 2u; }
#pragma unroll
    for (int i = 0; i < 2; ++i) { const int c = tid + i * NTHR, row = c >> 4, ch = c & 15; voff[i] = (unsigned)(row * ldv + ch * 8) * 2u; }
    const unsigned kso = (unsigned)((tid >> 3) * ldk + (((tid & 7) ^ ((tid >> 3) & 7)) * 16));
    const unsigned vso = (unsigned)((tid >> 3) * ldv + (((tid & 7) ^ (((((tid >> 3) >> 1) & 1) | ((((tid >> 3) >> 3) & 1) << 1)) << 1)) * 16));
    const unsigned rso = (unsigned)((tid >> 2) * 64 + (((tid & 3) ^ (((tid >> 2) >> 1) & 3)) * 16));
    const int wv = F.wave;
    auto dma = [&](int jt, int b) {
        LAS unsigned char* kb = lds + (b ? LK1 : LK0) + wv * 1024; LAS unsigned char* vb = lds + (b ? LV1 : LV0) + wv * 1024;
        const char* kt8 = (const char*)kbase + (size_t)jt * 64 * ldk; const char* vt8 = (const char*)vbase + (size_t)jt * 64 * ldv;
        __builtin_amdgcn_global_load_lds((const unsigned*)(kt8 + kso), (LAS unsigned*)kb, 16, 0, 0);
        __builtin_amdgcn_global_load_lds((const unsigned*)(vt8 + vso), (LAS unsigned*)vb, 16, 0, 0);
        if (DK == 192) { if (wv < 4) __builtin_amdgcn_global_load_lds((const unsigned*)((const char*)krope + (size_t)jt * 64 * 64 + rso), (LAS unsigned*)(kb + 8192), 16, 0, 0); }
        if (C::CUM) { if (tid < 64) creg = cumk[jt * 64 + tid]; }
    };
    auto dma_done = [&](int b) {
        if (C::CUM) { if (tid < 64) ((LAS float*)(lds + LCUM))[b * 64 + tid] = creg; }
        asm volatile("s_waitcnt vmcnt(0)" ::: "memory");
    };
    auto gload = [&](int jt) {
        if constexpr (KV8) {
            const char* kt8 = (const char*)kbase + (size_t)jt * 64 * ldk; const char* vt8 = (const char*)vbase + (size_t)jt * 64 * ldv;
            k8m = *(const u32x4*)(kt8 + (size_t)(tid >> 3) * ldk + (tid & 7) * 16); v8m = *(const u32x4*)(vt8 + (size_t)(tid >> 3) * ldv + (tid & 7) * 16);
            if (DK == 192) { if (tid < 256) k8r = *(const u32x4*)((const char*)krope + (size_t)jt * 64 * 64 + tid * 16); }
            if (C::CUM) { if (tid < 64) creg = cumk[jt * 64 + tid]; }
            return;
        }
        const char* kt = (const char*)kbase + (size_t)jt * 64 * ldk * 2; const char* vtt = (const char*)vbase + (size_t)jt * 64 * ldv * 2; const char* krt = (const char*)krope + (size_t)jt * 64 * 128;
#pragma unroll
        for (int i = 0; i < NKC; ++i) kreg[i] = (DK == 192 && (koff[i] & 0x80000000u)) ? *(const u32x4*)(krt + (koff[i] & 0x7fffffffu)) : *(const u32x4*)(kt + koff[i]);
#pragma unroll
        for (int i = 0; i < 2; ++i) vreg[i] = *(const u32x4*)(vtt + voff[i]);
        if (C::CUM) { if (tid < 64) creg = cumk[jt * 64 + tid]; }
    };
    auto lstore = [&](int buf) {
        LAS unsigned char* kb = lds + (buf ? LK1 : LK0); LAS unsigned char* vb = lds + (buf ? LV1 : LV0);
        if constexpr (KV8) {
            *(LAS u32x4*)(kb + K8SWZ(tid >> 3, (tid & 7) * 16)) = k8m; *(LAS u32x4*)(vb + V8OFF(tid >> 3, (tid & 7) * 16)) = v8m;
            if (DK == 192) { if (tid < 256) *(LAS u32x4*)(kb + K8SWZ2(tid >> 2, (tid & 3) * 16)) = k8r; }
            if (C::CUM) { if (tid < 64) ((LAS float*)(lds + LCUM))[buf * 64 + tid] = creg; }
            return;
        }
#pragma unroll
        for (int i = 0; i < NKC; ++i) { const int c = tid + i * NTHR, row = c / (DK / 8), c8 = c % (DK / 8);
            if (QK8) *(LAS u32x2*)(kb + (c8 < 16 ? K8SWZ(row, c8 * 8) : K8SWZ2(row, (c8 - 16) * 8))) = bf8_to_f8(kreg[i]);
            else *(LAS u32x4*)(kb + KSWZ(DK * 2, row, c8 * 16)) = kreg[i]; }
#pragma unroll
        for (int i = 0; i < 2; ++i) { const int c = tid + i * NTHR, row = c >> 4, ch = c & 15;
            if (PV8) *(LAS u32x2*)(vb + V8OFF(row, 8 * ch)) = bf8_to_f8(vreg[i]);
            else *(LAS u32x4*)(vb + VOFF(row, ch)) = vreg[i]; }
        if (C::CUM) { if (tid < 64) ((LAS float*)(lds + LCUM))[buf * 64 + tid] = creg; }
    };
    if constexpr (KVDMA) { dma(j, 0); dma_done(0); } else { gload(j); lstore(0); }
    __syncthreads();
    int buf = 0;
    constexpr unsigned WCMP = C::WIN ? (unsigned)C::WIN : 0x7fffffffu;
    while (j < thi) {
        const int jn = next_tile(j);
        if (jn < thi) { if constexpr (KVDMA) dma(jn, buf ^ 1); else gload(jn); }
        bool act = (64 * j <= tw_hi);
        if (C::WIN) act = act && (64 * j + 63 >= tw_lo - (C::WIN - 1));
        const bool selb = C::SEL ? (((sel >> j) & 1ull) != 0ull) : true;
        if (C::SEL) act = act && (__ballot(selb) != 0ull);
        if (act) {
            const LAS unsigned char* kb = lds + (buf ? LK1 : LK0);
            f32x16 p0, p1;
            if constexpr (QK8) qk_tile8<DK>(kb, ka8, q8, p0, p1); else qk_tile<DK>(kb, ka, qf, p0, p1);
            if (C::CUM) {
                const LAS float* cb = (const LAS float*)(lds + LCUM) + buf * 64 + 4 * hh;
#pragma unroll
                for (int g = 0; g < 4; ++g) { const f32x4 k0 = *(const LAS f32x4*)(cb + 8 * g), k1 = *(const LAS f32x4*)(cb + 32 + 8 * g);
#pragma unroll
                    for (int e = 0; e < 4; ++e) { p0[4 * g + e] = fmaf(p0[4 * g + e], c2, cumq - k0[e]); p1[4 * g + e] = fmaf(p1[4 * g + e], c2, cumq - k1[e]); } }
            } else if (!FOLDC2) {
#pragma unroll
                for (int r = 0; r < 16; ++r) { p0[r] *= c2; p1[r] *= c2; }
            }
            bool need = (64 * j + 63 > tw_lo);
            if (C::WIN) need = need || (tw_hi - 64 * j >= C::WIN);
            if (C::SEL) need = true;
            if (need) {
                const float NEG = -__builtin_inff();
                int dq = tpos - 64 * j - 4 * hh; if (C::SEL && !selb) dq = -1;
#pragma unroll
                for (int r = 0; r < 16; ++r) { const int c = crow(r);
                    if ((unsigned)(dq - c) >= WCMP) p0[r] = NEG;
                    if ((unsigned)(dq - c - 32) >= WCMP) p1[r] = NEG; }
            }
            float pmax = p0[0];
#pragma unroll
            for (int r = 1; r < 16; ++r) pmax = fmaxf(pmax, p0[r]);
#pragma unroll
            for (int r = 0; r < 16; ++r) pmax = fmaxf(pmax, p1[r]);
            pmax = fmaxf(pmax, __shfl_xor(pmax, 32));
            if (!C::CUM && FOLDC2) pmax *= c2;
            float mn = m_run;
            if (!__all(pmax - m_run <= THR)) {
                mn = fmaxf(m_run, pmax); const float alpha = fast_exp2(m_run - mn); m_run = mn; l_run *= alpha;
#pragma unroll
                for (int db = 0; db < 4; ++db)
#pragma unroll
                    for (int r = 0; r < 16; ++r) o[db][r] *= alpha;
            }
            float ps = 0.f;
#pragma unroll
            for (int r = 0; r < 16; ++r) {
                if (C::CUM || !FOLDC2) { p0[r] = fast_exp2(p0[r] - mn); p1[r] = fast_exp2(p1[r] - mn); }
                else { p0[r] = fast_exp2(fmaf(p0[r], c2, -mn)); p1[r] = fast_exp2(fmaf(p1[r], c2, -mn)); }
                if (!PV8) ps += p0[r] + p1[r]; }
            if (!PV8) { ps += __shfl_xor(ps, 32); l_run += ps; }
            if (PV8) l_run += pv_tile8(buf ? LV1 : LV0, va8, p0, p1, o, ones8); else pv_tile(buf ? LV1 : LV0, va, p0, p1, o);
        }
        if (jn < thi) { if constexpr (KVDMA) dma_done(buf ^ 1); else lstore(buf ^ 1); }
        __syncthreads();
        j = jn; buf ^= 1;
    }
}

template <bool ADD, bool IMG = false, bool NOBF = false>
__device__ __forceinline__ void out_row(bf16_t* orow, const f32x16 (&o)[4], float scale, int hh, unsigned char* o8 = nullptr) {
#pragma unroll
    for (int db = 0; db < 4; ++db) {
        u32x2 wb[4], wo[4]; unsigned qi[4];
        if (ADD) {
#pragma unroll
            for (int pr = 0; pr < 2; ++pr) { const u32x4 l = *(const u32x4*)(orow + 32 * db + 16 * pr + 8 * hh);
                const auto rx = __builtin_amdgcn_permlane32_swap(l.x, l.z, false, false); const auto ry = __builtin_amdgcn_permlane32_swap(l.y, l.w, false, false);
                wo[2 * pr].x = rx[0]; wo[2 * pr].y = ry[0]; wo[2 * pr + 1].x = rx[1]; wo[2 * pr + 1].y = ry[1]; }
        }
#pragma unroll
        for (int g = 0; g < 4; ++g) {
            float v0 = o[db][4 * g] * scale, v1 = o[db][4 * g + 1] * scale, v2 = o[db][4 * g + 2] * scale, v3 = o[db][4 * g + 3] * scale;
            if (ADD) { const u32x2 w = wo[g]; v0 += __uint_as_float(w.x << 16); v1 += __uint_as_float(w.x & 0xffff0000u); v2 += __uint_as_float(w.y << 16); v3 += __uint_as_float(w.y & 0xffff0000u); }
            if (!NOBF) { wb[g].x = cvt_pk(v0, v1); wb[g].y = cvt_pk(v2, v3); }
            if (IMG) { int q = __float_as_int(v0); q = __builtin_amdgcn_cvt_pk_fp8_f32(v0 * F8_OSC, v1 * F8_OSC, q, false); q = __builtin_amdgcn_cvt_pk_fp8_f32(v2 * F8_OSC, v3 * F8_OSC, q, true); qi[g] = (unsigned)q; }
        }
        if (!NOBF) {
#pragma unroll
            for (int pr = 0; pr < 2; ++pr) {
                const auto rx = __builtin_amdgcn_permlane32_swap(wb[2 * pr].x, wb[2 * pr + 1].x, false, false); const auto ry = __builtin_amdgcn_permlane32_swap(wb[2 * pr].y, wb[2 * pr + 1].y, false, false);
                *(u32x4*)(orow + 32 * db + 16 * pr + 8 * hh) = (u32x4){rx[0], ry[0], rx[1], ry[1]};
            }
        }
        if (IMG) {
            const auto a = __builtin_amdgcn_permlane32_swap(qi[0], qi[1], false, false); const auto b = __builtin_amdgcn_permlane32_swap(qi[2], qi[3], false, false);
            const auto x = __builtin_amdgcn_permlane32_swap(a[0], b[0], false, false); const auto y = __builtin_amdgcn_permlane32_swap(a[1], b[1], false, false);
            *(u32x4*)(o8 + 32 * db + 16 * hh) = (u32x4){x[0], y[0], x[1], y[1]};
        }
    }
}
__device__ __forceinline__ void zero_o(f32x16 (&o)[4]) {
#pragma unroll
    for (int db = 0; db < 4; ++db)
#pragma unroll
        for (int r = 0; r < 16; ++r) o[db][r] = 0.f;
}
constexpr float TINY = 1.17549435e-38f;

__device__ __forceinline__ const bf16_t* kvp(const bf16_t* base, size_t el) { return (const bf16_t*)((const unsigned char*)base + el * (KV8 ? 1 : 2)); }
struct L0Bufs { const bf16_t *QA, *KA, *VA, *QB, *KB, *KR, *VB; const float* sinks; bf16_t* O; };
__device__ __forceinline__ void item_A(const Frame& F, const L0Bufs& Bf, int b, int hk, int qt) {
    const int lane = F.lane, n = lane & 31, hh = lane >> 5, w = F.wave;
    const int tok = 64 * qt + 8 * w + (n & 7), head = 4 * hk + (n >> 3);
    const bf16_t* qrow = kvp(Bf.QA, ((size_t)b * S + tok) * 1024 + head * 128);
    float m = Bf.sinks[head] * LOG2E, l = 1.0f; f32x16 o[4]; zero_o(o);
    const int tlo = qt - 2 < 0 ? 0 : qt - 2;
    flash<M_A>(F, qrow, kvp(Bf.KA, (size_t)b * S * 256 + hk * 128), 256, nullptr, kvp(Bf.VA, (size_t)b * S * 256 + hk * 128), 256, nullptr, 0.f,
               tok, 64 * qt + 8 * w, 64 * qt + 8 * w + 7, tlo, qt + 1, 0ull, 0ull, 0.08838834764831845f * LOG2E, m, l, o);
    out_row<false, F8_WO0, F8_WO0>(Bf.O + ((size_t)b * S + tok) * D + head * 128, o, 1.0f / fmaxf(l, TINY), hh, F.ws + WS_O8 + ((size_t)b * S + tok) * D + head * 128);
}
__device__ __forceinline__ void item_B(const Frame& F, const L0Bufs& Bf, int b, int h, int qt) {
    const int lane = F.lane, n = lane & 31, hh = lane >> 5, w = F.wave;
    const int tok = 256 * qt + 32 * w + n;
    const bf16_t* qrow = kvp(Bf.QB, ((size_t)b * S + tok) * 1536 + h * 192);
    float m = -1e30f, l = 0.f; f32x16 o[4]; zero_o(o);
    flash<M_B>(F, qrow, kvp(Bf.KB, (size_t)b * S * 1024 + h * 128), 1024, kvp(Bf.KR, (size_t)b * S * 64), kvp(Bf.VB, (size_t)b * S * 1024 + h * 128), 1024, nullptr, 0.f,
               tok, 256 * qt + 32 * w, 256 * qt + 32 * w + 31, 0, 4 * (qt + 1), 0ull, 0ull, 0.07216878364870322f * LOG2E, m, l, o);
    out_row<false, F8_WO0, F8_WO0>(Bf.O + ((size_t)b * S + tok) * D + 1024 + h * 128, o, 1.0f / fmaxf(l, TINY), hh, F.ws + WS_O8 + ((size_t)b * S + tok) * D + 1024 + h * 128);
}
struct L1Bufs { const bf16_t *CQ, *CK, *CV, *DQ, *KS, *VS, *KW, *VW, *KCMP, *VCMP; const float *CUM, *DG; u64* SEL; bf16_t* O; };
__device__ __forceinline__ void item_C(const Frame& F, const L1Bufs& Bf, int b, int h, int qt) {
    const int lane = F.lane, n = lane & 31, hh = lane >> 5, w = F.wave;
    const int tok = 256 * qt + 32 * w + n;
    const bf16_t* qrow = kvp(Bf.CQ, ((size_t)b * S + tok) * 1024 + h * 128);
    const float* cumk = Bf.CUM + (size_t)(b * 8 + h) * S;
    float m = -1e30f, l = 0.f; f32x16 o[4]; zero_o(o);
    flash<M_C>(F, qrow, kvp(Bf.CK, (size_t)b * S * 1024 + h * 128), 1024, nullptr, kvp(Bf.CV, (size_t)b * S * 1024 + h * 128), 1024, cumk, cumk[tok],
               tok, 256 * qt + 32 * w, 256 * qt + 32 * w + 31, 0, 4 * (qt + 1), 0ull, 0ull, 0.08838834764831845f * LOG2E, m, l, o);
    out_row<false, F8_WO1, F8_WO1>(Bf.O + ((size_t)b * S + tok) * D + h * 128, o, 1.0f / fmaxf(l, TINY), hh, F.ws + WS_O8 + ((size_t)b * S + tok) * D + h * 128);
}
__device__ __forceinline__ void item_W(const Frame& F, const L1Bufs& Bf, int b, int hk, int qt) {
    const int lane = F.lane, n = lane & 31, hh = lane >> 5, w = F.wave;
    const int tok = 64 * qt + 8 * w + (n & 7), head = 4 * hk + (n >> 3);
    const bf16_t* qrow = Bf.DQ + ((size_t)b * S + tok) * 1024 + head * 128;
    float m = -1e30f, l = 0.f; f32x16 o[4]; zero_o(o);
    const int tlo = qt - 8 < 0 ? 0 : qt - 8;
    flash<M_W>(F, qrow, kvp(Bf.KW, (size_t)b * S * 256 + hk * 128), 256, nullptr, kvp(Bf.VW, (size_t)b * S * 256 + hk * 128), 256, nullptr, 0.f,
               tok, 64 * qt + 8 * w, 64 * qt + 8 * w + 7, tlo, qt + 1, 0ull, 0ull, 0.08838834764831845f * LOG2E, m, l, o);
    const float g2 = Bf.DG[((size_t)b * S + tok) * 24 + 16 + head];
    out_row<false>(Bf.O + ((size_t)b * S + tok) * D + 1024 + head * 128, o, g2 / fmaxf(l, TINY), hh);
}
__device__ __forceinline__ void item_S(const Frame& F, const L1Bufs& Bf, int b, int hk, int qt) {
    const int tid = F.tid, lane = F.lane, n = lane & 31, hh = lane >> 5, w = F.wave;
    const int tl = 8 * w + (n & 7), tok = 64 * qt + tl, gq = n >> 3, head = 4 * hk + gq;
    const bf16_t* qrow = Bf.DQ + ((size_t)b * S + tok) * 1024 + head * 128;
    LAS unsigned char* lds = F.lds;
    LAS float* imp = (LAS float*)(lds + LDS_IMP);
    LAS u64* selL = (LAS u64*)(lds + LDS_SEL);
    const float c2 = 0.08838834764831845f * LOG2E;
    bf16_t* orow = Bf.O + ((size_t)b * S + tok) * D + 1024 + head * 128;
    const int cmax = (64 * qt + 63 - 31) >> 4;
    const int ntile = (cmax >> 6) + 1;
    for (int i = tid; i < 64 * 64; i += NTHR) imp[i] = 0.f;
    {
        const bf16_t* kc = Bf.KCMP + (size_t)(b * 2 + hk) * 256 * 128; const bf16_t* vc = Bf.VCMP + (size_t)(b * 2 + hk) * 256 * 128;
        for (int c = tid; c < ntile * 1024; c += NTHR) { const int tt = c >> 10, cc = c & 1023, row = cc >> 4, c8 = cc & 15;
            *(LAS u32x4*)(lds + tt * 16384 + KSWZ(256, row, c8 * 16)) = *(const u32x4*)(kc + (size_t)(tt * 64 + row) * 128 + c8 * 8);
            *(LAS u32x4*)(lds + 65536 + tt * 16384 + VOFF(row, c8)) = *(const u32x4*)(vc + (size_t)(tt * 64 + row) * 128 + c8 * 8); }
    }
    __syncthreads();
    bf16x8 qf[8];
#pragma unroll
    for (int ks = 0; ks < 8; ++ks) qf[ks] = *(const bf16x8*)(qrow + 16 * ks + 8 * hh);
    int ka[4], va[8]; kv_addr<128>(lane, ka, va);
    const int cq = (tok - 31) >> 4;
    float m = -1e30f, l = 0.f;
    for (int tt = 0; tt < ntile; ++tt) {
        f32x16 p0, p1; qk_tile<128>(lds + tt * 16384, ka, qf, p0, p1);
        const int dq = cq - 64 * tt - 4 * hh; float pmax = -__builtin_inff();
#pragma unroll
        for (int r = 0; r < 16; ++r) { const int c = crow(r);
            p0[r] = (dq - c >= 0) ? p0[r] * c2 : -__builtin_inff(); p1[r] = (dq - c - 32 >= 0) ? p1[r] * c2 : -__builtin_inff(); pmax = fmaxf(pmax, fmaxf(p0[r], p1[r])); }
        pmax = fmaxf(pmax, __shfl_xor(pmax, 32));
        const float mn = fmaxf(m, pmax); float ps = 0.f;
#pragma unroll
        for (int r = 0; r < 16; ++r) ps += fast_exp2(p0[r] - mn) + fast_exp2(p1[r] - mn);
        ps += __shfl_xor(ps, 32);
        l = l * fast_exp2(m - mn) + ps; m = mn;
    }
    const float invl = 1.0f / fmaxf(l, TINY);
    f32x16 o[4]; zero_o(o);
    float carry = 0.f;
    for (int tt = 0; tt < ntile; ++tt) {
        f32x16 p0, p1; qk_tile<128>(lds + tt * 16384, ka, qf, p0, p1);
        const int dq = cq - 64 * tt - 4 * hh;
#pragma unroll
        for (int r = 0; r < 16; ++r) { const int c = crow(r);
            p0[r] = (dq - c >= 0) ? fast_exp2(p0[r] * c2 - m) * invl : 0.f; p1[r] = (dq - c - 32 >= 0) ? fast_exp2(p1[r] * c2 - m) * invl : 0.f; }
        float qs[8], e3[8];
#pragma unroll
        for (int q = 0; q < 4; ++q) { qs[q] = (p0[4 * q] + p0[4 * q + 1]) + (p0[4 * q + 2] + p0[4 * q + 3]); e3[q] = p0[4 * q + 3];
                                      qs[4 + q] = (p1[4 * q] + p1[4 * q + 1]) + (p1[4 * q + 2] + p1[4 * q + 3]); e3[4 + q] = p1[4 * q + 3]; }
        float pe[8];
#pragma unroll
        for (int q = 0; q < 8; ++q) pe[q] = __shfl_xor(e3[q], 32);
#pragma unroll
        for (int q = 0; q < 8; ++q) { const float add = hh ? pe[q] : (q > 0 ? pe[q - 1] : carry); float v = qs[q] + add;
            v += __shfl_xor(v, 8); v += __shfl_xor(v, 16);
            if (gq == 0) imp[tl * 64 + 16 * tt + 2 * q + hh] = v; }
        carry = pe[7];
        pv_tile(65536 + tt * 16384, va, p0, p1, o);
    }
    const float* dg = Bf.DG + ((size_t)b * S + tok) * 24;
    out_row<true>(orow, o, dg[head], hh);
    __syncthreads();
    {
        const int srow = tid >> 3, part = tid & 7, cur = qt;
        u64 mk = 1ull | (1ull << cur); if (cur >= 1) mk |= 1ull << (cur - 1);
        const int nvalid = cur + 1, ksel = nvalid < 8 ? nvalid : 8;
        const f32x4 i0 = *(const LAS f32x4*)(imp + srow * 64 + part * 8), i1 = *(const LAS f32x4*)(imp + srow * 64 + part * 8 + 4);
        const float iv[8] = {i0[0], i0[1], i0[2], i0[3], i1[0], i1[1], i1[2], i1[3]};
        unsigned lm = (unsigned)(mk >> (part * 8)) & 0xffu;
        unsigned vm = 0u;
#pragma unroll
        for (int i = 0; i < 8; ++i) vm |= (part * 8 + i <= cur) ? (1u << i) : 0u;
        for (int have = __popcll(mk); have < ksel; ++have) {
            float bv = -__builtin_inff(); int bi = 64;
#pragma unroll
            for (int i = 0; i < 8; ++i) if (((vm & ~lm) >> i) & 1u) { if (iv[i] > bv) { bv = iv[i]; bi = part * 8 + i; } }
#pragma unroll
            for (int off = 1; off < 8; off <<= 1) { const float ov = __shfl_xor(bv, off); const int oi = __shfl_xor(bi, off); if (ov > bv || (ov == bv && oi < bi)) { bv = ov; bi = oi; } }
            mk |= 1ull << bi; if ((bi >> 3) == part) lm |= 1u << (bi & 7);
        }
        if (part == 0) { selL[srow] = mk; Bf.SEL[(size_t)(b * 2 + hk) * S + 64 * qt + srow] = mk; }
    }
    __syncthreads();
    const u64 sel = selL[tl]; u64 selu = 0ull;
    for (int i = 0; i < 64; ++i) selu |= selL[i];
    __syncthreads();
    m = -1e30f; l = 0.f; zero_o(o);
    flash<M_S>(F, qrow, kvp(Bf.KS, (size_t)b * S * 256 + hk * 128), 256, nullptr, kvp(Bf.VS, (size_t)b * S * 256 + hk * 128), 256, nullptr, 0.f,
               tok, 64 * qt + 8 * w, 64 * qt + 8 * w + 7, 0, qt + 1, sel, selu, c2, m, l, o);
    out_row<true, F8_WO1>(orow, o, dg[8 + head] / fmaxf(l, TINY), hh, F.ws + WS_O8 + (size_t)(orow - Bf.O));
}
#undef KSWZ
#undef K8SWZ
#undef K8SWZ2
#undef V8OFF
#undef VOFF
}
__device__ __forceinline__ void router_phase(const Params& P, const Frame& F, int layer, const bf16_t* h) {
    unsigned char* ws = P.ws;
    const bf16_t* wrh = (const bf16_t*)(ws + WS_WRT) + (size_t)layer * 48 * 2048; const bf16_t* wrl = wrh + 2 * 48 * 2048;
    const float* gb = P.in[I_RGB] + layer * 4; const float* eb = P.in[I_REB] + layer * 32;
    float* rstdm = (float*)(ws + WS_RSTDM); int* slote = (int*)(ws + WS_SLOTE); int* slotr = (int*)(ws + WS_SLOTR);
    int* list = (int*)(ws + WS_LIST); float* wlist = (float*)(ws + WS_WLIST); float* rlist = (float*)(ws + WS_RLIST); unsigned* cntg = F.ctl + CW_CNT + layer * 32;
    LAS float* part = (LAS float*)F.lds;
    LAS float* ssqL = part + 2 * 64 * 48;
    LAS unsigned* cl = (LAS unsigned*)(ssqL + 128);
    LAS int* asg = (LAS int*)(cl + 64);
    LAS float* asw = (LAS float*)(asg + 256);
    const int tid = F.tid, lane = F.lane, w = F.wave, tg = w & 3, kh = w >> 2, li = lane & 15, kq = lane >> 4;
    for (int blk = F.bx; blk < T / 64; blk += F.G) {
        const int tok0 = blk * 64;
        if (tid < 32) cl[tid] = 0u;
        f32x4 acc[3]; acc[0] = acc[1] = acc[2] = (f32x4){0.f, 0.f, 0.f, 0.f}; float ss = 0.f;
        const bf16_t* hp = h + (size_t)(tok0 + 16 * tg + li) * D + kh * 1024 + 8 * kq;
        const bf16_t* wph = wrh + (size_t)li * 2048 + kh * 1024 + 8 * kq; const bf16_t* wpl = wrl + (size_t)li * 2048 + kh * 1024 + 8 * kq;
#pragma unroll 4
        for (int c = 0; c < 32; ++c) {
            const u32x4 au = *(const u32x4*)(hp + 32 * c); const bf16x8 a = __builtin_bit_cast(bf16x8, au);
            float av[8]; unpack8(au, av);
#pragma unroll
            for (int e = 0; e < 8; ++e) ss += av[e] * av[e];
#pragma unroll
            for (int nb = 0; nb < 3; ++nb) {
                const bf16x8 bh = *(const bf16x8*)(wph + (size_t)nb * 16 * 2048 + 32 * c), bl = *(const bf16x8*)(wpl + (size_t)nb * 16 * 2048 + 32 * c);
                acc[nb] = __builtin_amdgcn_mfma_f32_16x16x32_bf16(a, bh, acc[nb], 0, 0, 0);
                acc[nb] = __builtin_amdgcn_mfma_f32_16x16x32_bf16(a, bl, acc[nb], 0, 0, 0);
            }
        }
        ss += __shfl_xor(ss, 16); ss += __shfl_xor(ss, 32);
#pragma unroll
        for (int nb = 0; nb < 3; ++nb)
#pragma unroll
            for (int r = 0; r < 4; ++r) part[(kh * 64 + 16 * tg + 4 * kq + r) * 48 + 16 * nb + li] = acc[nb][r];
        if (kq == 0) ssqL[kh * 64 + 16 * tg + li] = ss;
        __syncthreads();
        if (tid < 64) {
            const int t = tok0 + tid;
            const float rs = __builtin_amdgcn_rsqf((ssqL[tid] + ssqL[64 + tid]) * (1.0f / D) + EPS);
            rstdm[t] = rs; asw[256 + tid] = rs;
            float lg[4]; int gi = 0;
#pragma unroll
            for (int c = 0; c < 4; ++c) lg[c] = rs * (part[tid * 48 + c] + part[(64 + tid) * 48 + c]) + gb[c];
#pragma unroll
            for (int c = 1; c < 4; ++c) gi = lg[c] > lg[gi] ? c : gi;
            float gden = 0.f;
#pragma unroll
            for (int c = 0; c < 4; ++c) gden += __expf(lg[c] - lg[gi]);
            const float gval = 1.0f / gden;
            float el[8];
#pragma unroll
            for (int c = 0; c < 8; ++c) el[c] = rs * (part[tid * 48 + 4 + gi * 8 + c] + part[(64 + tid) * 48 + 4 + gi * 8 + c]) + eb[gi * 8 + c];
            int e0 = 0;
#pragma unroll
            for (int c = 1; c < 8; ++c) e0 = el[c] > el[e0] ? c : e0;
            int e1 = e0 == 0 ? 1 : 0;
#pragma unroll
            for (int c = 0; c < 8; ++c) e1 = (c != e0 && el[c] > el[e1]) ? c : e1;
            const float x1 = __expf(el[e1] - el[e0]);
            const float w0 = gval / (1.0f + x1), w1 = gval * x1 / (1.0f + x1);
            const int E0 = gi * 8 + e0, E1 = gi * 8 + e1;
            asg[tid * 2] = E0; asg[tid * 2 + 1] = E1; asw[tid * 2] = w0; asw[tid * 2 + 1] = w1;
            asg[128 + tid * 2] = (int)atomicAdd((unsigned*)&cl[E0], 1u); asg[128 + tid * 2 + 1] = (int)atomicAdd((unsigned*)&cl[E1], 1u);
        }
        __syncthreads();
        if (tid < 32) { const unsigned n = cl[tid]; cl[32 + tid] = n ? atomicAdd(&cntg[tid], n) : 0u; }
        __syncthreads();
        if (tid < 128) { const int t = tok0 + (tid >> 1), e = asg[tid], r = (int)cl[32 + e] + asg[128 + tid];
            list[(size_t)e * T + r] = t; wlist[(size_t)e * T + r] = asw[tid]; rlist[(size_t)e * T + r] = asw[256 + (tid >> 1)]; slote[t * 2 + (tid & 1)] = e; slotr[t * 2 + (tid & 1)] = r; }
        __syncthreads();
    }
}
__device__ __forceinline__ int moe_tables(const Frame& F, int layer) {
    volatile LAS unsigned* ord = (volatile LAS unsigned*)(F.lds + LDS_ORD);
    __syncthreads();
    if (F.tid < 64) {
        const int e = F.tid & 31;
        const unsigned n = __hip_atomic_load(F.ctl + CW_CNT + layer * 32 + e, __ATOMIC_RELAXED, __HIP_MEMORY_SCOPE_AGENT);
        const int nt = (int)((n + 255u) >> 8), nfu = (int)(n >> 8), r = (int)(n & 255u), nh = (r > 0) + (r > 128);
        int pt = nt, pf = nfu, ph = nh;
#pragma unroll
        for (int o = 1; o < 32; o <<= 1) { const int a = __shfl_up(pt, o), b = __shfl_up(pf, o), c = __shfl_up(ph, o); if ((F.tid & 31) >= o) { pt += a; pf += b; ph += c; } }
        const int tot_f = __shfl(pf, 31), tot_h = __shfl(ph, 31), tot = __shfl(pt, 31);
        if (F.tid < 32) {
            const int t0 = pt - nt;
            F.misc[MW_CNT + e] = n; F.misc[MW_TAB + e] = (unsigned)t0; if (e == 31) { F.misc[MW_TAB + NEXP] = (unsigned)tot; F.misc[MW_NORD] = (unsigned)(tot_f + tot_h); }
            for (int k = 0; k < nfu; ++k) ord[(pf - nfu) + k] = (unsigned)(t0 + k) | ((unsigned)e << 8);
            if (nh > 0) ord[tot_f + (ph - nh)] = (unsigned)(t0 + nfu) | ((unsigned)e << 8) | (1u << 16);
            if (nh > 1) ord[tot_f + (ph - nh) + 1] = (unsigned)(t0 + nfu) | ((unsigned)e << 8) | (2u << 16);
        }
    }
    __syncthreads();
    return __builtin_amdgcn_readfirstlane((int)F.misc[MW_NORD]);
}
__device__ __forceinline__ void unpack8_f8(const u32x2 w, float (&v)[8]) {
    const f32x2 a = __builtin_amdgcn_cvt_pk_f32_fp8((int)w.x, false), b = __builtin_amdgcn_cvt_pk_f32_fp8((int)w.x, true), c = __builtin_amdgcn_cvt_pk_f32_fp8((int)w.y, false), d = __builtin_amdgcn_cvt_pk_f32_fp8((int)w.y, true);
    v[0] = a[0]; v[1] = a[1]; v[2] = b[0]; v[3] = b[1]; v[4] = c[0]; v[5] = c[1]; v[6] = d[0]; v[7] = d[1]; }
template <bool F8Y>
__device__ __forceinline__ void combine_phase(const Params& P, const Frame& F, const bf16_t* hin, bf16_t* hout, unsigned char* h8) {
    unsigned char* ws = P.ws; const bf16_t* Y = (const bf16_t*)(ws + SM_Y);
    const int* slote = (const int*)(ws + WS_SLOTE); const int* slotr = (const int*)(ws + WS_SLOTR); float* rstdp = (float*)(ws + WS_RSTDP);
    const int step = F.G * 8;
    for (int t0 = F.bx * 8 + F.wave; t0 < T; t0 += 2 * step) {
        const int t1 = t0 + step; const bool two = t1 < T; const int tb = two ? t1 : t0;
        const int ea0 = slote[t0 * 2], ea1 = slote[t0 * 2 + 1], eb0 = slote[tb * 2], eb1 = slote[tb * 2 + 1];
        const size_t ra0 = (size_t)F.misc[MW_TAB + ea0] * 256 + slotr[t0 * 2], ra1 = (size_t)F.misc[MW_TAB + ea1] * 256 + slotr[t0 * 2 + 1];
        const size_t rb0 = (size_t)F.misc[MW_TAB + eb0] * 256 + slotr[tb * 2], rb1 = (size_t)F.misc[MW_TAB + eb1] * 256 + slotr[tb * 2 + 1];
        u32x4 ya0[4], ya1[4], ha[4], yb0[4], yb1[4], hb_[4];
#pragma unroll
        for (int j = 0; j < 4; ++j) { const int c = 8 * (F.lane + 64 * j);
            if (F8Y) { const unsigned char* Y8 = (const unsigned char*)Y; ya0[j].x = ((const u32x2*)(Y8 + ra0 * D + c))->x; ya0[j].y = ((const u32x2*)(Y8 + ra0 * D + c))->y; ya1[j].x = ((const u32x2*)(Y8 + ra1 * D + c))->x; ya1[j].y = ((const u32x2*)(Y8 + ra1 * D + c))->y;
                       yb0[j].x = ((const u32x2*)(Y8 + rb0 * D + c))->x; yb0[j].y = ((const u32x2*)(Y8 + rb0 * D + c))->y; yb1[j].x = ((const u32x2*)(Y8 + rb1 * D + c))->x; yb1[j].y = ((const u32x2*)(Y8 + rb1 * D + c))->y; }
            else { ya0[j] = *(const u32x4*)(Y + ra0 * D + c); ya1[j] = *(const u32x4*)(Y + ra1 * D + c); yb0[j] = *(const u32x4*)(Y + rb0 * D + c); yb1[j] = *(const u32x4*)(Y + rb1 * D + c); }
            ha[j] = *(const u32x4*)(hin + (size_t)t0 * D + c); hb_[j] = *(const u32x4*)(hin + (size_t)tb * D + c); }
        float ssa = 0.f, ssb = 0.f;
#pragma unroll
        for (int j = 0; j < 4; ++j) { const int c = 8 * (F.lane + 64 * j); const size_t o = (size_t)t0 * D + c;
            float y0[8], y1[8], v[8]; if (F8Y) { unpack8_f8((u32x2){ya0[j].x, ya0[j].y}, y0); unpack8_f8((u32x2){ya1[j].x, ya1[j].y}, y1); } else { unpack8(ya0[j], y0); unpack8(ya1[j], y1); } unpack8(ha[j], v);
#pragma unroll
            for (int e = 0; e < 8; ++e) { v[e] = F8Y ? fmaf(y0[e] + y1[e], 1.0f / F8_OSC, v[e]) : v[e] + y0[e] + y1[e]; ssa += v[e] * v[e]; }
            *(u32x4*)(hout + o) = pack8(v); if (h8) *(u32x2*)(h8 + o) = pack8_f8(v); }
        if (two) {
#pragma unroll
            for (int j = 0; j < 4; ++j) { const int c = 8 * (F.lane + 64 * j); const size_t o = (size_t)t1 * D + c;
                float y0[8], y1[8], v[8]; if (F8Y) { unpack8_f8((u32x2){yb0[j].x, yb0[j].y}, y0); unpack8_f8((u32x2){yb1[j].x, yb1[j].y}, y1); } else { unpack8(yb0[j], y0); unpack8(yb1[j], y1); } unpack8(hb_[j], v);
#pragma unroll
                for (int e = 0; e < 8; ++e) { v[e] = F8Y ? fmaf(y0[e] + y1[e], 1.0f / F8_OSC, v[e]) : v[e] + y0[e] + y1[e]; ssb += v[e] * v[e]; }
                *(u32x4*)(hout + o) = pack8(v); if (h8) *(u32x2*)(h8 + o) = pack8_f8(v); }
        }
#pragma unroll
        for (int o = 32; o > 0; o >>= 1) { ssa += __shfl_xor(ssa, o); ssb += __shfl_xor(ssb, o); }
        if (F.lane == 0) { rstdp[t0] = __builtin_amdgcn_rsqf(ssa * (1.0f / D) + EPS); if (two) rstdp[t1] = __builtin_amdgcn_rsqf(ssb * (1.0f / D) + EPS); }
    }
}
__device__ __forceinline__ void final_norm_phase(const Params& P, const Frame& F, const bf16_t* hin) {
    float* out = P.out; const float* g = P.in[I_FINN];
    const int step = F.G * 8;
    f32x4 g0[4], g1[4];
#pragma unroll
    for (int j = 0; j < 4; ++j) { const int c = 8 * (F.lane + 64 * j); g0[j] = *(const f32x4*)(g + c); g1[j] = *(const f32x4*)(g + c + 4); }
    for (int t0 = F.bx * 8 + F.wave; t0 < T; t0 += 2 * step) {
        const int t1 = t0 + step; const bool two = t1 < T; const int tb = two ? t1 : t0;
        u32x4 wa[4], wb[4];
#pragma unroll
        for (int j = 0; j < 4; ++j) { wa[j] = *(const u32x4*)(hin + (size_t)t0 * D + 8 * (F.lane + 64 * j)); wb[j] = *(const u32x4*)(hin + (size_t)tb * D + 8 * (F.lane + 64 * j)); }
#pragma unroll
        for (int k = 0; k < 2; ++k) {
            if (k == 1 && !two) break;
            const int t = k ? t1 : t0;
            float v[4][8]; float ss = 0.f;
#pragma unroll
            for (int j = 0; j < 4; ++j) { unpack8(k ? wb[j] : wa[j], v[j]);
#pragma unroll
                for (int e = 0; e < 8; ++e) ss += v[j][e] * v[j][e]; }
#pragma unroll
            for (int o = 32; o > 0; o >>= 1) ss += __shfl_xor(ss, o);
            const float rs = __builtin_amdgcn_rsqf(ss * (1.0f / D) + EPS);
#pragma unroll
            for (int j = 0; j < 4; ++j) { const int c = 8 * (F.lane + 64 * j);
                __builtin_nontemporal_store((f32x4){v[j][0] * rs * g0[j][0], v[j][1] * rs * g0[j][1], v[j][2] * rs * g0[j][2], v[j][3] * rs * g0[j][3]}, (f32x4*)(out + (size_t)t * D + c));
                __builtin_nontemporal_store((f32x4){v[j][4] * rs * g1[j][0], v[j][5] * rs * g1[j][1], v[j][6] * rs * g1[j][2], v[j][7] * rs * g1[j][3]}, (f32x4*)(out + (size_t)t * D + c + 4)); }
        }
    }
}
__device__ __forceinline__ void cumsum_seq(const Params& P, const Frame& F, int seq) {
    const float* lf = (const float*)(P.ws + S1_LF); float* cum = (float*)(P.ws + S1_CUM);
    LAS float* sc = (LAS float*)F.lds;
    const int b = seq >> 3, hd = seq & 7, tid = F.tid;
    float v[8], run = 0.f;
#pragma unroll
    for (int i = 0; i < 8; ++i) { run += lf[((size_t)b * S + tid * 8 + i) * 8 + hd]; v[i] = run; }
    sc[tid] = run; __syncthreads();
    if (tid == 0) { float r = 0.f; for (int i = 0; i < NTHR; ++i) { const float x = sc[i]; sc[i] = r; r += x; } }
    __syncthreads();
    const float base = sc[tid];
#pragma unroll
    for (int i = 0; i < 8; ++i) cum[(size_t)seq * S + tid * 8 + i] = (base + v[i]) * LOG2E;
    __syncthreads();
}
__device__ __forceinline__ int queue_next(const Frame& F, int q) {
    __syncthreads();
    if (F.tid == 0) F.misc[MW_ITEM] = atomicAdd(F.ctl + CW_QUEUE + 64 * q, 1u);
    __syncthreads();
    return __builtin_amdgcn_readfirstlane((int)F.misc[MW_ITEM]);
}
__device__ __forceinline__ int queue_next1(const Frame& F, int q, unsigned& n) {
    const int slot = MW_ITEM + (int)(n & 1u); ++n;
    if (F.tid == 0) F.misc[slot] = atomicAdd(F.ctl + CW_QUEUE + 64 * q, 1u);
    __syncthreads();
    return __builtin_amdgcn_readfirstlane((int)F.misc[slot]);
}
constexpr int NPHASE = 21;
constexpr int PP1_GU_V0 = 160;
__device__ __forceinline__ int pp1_gu(int G) { return G == 256 ? 2 * (256 - PP1_GU_V0) : 0; }
__device__ __forceinline__ int pp1_tail(int G) { const int nfull = ((NIN1 / 256) * (T / 256)) % G; int n = 2 * (G - nfull); const int all = (T / 256) * (D / 256); return n < all ? n : all; }
__global__ void __launch_bounds__(NTHR, 2) mega_fwd(Params P) {
    extern __shared__ __attribute__((aligned(16))) unsigned char lds_raw[];
    Frame F;
    F.lds = (LAS unsigned char*)lds_raw; F.misc = (volatile LAS unsigned*)(F.lds + LDS_MISC);
    F.tid = threadIdx.x; F.lane = F.tid & 63; F.wave = __builtin_amdgcn_readfirstlane(F.tid >> 6);
    F.G = gridDim.x; F.bx = blockIdx.x; F.vcu = (F.G % 8 == 0) ? (F.bx % 8) * (F.G / 8) + F.bx / 8 : F.bx;
    F.ws = P.ws; F.ctl = (unsigned*)(P.ws + WS_CTL);
    unsigned char* ws = P.ws;
    for (int u = F.tid; u < 256; u += NTHR) F.misc[u] = 0u;
    __syncthreads();
    const int lo = P.ph_lo, hi = P.ph_hi;
    const bool fused = (hi - lo) > 1;
    XcdBarrier bar; bar.bar = F.ctl + CW_BAR; bar.x = 0; bar.st = F.misc + MW_BAR;
    if (fused) bar = xcd_barrier_post(F.ctl + CW_BAR, F.misc + MW_BAR);
#define IN(k) (lo <= (k) && (k) < hi)
#define SEAM(k) do { if (IN((k) + 1)) xcd_barrier(bar); } while (0)
    LAS unsigned char* stage = F.lds + LDS_STAGE;
    bf16_t* hbA = (bf16_t*)(ws + WS_HBA); bf16_t* hbB = (bf16_t*)(ws + WS_HBB); unsigned char* h8A = ws + WS_H8A; unsigned char* h8B = ws + WS_H8B;
    const float* c128 = (const float*)(ws + WS_COS128); const float* s128 = (const float*)(ws + WS_SIN128);
    const float* c64 = (const float*)(ws + WS_COS64); const float* s64 = (const float*)(ws + WS_SIN64);

    if (IN(0)) { p0_prologue(P, F); SEAM(0); }

    if (IN(1)) {
        pg8::PlainOrder S; S.init(F8_IN0 ? (const bf16_t*)h8A : hbA, F8_IN0 ? D / 2 : D, (const bf16_t*)(ws + WS_WIN0T), F8_IN0 ? D / 2 : D, T, NIN0, F.G, F.bx);
        epi::In0 E{(const float*)(ws + WS_RSTD0), c128, s128, c64, s64, (bf16_t*)(ws + S0_QA), (bf16_t*)(ws + S0_KA), (bf16_t*)(ws + S0_VTA), (bf16_t*)(ws + S0_QLAT), (bf16_t*)(ws + S0_KVLAT),
                   (bf16_t*)(ws + S0_KB + (size_t)T * 1024 * (KV8 ? 1 : 2)), (float*)(ws + WS_SSQQ), (float*)(ws + WS_SSQKV)};
        pg8::gemm_phase_t<F8_IN0>(stage, F8_IN0 ? D / 2 : D, S, E, F8_SC_IN1);
        if (F.bx >= F.G / 2) p0_rest(P, F, F.bx - F.G / 2, F.G - F.G / 2);
        unsigned qn4 = 0;
        for (;;) { const int i = queue_next1(F, 4, qn4); if (i >= (NCONV_FG - 320 + 1) / 2) break;
            Frame Fi = F; asm volatile("" : "+v"(Fi.tid), "+v"(Fi.lane));
            const int t0 = 320 + 2 * i; conv_range(P, Fi.tid, t0, 1, t0 + 2 < NCONV_FG ? t0 + 2 : NCONV_FG, -1); }
        SEAM(1);
    }
    if (IN(2)) {
        { pg8::PlainOrder S; S.init((const bf16_t*)(ws + S0_QLAT), 512, (const bf16_t*)(ws + WS_WUQT), 512, T, 1536, F.G, F.bx);
          epi::Uq E{(const float*)(ws + WS_SSQQ), c64, s64, (bf16_t*)(ws + S0_QB)};
          pg8::gemm_phase(stage, 512, S, E); }
        { pg8::PlainOrder S; S.init((const bf16_t*)(ws + S0_KVLAT), 256, (const bf16_t*)(ws + WS_WUKVT), 256, T, 2048, F.G, F.bx);
          epi::Ukv E{(const float*)(ws + WS_SSQKV), (bf16_t*)(ws + S0_KB), (bf16_t*)(ws + S0_VTB)};
          pg8::gemm_phase(stage, 256, S, E); }
        {
          pg8::PlainOrder S; S.init((const bf16_t*)(ws + WS_PB), 256, (const bf16_t*)(ws + WS_WPPT), 256, T, D, F.G, F.bx);
          const int nlo = F.G / 2, nhi = F.G - nlo, chi = (S.nwg * 3) / 4;
          if (F.bx >= nlo) S.sub(0, chi, nhi, F.bx - nlo); else S.sub(chi, S.nwg - chi, nlo, F.bx);
          epi::PlainBf16 E{(bf16_t*)(ws + WS_PP), D};
          pg8::gemm_phase(stage, 256, S, E); }
        if (F.bx == 0) {
            const float* part = (const float*)(ws + WS_SSQP); float* cb = (float*)(ws + WS_CBIAS);
            float a = 0.f;
#pragma unroll
            for (int kp = 0; kp < 64; ++kp) a += part[kp * 512 + F.tid];
            cb[F.tid] = a;
        }
        SEAM(2);
    }
    if (IN(3)) {
        const att::L0Bufs Bf{(const bf16_t*)(ws + S0_QA), (const bf16_t*)(ws + S0_KA), (const bf16_t*)(ws + S0_VTA), (const bf16_t*)(ws + S0_QB), (const bf16_t*)(ws + S0_KB), (const bf16_t*)(ws + S0_KB + (size_t)T * 1024 * (KV8 ? 1 : 2)), (const bf16_t*)(ws + S0_VTB),
                             P.in[I_SINKS], (bf16_t*)(ws + S0_O)};
        unsigned qn0 = 0;
        for (;;) { const int p = queue_next1(F, 0, qn0); if (p >= 2560) break;
            Frame Fi = F; asm volatile("" : "+v"(Fi.tid), "+v"(Fi.lane));
            if (p < 2048) { if ((p & 3) == 0) { const int idx = p >> 2, qt = 15 - (idx >> 5), bh = idx & 31; att::item_B(Fi, Bf, bh >> 3, bh & 7, qt); }
                            else { const int cc = (p >> 2) * 3 + (p & 3) - 1; conv_range(P, Fi.tid, 4 * cc, 1, 4 * cc + 4, 0); } }
            else { const int ia = p - 2048, qt = 63 - (ia >> 3), bhk = ia & 7; att::item_A(Fi, Bf, bhk >> 1, bhk & 1, qt); } }
        SEAM(3);
    }
    if (IN(4)) {
        { pg8::PlainOrder S; S.init(F8_WO0 ? (const bf16_t*)(ws + WS_O8) : (const bf16_t*)(ws + S0_O), F8_WO0 ? D / 2 : D, (const bf16_t*)(ws + WS_WO0T), F8_WO0 ? D / 2 : D, T, D, F.G, F.bx);
          epi::Wo<true> E{P.in[I_X], hbB, F8_MOE0 ? h8B : nullptr};
          pg8::gemm_phase_t<F8_WO0>(stage, F8_WO0 ? D / 2 : D, S, E, F8_SC_WO); }
        SEAM(4);
    }
#define MOE_PLE_PHASES(PH, LAYER, HB_IN, HB_MID, HB_OUT, H8_IN, H8_MID, H8_OUT, F8M, F8P, F8Y)                                                                             \
    if (IN((PH) + 0)) { router_phase(P, F, (LAYER), (HB_IN)); SEAM((PH) + 0); }                                                                                       \
    if (IN((PH) + 1)) { const int nrt = moe_tables(F, (LAYER));                                                                                                       \
        pg8::MoeOrder<true, 4> S{(F8M) ? (const bf16_t*)(H8_IN) : (HB_IN), (const bf16_t*)(ws + WS_WGU) + (size_t)(LAYER) * 32 * 1024 * 2048, (F8M) ? D / 2 : D, (F8M) ? D / 2 : D, \
                                 (F8M) ? (size_t)1024 * 1024 : (size_t)1024 * 2048, (const int*)(ws + WS_LIST), F.misc + MW_TAB, F.misc + MW_CNT, (volatile LAS unsigned*)(F.lds + LDS_ORD), F.G, F.vcu, nrt * 4};                             \
        epi::MoeGu<F8M> E{(const float*)(ws + WS_RLIST), F.misc + MW_CNT, (bf16_t*)(ws + SM_H)};                                                                      \
        pg8::gemm_phase_t<F8M>(stage, (F8M) ? D / 2 : D, S, E, F8_SC_GU);                                                                                              \
        if ((LAYER) == 0 && pp1_gu(F.G) > 0 && F.vcu >= PP1_GU_V0) { pg8::PlainOrder S2; S2.init((const bf16_t*)(ws + WS_PB) + (size_t)T * 256, 256, (const bf16_t*)(ws + WS_WPPT) + (size_t)2048 * 256, 256, T, D, F.G, F.bx); \
            S2.sub(0, pp1_gu(F.G), F.G - PP1_GU_V0, F.vcu - PP1_GU_V0); epi::PlainBf16 E2{(bf16_t*)(ws + WS_PP1), D}; pg8::gemm_phase(stage, 256, S2, E2); }                         \
        SEAM((PH) + 1); }                                                                           \
    if (IN((PH) + 2)) { const int nrt = moe_tables(F, (LAYER));                                                                                                       \
        pg8::MoeOrder<false, 8> S{(const bf16_t*)(ws + SM_H), (const bf16_t*)(ws + WS_WDN) + (size_t)(LAYER) * 32 * 2048 * 512, (F8M) ? EH / 2 : EH, (F8M) ? EH / 2 : EH, \
                                  (size_t)2048 * 512, (const int*)(ws + WS_LIST), F.misc + MW_TAB, F.misc + MW_CNT, (volatile LAS unsigned*)(F.lds + LDS_ORD), F.G, F.vcu, nrt * 8};                             \
        epi::MoeDn<F8Y> E{(const float*)(ws + WS_WLIST), F.misc + MW_CNT, (bf16_t*)(ws + SM_Y)};                                                                           \
        pg8::gemm_phase_t<F8M>(stage, (F8M) ? EH / 2 : EH, S, E, F8_SC_DN); SEAM((PH) + 2); }                                                                         \
    if (IN((PH) + 3)) { (void)moe_tables(F, (LAYER)); combine_phase<F8Y>(P, F, (HB_IN), (HB_MID), (F8P) ? (H8_MID) : nullptr); SEAM((PH) + 3); }                           \
    if (IN((PH) + 4)) { pg8::PlainOrder S; S.init((F8P) ? (const bf16_t*)(H8_MID) : (HB_MID), (F8P) ? D / 2 : D, (const bf16_t*)(ws + WS_WPGT) + (size_t)(LAYER) * 2048 * 2048, (F8P) ? D / 2 : D, T, D, F.G, F.bx); \
        epi::Ple E{(const float*)(ws + WS_RSTDP), (const bf16_t*)(ws + ((LAYER) ? WS_PP1 : WS_PP)), (HB_MID), (HB_OUT), (LAYER) == 0 ? (float*)(ws + WS_SSQP) : (float*)nullptr, (H8_OUT)};                                 \
        pg8::gemm_phase_t<F8P>(stage, (F8P) ? D / 2 : D, S, E, F8_SC_PG); SEAM((PH) + 4); }

    MOE_PLE_PHASES(5, 0, hbB, hbA, hbB, h8B, h8A, (F8_IN1 ? h8B : nullptr), F8_MOE0, F8_PLE0, false)

    if (IN(10)) {
        pg8::PlainOrder S; S.init(F8_IN1 ? (const bf16_t*)h8B : hbB, F8_IN1 ? D / 2 : D, (const bf16_t*)(ws + WS_WIN1T), F8_IN1 ? D / 2 : D, T, NIN1, F.G, F.bx);
        epi::In1 E{(const float*)(ws + WS_SSQP), c128, s128, P.in[I_FB], (bf16_t*)(ws + S1_CQ), (bf16_t*)(ws + S1_CK), (bf16_t*)(ws + S1_CVT), (bf16_t*)(ws + S1_DQ), (bf16_t*)(ws + S1_KC), (bf16_t*)(ws + S1_VC),
                   (bf16_t*)(ws + S1_KS), (bf16_t*)(ws + S1_VST), (bf16_t*)(ws + S1_KW), (bf16_t*)(ws + S1_VWT), (float*)(ws + S1_LF), (float*)(ws + S1_DG)};
        pg8::gemm_phase_t<F8_IN1>(stage, F8_IN1 ? D / 2 : D, S, E, F8_SC_IN1);
        {
          const int nfull = S.nwg % F.G;
          if (nfull > 0) {
              pg8::PlainOrder S2; S2.init((const bf16_t*)(ws + WS_PB) + (size_t)T * 256, 256, (const bf16_t*)(ws + WS_WPPT) + (size_t)2048 * 256, 256, T, D, F.G, F.bx);
              S2.sub(pp1_gu(F.G), pp1_tail(F.G), F.G - nfull, F.bx >= nfull ? F.bx - nfull : -1);
              epi::PlainBf16 E2{(bf16_t*)(ws + WS_PP1), D};
              pg8::gemm_phase(stage, 256, S2, E2); } }
        SEAM(10);
    }
    const att::L1Bufs B1{(const bf16_t*)(ws + S1_CQ), (const bf16_t*)(ws + S1_CK), (const bf16_t*)(ws + S1_CVT), (const bf16_t*)(ws + S1_DQ), (const bf16_t*)(ws + S1_KS), (const bf16_t*)(ws + S1_VST),
                         (const bf16_t*)(ws + S1_KW), (const bf16_t*)(ws + S1_VWT), (const bf16_t*)(ws + S1_KCMP), (const bf16_t*)(ws + S1_VCMPT), (const float*)(ws + S1_CUM), (const float*)(ws + S1_DG),
                         (u64*)(ws + S1_SEL), (bf16_t*)(ws + S1_O)};
    if (IN(11)) {
        const int cv = (F.bx + F.G - 16) % F.G;
        { pg8::HalfOrder S{(const bf16_t*)(ws + S1_KC), (const bf16_t*)(ws + WS_WC1KT), F8_CMP ? 1024 : 2048, 16, F.G, F.bx};
          epi::Cmp1<true> E{(const float*)(ws + WS_CBIAS), (bf16_t*)(ws + S1_HID)};
          pg8::gemm_phase_t<F8_CMP>(stage, F8_CMP ? 2048 : 4096, S, E, F8_SC_IN1); }
        { pg8::HalfOrder S{(const bf16_t*)(ws + S1_VC), (const bf16_t*)(ws + WS_WC1VT), F8_CMP ? 1024 : 2048, 16, F.G, cv};
          epi::Cmp1<true> E{(const float*)(ws + WS_CBIAS) + 256, (bf16_t*)(ws + S1_HID) + (size_t)2048 * 256};
          pg8::gemm_phase_t<F8_CMP>(stage, F8_CMP ? 2048 : 4096, S, E, F8_SC_IN1); }
        if (F.bx < 32) { asm volatile("s_waitcnt vmcnt(0)" ::: "memory"); __syncthreads(); __builtin_amdgcn_fence(__ATOMIC_ACQUIRE, "agent"); asm volatile("s_waitcnt vmcnt(0)" ::: "memory"); __syncthreads(); }
        { pg8::HalfOrder S{(const bf16_t*)(ws + S1_HID), (const bf16_t*)(ws + WS_WC2KT), 256, 16, F.G, F.bx};
          epi::Cmp2<true, true> E{c128, s128, (bf16_t*)(ws + S1_KCMP)};
          pg8::gemm_phase(stage, 256, S, E); }
        { pg8::HalfOrder S{(const bf16_t*)(ws + S1_HID) + (size_t)2048 * 256, (const bf16_t*)(ws + WS_WC2VT), 256, 16, F.G, cv};
          epi::Cmp2<false, true> E{c128, s128, (bf16_t*)(ws + S1_VCMPT)};
          pg8::gemm_phase(stage, 256, S, E); }
        if (F.bx >= 32 && F.bx < 64) cumsum_seq(P, F, F.bx - 32);
        if (F.bx >= 32) {
          pg8::PlainOrder S; S.init((const bf16_t*)(ws + WS_PB) + (size_t)T * 256, 256, (const bf16_t*)(ws + WS_WPPT) + (size_t)2048 * 256, 256, T, D, F.G - 32, F.bx - 32);
          { const int done = pp1_gu(F.G) + (((NIN1 / 256) * (T / 256)) % F.G > 0 ? pp1_tail(F.G) : 0); S.sub(done, S.nwg - done, F.G - 32, F.bx - 32); }
          epi::PlainBf16 E{(bf16_t*)(ws + WS_PP1), D};
          pg8::gemm_phase(stage, 256, S, E); }
        unsigned qn1 = 0;
        for (;;) { const int idx = queue_next1(F, 1, qn1); if (idx >= 512) break;
            Frame Fi = F; asm volatile("" : "+v"(Fi.tid), "+v"(Fi.lane));
            const int qt = 63 - (idx >> 3), bhk = idx & 7; att::item_W(Fi, B1, bhk >> 1, bhk & 1, qt); }
        SEAM(11);
    }
    if (IN(13)) {
        unsigned qn2 = 0;
        for (;;) { const int p = queue_next1(F, 2, qn2); if (p >= 2560) break;
            Frame Fi = F; asm volatile("" : "+v"(Fi.tid), "+v"(Fi.lane));
            if (p < 2048 && (p & 3) != 0) { const int cc = (p >> 2) * 3 + (p & 3) - 1; conv_range(P, Fi.tid, 4 * cc, 1, 4 * cc + 4, 1); }
            else { const int idx = p < 2048 ? (p >> 2) : 512 + (p - 2048); const int k = idx >> 1;
                if (!(idx & 1)) { const int qt = 15 - (k >> 5), bh = k & 31; att::item_C(Fi, B1, bh >> 3, bh & 7, qt); }
                else { const int qt = 63 - (k >> 3), bhk = k & 7; att::item_S(Fi, B1, bhk >> 1, bhk & 1, qt); } } }
        SEAM(13);
    }
    if (IN(14)) {
        { pg8::PlainOrder S; S.init(F8_WO1 ? (const bf16_t*)(ws + WS_O8) : (const bf16_t*)(ws + S1_O), F8_WO1 ? D / 2 : D, (const bf16_t*)(ws + WS_WO1T), F8_WO1 ? D / 2 : D, T, D, F.G, F.bx);
          epi::Wo<false> E{hbB, hbA, F8_MOE1 ? h8A : nullptr};
          pg8::gemm_phase_t<F8_WO1>(stage, F8_WO1 ? D / 2 : D, S, E, F8_SC_WO); }
        SEAM(14);
    }
    MOE_PLE_PHASES(15, 1, hbA, hbB, hbA, h8A, h8B, ((unsigned char*)nullptr), F8_MOE1, F8_PLE1, F8_Y1)
    if (IN(20)) { final_norm_phase(P, F, hbA); }
#undef IN
#undef SEAM
}

extern "C" void kernel_launch(void* const* d_in, const int* in_sizes, int n_in, void* d_out, int out_size, void* d_ws, size_t ws_size, hipStream_t stream) {
    static int grid = 0;
    if (grid == 0) {
        if (n_in != 32 || out_size != T * D || ws_size < WS_END) { fprintf(stderr, "kernel_launch: unexpected problem (n_in %d, out %d, ws %zu < %zu)\n", n_in, out_size, ws_size, (size_t)WS_END); grid = -1; return; }
        int dev = 0, cus = 0, per_cu = 0;
        if (hipGetDevice(&dev) != hipSuccess || hipDeviceGetAttribute(&cus, hipDeviceAttributeMultiprocessorCount, dev) != hipSuccess) { grid = -1; return; }
        if (hipFuncSetAttribute((const void*)mega_fwd, hipFuncAttributeMaxDynamicSharedMemorySize, LDS_BYTES) != hipSuccess) { fprintf(stderr, "kernel_launch: hipFuncSetAttribute failed\n"); grid = -1; return; }
        if (hipOccupancyMaxActiveBlocksPerMultiprocessor(&per_cu, (const void*)mega_fwd, NTHR, LDS_BYTES) != hipSuccess || per_cu < 1) fprintf(stderr, "kernel_launch: occupancy query says %d\n", per_cu);
        (void)hipGetLastError();
        grid = cus;
    }
    if (grid < 0) return;
    (void)in_sizes;
    if (hipMemsetAsync((char*)d_ws + WS_CTL, 0, CTL_BYTES, stream) != hipSuccess) return;
    Params p{};
    for (int i = 0; i < 32; ++i) p.in[i] = (const float*)d_in[i];
    p.out = (float*)d_out; p.ws = (unsigned char*)d_ws;
    p.ph_lo = 0; p.ph_hi = NPHASE;
    hipLaunchKernelGGL(mega_fwd, dim3(grid), dim3(NTHR), LDS_BYTES, stream, p);
}
```

```cpp
#include <hip/hip_runtime.h>
#include <stdint.h>
#include <stdio.h>

#define LAS __attribute__((address_space(3)))
typedef unsigned short bf16_t;
typedef short bf16x8 __attribute__((ext_vector_type(8)));
typedef float f32x4 __attribute__((ext_vector_type(4)));
typedef float f32x2 __attribute__((ext_vector_type(2)));
typedef float f32x16 __attribute__((ext_vector_type(16)));
typedef unsigned u32x4 __attribute__((ext_vector_type(4)));
typedef unsigned u32x2 __attribute__((ext_vector_type(2)));
typedef unsigned long long u64;
typedef int i32x4 __attribute__((ext_vector_type(4)));
typedef int i32x8 __attribute__((ext_vector_type(8)));

constexpr int T = 16384, D = 2048, NB = 4, S = 4096;
constexpr int EVEN_IN = 2368, ODD_IN = 5664;
constexpr int NIN0 = 2560, NIN1 = 5888;
constexpr int NEXP = 32, EH = 512;
constexpr int MAXRT = 160;
constexpr float EPS = 1e-6f;
constexpr bool F8_IN0 = true, F8_MOE0 = false, F8_PLE0 = true, F8_IN1 = true, F8_MOE1 = true, F8_PLE1 = true, F8_WO0 = true, F8_WO1 = true;
constexpr float F8_OSC = 16.f;
constexpr bool F8_CMP = true;
constexpr bool F8_Y1 = true;
constexpr bool KVDMA = true;
constexpr bool KV8 = true;
constexpr bool PV8 = true;
constexpr bool QK8 = true;
constexpr float LOG2E = 1.4426950408889634f;
constexpr int NTHR = 512;

constexpr size_t al256(size_t x) { return (x + 255) & ~(size_t)255; }
constexpr size_t WS_CTL = 0;
constexpr size_t CTL_BYTES = 65536;
constexpr size_t WS_WIN0T = WS_CTL + CTL_BYTES;
constexpr size_t WS_WUQT = WS_WIN0T + (size_t)NIN0 * 2048 * 2;
constexpr size_t WS_WUKVT = WS_WUQT + (size_t)1536 * 512 * 2;
constexpr size_t WS_WO0T = WS_WUKVT + (size_t)2048 * 256 * 2;
constexpr size_t WS_WIN1T = WS_WO0T + (size_t)2048 * 2048 * 2;
constexpr size_t WS_WC1KT = WS_WIN1T + (size_t)NIN1 * 2048 * 2;
constexpr size_t WS_WC1VT = WS_WC1KT + (size_t)256 * 4096 * 2;
constexpr size_t WS_WC2KT = WS_WC1VT + (size_t)256 * 4096 * 2;
constexpr size_t WS_WC2VT = WS_WC2KT + (size_t)256 * 256 * 2;
constexpr size_t WS_WO1T = WS_WC2VT + (size_t)256 * 256 * 2;
constexpr size_t WS_WPPT = WS_WO1T + (size_t)2048 * 2048 * 2;
constexpr size_t WS_WPGT = WS_WPPT + (size_t)2 * 2048 * 256 * 2;
constexpr size_t WS_WGU = WS_WPGT + (size_t)2 * 2048 * 2048 * 2;
constexpr size_t WS_WGU1 = WS_WGU + (size_t)32 * 1024 * 2048 * 2;
constexpr size_t WS_PP1 = WS_WGU1 + (size_t)32 * 1024 * 2048;
static_assert(F8_MOE1, "WS_PP1 lives in the space the fp8 layer-1 expert weights leave free");
constexpr size_t WS_WDN = WS_WGU + (size_t)2 * 32 * 1024 * 2048 * 2;
constexpr size_t WS_WRT = WS_WDN + (size_t)2 * 32 * 2048 * 512 * 2;
constexpr size_t WS_CBIAS = WS_WRT + (size_t)2 * 48 * 2048 * 4;
constexpr size_t WS_COS128 = WS_CBIAS + 2 * 256 * 4;
constexpr size_t WS_SIN128 = WS_COS128 + (size_t)T * 64 * 4;
constexpr size_t WS_COS64 = WS_SIN128 + (size_t)T * 64 * 4;
constexpr size_t WS_SIN64 = WS_COS64 + (size_t)T * 32 * 4;
constexpr size_t WS_HBA = WS_SIN64 + (size_t)T * 32 * 4;
constexpr size_t WS_HBB = WS_HBA + (size_t)(T + 256) * 2048 * 2;
constexpr size_t WS_PB = WS_HBB + (size_t)(T + 256) * 2048 * 2;
constexpr size_t WS_PP = WS_PB + (size_t)2 * T * 256 * 2;
constexpr size_t WS_RSTD0 = WS_PP + (size_t)T * 2048 * 2;
constexpr size_t WS_RSTDM = WS_RSTD0 + (size_t)T * 4;
constexpr size_t WS_RSTDP = WS_RSTDM + (size_t)(T + 64) * 4;
constexpr size_t WS_SSQP = WS_RSTDP + (size_t)T * 4;
constexpr size_t WS_SSQQ = WS_SSQP + (size_t)T * 32 * 4;
constexpr size_t WS_SSQKV = WS_SSQQ + (size_t)T * 8 * 4;
constexpr size_t WS_SLOTE = WS_SSQKV + (size_t)T * 4 * 4;
constexpr size_t WS_SLOTR = WS_SLOTE + (size_t)T * 2 * 4;
constexpr size_t WS_LIST = WS_SLOTR + (size_t)T * 2 * 4;
constexpr size_t WS_WLIST = WS_LIST + (size_t)32 * T * 4;
constexpr size_t WS_RLIST = WS_WLIST + (size_t)32 * T * 4;
constexpr size_t WS_H8A = al256(WS_RLIST + (size_t)32 * T * 4);
constexpr size_t WS_H8B = WS_H8A + (size_t)(T + 256) * 2048;
constexpr size_t WS_O8 = WS_H8B + (size_t)(T + 256) * 2048;
constexpr size_t WS_SCR = al256(WS_O8 + (size_t)T * 2048);
constexpr size_t S0_QA = WS_SCR;
constexpr size_t S0_KA = S0_QA + (size_t)T * 1024 * 2;
constexpr size_t S0_VTA = S0_KA + (size_t)T * 256 * 2;
constexpr size_t S0_QLAT = S0_VTA + (size_t)T * 256 * 2;
constexpr size_t S0_KVLAT = S0_QLAT + (size_t)T * 512 * 2;
constexpr size_t S0_QB = S0_KVLAT + (size_t)T * 256 * 2;
constexpr size_t S0_KB = S0_QB + (size_t)T * 1536 * 2;
constexpr size_t S0_VTB = S0_KB + (size_t)T * 1536 * 2;
constexpr size_t S0_O = S0_VTB + (size_t)T * 1024 * 2;
constexpr size_t S0_END = S0_O + (size_t)T * 2048 * 2;
constexpr size_t SM_H = WS_SCR;
constexpr size_t SM_Y = SM_H + (size_t)MAXRT * 256 * 512 * 2;
constexpr size_t SM_END = SM_Y + (size_t)MAXRT * 256 * 2048 * 2;
constexpr size_t S1_CQ = WS_SCR;
constexpr size_t S1_CK = S1_CQ + (size_t)T * 1024 * 2;
constexpr size_t S1_CVT = S1_CK + (size_t)T * 1024 * 2;
constexpr size_t S1_DQ = S1_CVT + (size_t)T * 1024 * 2;
constexpr size_t S1_KC = S1_DQ + (size_t)T * 1024 * 2;
constexpr size_t S1_VC = S1_KC + (size_t)T * 256 * 2 + 8192;
constexpr size_t S1_KS = S1_VC + (size_t)T * 256 * 2 + 8192;
constexpr size_t S1_VST = S1_KS + (size_t)T * 256 * 2;
constexpr size_t S1_KW = S1_VST + (size_t)T * 256 * 2;
constexpr size_t S1_VWT = S1_KW + (size_t)T * 256 * 2;
constexpr size_t S1_LF = S1_VWT + (size_t)T * 256 * 2;
constexpr size_t S1_CUM = S1_LF + (size_t)T * 8 * 4;
constexpr size_t S1_DG = S1_CUM + (size_t)T * 8 * 4;
constexpr size_t S1_HID = S1_DG + (size_t)T * 24 * 4;
constexpr size_t S1_KCMP = S1_HID + (size_t)2 * 2048 * 256 * 2;
constexpr size_t S1_VCMPT = S1_KCMP + (size_t)8 * 256 * 128 * 2;
constexpr size_t S1_SEL = S1_VCMPT + (size_t)8 * 128 * 256 * 2;
constexpr size_t S1_O = al256(S1_SEL + (size_t)8 * S * 8);
constexpr size_t S1_END = S1_O + (size_t)T * 2048 * 2;
constexpr size_t cmax3(size_t a, size_t b, size_t c) { return a > b ? (a > c ? a : c) : (b > c ? b : c); }
constexpr size_t WS_END = cmax3(S0_END, SM_END, S1_END);

constexpr int CW_BAR = 0;
constexpr int CW_CNT = 4096;
constexpr int CW_QUEUE = 4224;
constexpr int CW_DBG = 8192;

constexpr int LDS_STAGE = 0;
constexpr int LDS_IMP = 131072;
constexpr int LDS_SEL = LDS_IMP + 16384;
constexpr int LDS_MISC = LDS_SEL + 512;
constexpr int LDS_RS = LDS_MISC + 1024;
constexpr int LDS_ORD = LDS_RS + 1024;
constexpr int LDS_BYTES = LDS_ORD + 1024;
constexpr int MW_BAR = 0;
constexpr int MW_ITEM = 8;
constexpr int MW_TAB = 16;
constexpr int MW_CNT = 64;
constexpr int MW_NORD = 96;

struct Params { const float* in[32]; float* out; unsigned char* ws; int ph_lo, ph_hi; };

enum { I_X = 0, I_P, I_POS, I_ABWIN, I_SINKS, I_QLN, I_KVLN, I_WUQ, I_WUKV, I_ABWO, I_CDWIN, I_FB, I_PEK, I_W1K, I_W2K, I_PEV, I_W1V, I_W2V, I_CDWO,
       I_MIXN, I_MOEN, I_RGW, I_RGB, I_REW, I_REB, I_EWG, I_EWU, I_EWD, I_PLEP, I_PLEN, I_PLEG, I_FINN };

__device__ __forceinline__ unsigned cvt_pk(float lo, float hi) { unsigned r; asm volatile("v_cvt_pk_bf16_f32 %0, %1, %2" : "=v"(r) : "v"(lo), "v"(hi)); return r; }
__device__ __forceinline__ u32x4 pack8(const float (&v)[8]) { u32x4 w; w.x = cvt_pk(v[0], v[1]); w.y = cvt_pk(v[2], v[3]); w.z = cvt_pk(v[4], v[5]); w.w = cvt_pk(v[6], v[7]); return w; }
__device__ __forceinline__ u32x2 pack8_f8(const float (&v)[8]) {
    int a = __builtin_amdgcn_cvt_pk_fp8_f32(v[0], v[1], __float_as_int(v[0]), false); a = __builtin_amdgcn_cvt_pk_fp8_f32(v[2], v[3], a, true);
    int b = __builtin_amdgcn_cvt_pk_fp8_f32(v[4], v[5], __float_as_int(v[4]), false); b = __builtin_amdgcn_cvt_pk_fp8_f32(v[6], v[7], b, true); u32x2 w; w.x = (unsigned)a; w.y = (unsigned)b; return w; }
__device__ __forceinline__ float bf2f(unsigned short b) { return __uint_as_float(((unsigned)b) << 16); }
__device__ __forceinline__ bf16_t f2bf(float f) { return (bf16_t)(cvt_pk(f, 0.f) & 0xffffu); }
__device__ __forceinline__ void unpack8(const u32x4 w, float (&v)[8]) {
    v[0] = __uint_as_float(w.x << 16); v[1] = __uint_as_float(w.x & 0xffff0000u); v[2] = __uint_as_float(w.y << 16); v[3] = __uint_as_float(w.y & 0xffff0000u);
    v[4] = __uint_as_float(w.z << 16); v[5] = __uint_as_float(w.z & 0xffff0000u); v[6] = __uint_as_float(w.w << 16); v[7] = __uint_as_float(w.w & 0xffff0000u); }
__device__ __forceinline__ float fast_exp2(float x) { return __builtin_amdgcn_exp2f(x); }
__device__ __forceinline__ float fast_rcp(float x) { return __builtin_amdgcn_rcpf(x); }
__device__ __forceinline__ float sigmoidf_(float x) { return fast_rcp(1.0f + fast_exp2(-x * LOG2E)); }
__device__ __forceinline__ int perm32(int rho) { const int n = rho >> 4, i = rho & 15; return 8 * (i >> 2) + 4 * n + (i & 3); }
__device__ __forceinline__ int kperm16(int x) { return (x & 3) | ((x & 4) << 1) | ((x & 8) >> 1); }
__device__ __forceinline__ int vpos(int s) { return (s & ~15) | kperm16(s & 15); }

struct Frame {
    LAS unsigned char* lds; volatile LAS unsigned* misc; unsigned* ctl; unsigned char* ws;
    int tid, lane, wave, G, bx, vcu;
};
#define XB_TMO      128
#define XB_XCNT(j)  (256  + 64 * (j))
#define XB_XSUB(j)  (1280 + 64 * (j))
#define XB_XGEN(j)  (2304 + 64 * (j))
#define XB_TOP      3328
#define XB_TOPGEN   3392
#define XCD_BAR_WORDS 3456
#define XB_SPIN_CAP (1u << 18)

__device__ __forceinline__ unsigned xb_ld(unsigned* p)              { return __hip_atomic_load(p, __ATOMIC_RELAXED, __HIP_MEMORY_SCOPE_AGENT); }
__device__ __forceinline__ unsigned xb_add(unsigned* p, unsigned v) { return __hip_atomic_fetch_add(p, v, __ATOMIC_RELAXED, __HIP_MEMORY_SCOPE_AGENT); }
__device__ __forceinline__ unsigned xb_xcc_id() { return (unsigned)__builtin_amdgcn_s_getreg((3 << 11) | 20) & 0xFu; }
#define XB_SPIN(cond, bar) do { unsigned _sp = 0; while (cond) { __builtin_amdgcn_s_sleep(1); \
    if ((++_sp & 255u) == 0u) { if (xb_ld(&(bar)[XB_TMO])) break; if (_sp > XB_SPIN_CAP) { atomicAdd(&(bar)[XB_TMO], 1u); break; } } } } while (0)

struct XcdBarrier {
    unsigned* bar; unsigned x;
    volatile LAS unsigned* st;
};

__device__ __forceinline__ XcdBarrier xcd_barrier_post(unsigned* bar, volatile LAS unsigned* st) {
    XcdBarrier b; b.bar = bar; b.x = xb_xcc_id(); b.st = st;
    if (threadIdx.x == 0) (void)xb_add(&bar[XB_XCNT(b.x)], 1u);
    return b;
}
__device__ __forceinline__ void xcd_barrier_complete(unsigned* bar, unsigned x, unsigned& nloc, unsigned& nx) {
    const unsigned G = gridDim.x * gridDim.y * gridDim.z;
    unsigned sum, cnt, mine, sp = 0u;
    for (;;) {
        sum = 0u; cnt = 0u; mine = 0u;
#pragma unroll
        for (unsigned j = 0; j < 16; ++j) { const unsigned c = xb_ld(&bar[XB_XCNT(j)]); sum += c; cnt += (c > 0u) ? 1u : 0u; mine = (j == x) ? c : mine; }
        if (sum == G) break;
        __builtin_amdgcn_s_sleep(1);
        if ((++sp & 255u) == 0u) { if (xb_ld(&bar[XB_TMO])) break; if (sp > XB_SPIN_CAP) { atomicAdd(&bar[XB_TMO], 1u); break; } }
    }
    nloc = mine > 0u ? mine : 1u; nx = cnt > 0u ? cnt : 1u;
}

__device__ __forceinline__ void xcd_barrier(const XcdBarrier& b) {
    asm volatile("s_waitcnt vmcnt(0)" ::: "memory");
    __syncthreads();
    if (threadIdx.x == 0) {
        unsigned* bar = b.bar;
        __builtin_amdgcn_s_waitcnt(0);
        unsigned nloc = b.st[0], nx = b.st[1];
        if (nloc == 0u) { xcd_barrier_complete(bar, b.x, nloc, nx); b.st[0] = nloc; b.st[1] = nx; }
        const unsigned old = xb_add(&bar[XB_XSUB(b.x)], 1u);
        const unsigned gen = old / nloc;
        if (old + 1u == (gen + 1u) * nloc) {
            __builtin_amdgcn_fence(__ATOMIC_RELEASE, "agent");
            asm volatile("s_waitcnt vmcnt(0)" ::: "memory");
            const unsigned og = xb_add(&bar[XB_TOP], 1u);
            const unsigned tg = og / nx;
            if (og + 1u == (tg + 1u) * nx) xb_add(&bar[XB_TOPGEN], 1u);
            else XB_SPIN(xb_ld(&bar[XB_TOPGEN]) == tg, bar);
            __builtin_amdgcn_fence(__ATOMIC_ACQUIRE, "agent");
            xb_add(&bar[XB_XGEN(b.x)], 1u);
            asm volatile("s_waitcnt vmcnt(0)" ::: "memory");
        } else {
            XB_SPIN(xb_ld(&bar[XB_XGEN(b.x)]) == gen, bar);
            __builtin_amdgcn_fence(__ATOMIC_ACQUIRE, "agent");
            asm volatile("s_waitcnt vmcnt(0)" ::: "memory");
        }
    }
    __syncthreads();
}

enum { CK_PLAIN = 0, CK_IN0, CK_UQ, CK_UKV, CK_IN1, CK_CMP2K, CK_GU, CK_PLAIN128 };
struct ConvJob { const float* src; const float* src2; const float* gain; bf16_t* dst; int K, ldn, nrows, kind; float f8; };

__device__ __forceinline__ int rope_pair_col(int q, int base, int pl) { const int bj = q >> 7, qq = q & 127; return base + (2 * pl + (qq >> 6)) * 128 + (qq & 63) + 64 * bj; }
__device__ __forceinline__ int colmap(int kind, int n) {
    const int pn = n >> 8, q = n & 255;
    switch (kind) {
    case CK_PLAIN: return n;
    case CK_PLAIN128: return n < 128 ? n : -1;
    case CK_IN0:
        if (pn < 4) return rope_pair_col(q, 0, pn);
        if (pn == 4) return rope_pair_col(q, 1024, 0);
        if (pn == 5) return 1280 + q;
        if (pn < 8) return 1536 + (pn - 6) * 256 + q;
        if (pn == 8) return 2048 + q;
        { const int bj = q >> 7, qq = q & 127; return qq < 32 ? 2304 + qq + 32 * bj : -1; }
    case CK_UQ:
        if (n < 1024) return (n >> 7) * 192 + (n & 127);
        { const int n2 = n - 1024, r = n2 >> 8, q2 = n2 & 255, bj = q2 >> 7, qq = q2 & 127; return (4 * r + (qq >> 5)) * 192 + 128 + (qq & 31) + 32 * bj; }
    case CK_UKV:
        if (n < 1024) return (n >> 7) * 256 + (n & 127);
        { const int n2 = n - 1024; return (n2 >> 7) * 256 + 128 + (n2 & 127); }
    case CK_IN1:
        if (pn < 12) return n;
        if (pn < 16) return rope_pair_col(q, 3080, pn - 12);
        if (pn == 16) return 4104 + q;
        if (pn == 17) return 4360 + q;
        if (pn == 18) return rope_pair_col(q, 4616, 0);
        if (pn == 19) return 4872 + q;
        if (pn == 20) return rope_pair_col(q, 5128, 0);
        if (pn == 21) return 5384 + q;
        return q < 8 ? 3072 + q : (q < 32 ? 5640 + q - 8 : -1);
    case CK_CMP2K: { const int bj = q >> 7, qq = q & 127; return (n < 256 && qq < 64) ? qq + 64 * bj : -1; }
    case CK_GU: return q < 128 ? 128 * pn + q : ((128 * pn + q - 128) | (1 << 20));
    }
    return -1;
}

constexpr float F8_WGU = 64.f, F8_WDN = 32.f, F8_WPG = 64.f, F8_WIN1 = 64.f;
constexpr unsigned F8_SC_GU = 127 - 6, F8_SC_DN = 127 - 5, F8_SC_PG = 127 - 6, F8_SC_IN1 = 127 - 6, F8_SC_WO = 127 - 6 - 4;
constexpr int NFIXJOB = 14, NFIXTILE = 2360, NGUTILE = 128, NDNTILE = 64, NCONVTILE = NFIXTILE + 64 * NGUTILE + 64 * NDNTILE;
__device__ __forceinline__ void get_job(const Params& P, int tile, ConvJob& J, int& lt) {
    unsigned char* ws = P.ws;
    J.src2 = nullptr; J.gain = nullptr; J.f8 = 0.f;
    if (tile >= NFIXTILE) {
        int t2 = tile - NFIXTILE;
        if (t2 < 64 * NGUTILE) { const int le = t2 / NGUTILE; lt = t2 % NGUTILE; const int l = le >> 5;
            J.src = P.in[I_EWG] + (size_t)le * 2048 * 512; J.src2 = P.in[I_EWU] + (size_t)le * 2048 * 512; J.gain = P.in[I_MOEN] + l * 2048;
            J.dst = l ? (bf16_t*)(ws + WS_WGU1 + (size_t)(le - 32) * 1024 * 2048) : (bf16_t*)(ws + WS_WGU) + (size_t)le * 1024 * 2048; J.K = 2048; J.ldn = 512; J.nrows = 1024; J.kind = CK_GU; J.f8 = (l ? F8_MOE1 : F8_MOE0) ? F8_WGU : 0.f; return; }
        t2 -= 64 * NGUTILE; { const int le = t2 / NDNTILE; lt = t2 % NDNTILE;
            J.src = P.in[I_EWD] + (size_t)le * 512 * 2048; J.dst = (bf16_t*)(ws + WS_WDN) + (size_t)le * 2048 * 512; J.K = 512; J.ldn = 2048; J.nrows = 2048; J.kind = CK_PLAIN; J.f8 = ((le >> 5) ? F8_MOE1 : F8_MOE0) ? F8_WDN : 0.f; return; }
    }
    const int ft[NFIXJOB] = {320, 48, 32, 256, 736, 64, 64, 4, 4, 256, 32, 32, 256, 256};
    int j = 0, base = 0; bool found = false;
#pragma unroll
    for (int i = 0; i < NFIXJOB; ++i) { if (!found) { if (tile < base + ft[i]) { found = true; j = i; } else base += ft[i]; } }
    lt = tile - base;
    switch (j) {
    case 0: J.src = P.in[I_ABWIN]; J.gain = P.in[I_MIXN]; J.dst = (bf16_t*)(ws + WS_WIN0T); J.K = 2048; J.ldn = EVEN_IN; J.nrows = NIN0; J.kind = CK_IN0; J.f8 = F8_IN0 ? F8_WIN1 : 0.f; break;
    case 1: J.src = P.in[I_WUQ]; J.gain = P.in[I_QLN]; J.dst = (bf16_t*)(ws + WS_WUQT); J.K = 512; J.ldn = 1536; J.nrows = 1536; J.kind = CK_UQ; break;
    case 2: J.src = P.in[I_WUKV]; J.gain = P.in[I_KVLN]; J.dst = (bf16_t*)(ws + WS_WUKVT); J.K = 256; J.ldn = 2048; J.nrows = 2048; J.kind = CK_UKV; break;
    case 3: J.src = P.in[I_ABWO]; J.dst = (bf16_t*)(ws + WS_WO0T); J.K = 2048; J.ldn = 2048; J.nrows = 2048; J.kind = CK_PLAIN; J.f8 = F8_WO0 ? F8_WIN1 : 0.f; break;
    case 4: J.src = P.in[I_CDWIN]; J.gain = P.in[I_MIXN] + 2048; J.dst = (bf16_t*)(ws + WS_WIN1T); J.K = 2048; J.ldn = ODD_IN; J.nrows = NIN1; J.kind = CK_IN1; J.f8 = F8_IN1 ? F8_WIN1 : 0.f; break;
    case 5: J.src = P.in[I_W1K]; J.dst = (bf16_t*)(ws + WS_WC1KT); J.K = 4096; J.ldn = 256; J.nrows = 256; J.kind = CK_PLAIN; J.f8 = F8_CMP ? F8_WIN1 : 0.f; break;
    case 6: J.src = P.in[I_W1V]; J.dst = (bf16_t*)(ws + WS_WC1VT); J.K = 4096; J.ldn = 256; J.nrows = 256; J.kind = CK_PLAIN; J.f8 = F8_CMP ? F8_WIN1 : 0.f; break;
    case 7: J.src = P.in[I_W2K]; J.dst = (bf16_t*)(ws + WS_WC2KT); J.K = 256; J.ldn = 128; J.nrows = 256; J.kind = CK_CMP2K; break;
    case 8: J.src = P.in[I_W2V]; J.dst = (bf16_t*)(ws + WS_WC2VT); J.K = 256; J.ldn = 128; J.nrows = 256; J.kind = CK_PLAIN128; break;
    case 9: J.src = P.in[I_CDWO]; J.dst = (bf16_t*)(ws + WS_WO1T); J.K = 2048; J.ldn = 2048; J.nrows = 2048; J.kind = CK_PLAIN; J.f8 = F8_WO1 ? F8_WIN1 : 0.f; break;
    case 10: case 11: J.src = P.in[I_PLEP] + (size_t)(j - 10) * 256 * 2048; J.dst = (bf16_t*)(ws + WS_WPPT) + (size_t)(j - 10) * 2048 * 256; J.K = 256; J.ldn = 2048; J.nrows = 2048; J.kind = CK_PLAIN; break;
    default: J.src = P.in[I_PLEG] + (size_t)(j - 12) * 2048 * 2048; J.gain = P.in[I_PLEN] + (j - 12) * 2048; J.dst = (bf16_t*)(ws + WS_WPGT) + (size_t)(j - 12) * 2048 * 2048; J.K = 2048; J.ldn = 2048; J.nrows = 2048; J.kind = CK_PLAIN; J.f8 = ((j == 13) ? F8_PLE1 : F8_PLE0) ? F8_WPG : 0.f; break;
    }
}

struct ConvRegs { f32x4 v[8]; f32x4 g0, g1; };
__device__ __forceinline__ void conv_load(const ConvJob& J, int lt, int tid, ConvRegs& R) {
    const int kt = J.K >> 8, tn = lt / kt, tk = lt % kt;
    const int n0 = tn * 64, k0 = tk * 256;
    const int g = tid & 15, kc = tid >> 4;
    const int r = n0 + 4 * g;
    const int nat = (r & ~31) + perm32(r & 31);
    int col = colmap(J.kind, nat);
    const float* src = J.src;
    if (col >= 0 && (col & (1 << 20))) { src = J.src2; col &= ~(1 << 20); }
    const int kb = k0 + 8 * kc;
#pragma unroll
    for (int e = 0; e < 8; ++e) R.v[e] = (col >= 0) ? __builtin_nontemporal_load((const f32x4*)(src + (size_t)(kb + e) * J.ldn + col)) : (f32x4){0.f, 0.f, 0.f, 0.f};
    if (J.gain) { R.g0 = *(const f32x4*)(J.gain + kb); R.g1 = *(const f32x4*)(J.gain + kb + 4); } else { R.g0 = (f32x4){1.f, 1.f, 1.f, 1.f}; R.g1 = R.g0; }
}
__device__ __forceinline__ void conv_store(const ConvJob& J, int lt, int tid, const ConvRegs& R) {
    const int kt = J.K >> 8, tn = lt / kt, tk = lt % kt;
    const int n0 = tn * 64, k0 = tk * 256;
    const int g = tid & 15, kc = tid >> 4;
    const int r = n0 + 4 * g, kb = k0 + 8 * kc;
    if (J.f8 != 0.f) {
#pragma unroll
        for (int i = 0; i < 4; i += 2) {
            float o0[8], o1[8];
#pragma unroll
            for (int e = 0; e < 4; ++e) { o0[e] = R.v[e][i] * R.g0[e] * J.f8; o0[e + 4] = R.v[e + 4][i] * R.g1[e] * J.f8; o1[e] = R.v[e][i + 1] * R.g0[e] * J.f8; o1[e + 4] = R.v[e + 4][i + 1] * R.g1[e] * J.f8; }
            const u32x2 pa = pack8_f8(o0), pb = pack8_f8(o1);
            const auto rx = __builtin_amdgcn_permlane16_swap(pa.x, pb.x, false, false); const auto ry = __builtin_amdgcn_permlane16_swap(pa.y, pb.y, false, false);
            unsigned char* d0 = (unsigned char*)J.dst + (size_t)(r + i) * J.K + kb;
            *(u32x4*)((kc & 1) ? d0 + J.K - 8 : d0) = (u32x4){rx[0], ry[0], rx[1], ry[1]};
        }
        return;
    }
#pragma unroll
    for (int i = 0; i < 4; ++i) {
        float o[8];
#pragma unroll
        for (int e = 0; e < 4; ++e) { o[e] = R.v[e][i] * R.g0[e]; o[e + 4] = R.v[e + 4][i] * R.g1[e]; }
        *(u32x4*)(J.dst + (size_t)(r + i) * J.K + kb) = pack8(o);
    }
}

__device__ __forceinline__ void sincos_rev(float ang, float& c, float& s) {
    const double rev = (double)ang * 0.15915494309189535;
    const float fr = (float)(rev - __builtin_rint(rev));
    c = __builtin_amdgcn_cosf(fr); s = __builtin_amdgcn_sinf(fr);
}

constexpr int NCONV_FG = NFIXTILE, NCHUNK_L = (32 * NGUTILE + 32 * NDNTILE) / 4;
__device__ __forceinline__ int conv_tile_id(int i, int layer) {
    if (layer < 0) return i;
    return i < 32 * NGUTILE ? NFIXTILE + layer * 32 * NGUTILE + i : NFIXTILE + 64 * NGUTILE + layer * 32 * NDNTILE + (i - 32 * NGUTILE);
}
__device__ __forceinline__ void conv_range(const Params& P, int tid, int first, int stride, int n, int layer) {
    for (int i = first; i < n; i += 2 * stride) {
        ConvJob J0, J1; int lt0, lt1 = 0; ConvRegs R0, R1; const bool two = i + stride < n;
        get_job(P, conv_tile_id(i, layer), J0, lt0); conv_load(J0, lt0, tid, R0);
        if (two) { get_job(P, conv_tile_id(i + stride, layer), J1, lt1); conv_load(J1, lt1, tid, R1); }
        conv_store(J0, lt0, tid, R0);
        if (two) conv_store(J1, lt1, tid, R1);
    }
}
__device__ __forceinline__ void p0_prologue(const Params& P, const Frame& F) {
    unsigned char* ws = P.ws;
    const int tid = F.tid, G = F.G;
    conv_range(P, tid, F.bx, G, 320, -1);
    {
        const float* x = P.in[I_X]; bf16_t* hb = (bf16_t*)(ws + WS_HBA); float* rstd0 = (float*)(ws + WS_RSTD0);
        const int step = G * 8;
        for (int t0 = F.bx * 8 + F.wave; t0 < T; t0 += 2 * step) {
            const int t1 = t0 + step; const bool two = t1 < T; const int tb = two ? t1 : t0;
            f32x4 va[8], vb[8];
#pragma unroll
            for (int j = 0; j < 8; ++j) { const int c = 4 * (F.lane + 64 * j); va[j] = *(const f32x4*)(x + (size_t)t0 * D + c); vb[j] = *(const f32x4*)(x + (size_t)tb * D + c); }
            float ssa = 0.f, ssb = 0.f;
#pragma unroll
            for (int j = 0; j < 8; ++j) { const int c = 4 * (F.lane + 64 * j);
                { const f32x4 v = va[j]; ssa += v[0] * v[0] + v[1] * v[1] + v[2] * v[2] + v[3] * v[3];
                  if (!F8_IN0) { u32x2 w; w.x = cvt_pk(v[0], v[1]); w.y = cvt_pk(v[2], v[3]); *(u32x2*)(hb + (size_t)t0 * D + c) = w; }
                  if (F8_IN0) { int q = __float_as_int(v[0]); q = __builtin_amdgcn_cvt_pk_fp8_f32(v[0], v[1], q, false); q = __builtin_amdgcn_cvt_pk_fp8_f32(v[2], v[3], q, true); *(int*)(ws + WS_H8A + (size_t)t0 * D + c) = q; } }
                if (two) { const f32x4 v = vb[j]; ssb += v[0] * v[0] + v[1] * v[1] + v[2] * v[2] + v[3] * v[3];
                  if (!F8_IN0) { u32x2 w; w.x = cvt_pk(v[0], v[1]); w.y = cvt_pk(v[2], v[3]); *(u32x2*)(hb + (size_t)t1 * D + c) = w; }
                  if (F8_IN0) { int q = __float_as_int(v[0]); q = __builtin_amdgcn_cvt_pk_fp8_f32(v[0], v[1], q, false); q = __builtin_amdgcn_cvt_pk_fp8_f32(v[2], v[3], q, true); *(int*)(ws + WS_H8A + (size_t)t1 * D + c) = q; } } }
#pragma unroll
            for (int o = 32; o > 0; o >>= 1) { ssa += __shfl_xor(ssa, o); ssb += __shfl_xor(ssb, o); }
            if (F.lane == 0) { rstd0[t0] = __builtin_amdgcn_rsqf(ssa * (1.0f / D) + EPS); if (two) rstd0[t1] = __builtin_amdgcn_rsqf(ssb * (1.0f / D) + EPS); }
        }
    }
    const int gtid = F.bx * NTHR + tid, gn = G * NTHR;
    { const int* pos = (const int*)P.in[I_POS]; float* c128 = (float*)(ws + WS_COS128); float* s128 = (float*)(ws + WS_SIN128); float* c64 = (float*)(ws + WS_COS64); float* s64 = (float*)(ws + WS_SIN64);
      for (int i = gtid; i < T * 96; i += gn) {
          const int t = i / 96, r = i % 96; const float pf = (float)pos[t];
          if (r < 64) { const float inv = 1.0f / fast_exp2((float)(2 * r) * (1.0f / 128.0f) * 13.287712379549449f); float c, s; sincos_rev(pf * inv, c, s); c128[t * 64 + r] = c; s128[t * 64 + r] = s; }
          else { const int q = r - 64; const float inv = 1.0f / fast_exp2((float)(2 * q) * (1.0f / 64.0f) * 13.287712379549449f); float c, s; sincos_rev(pf * inv, c, s); c64[t * 32 + q] = c; s64[t * 32 + q] = s; }
      } }
}
__device__ __forceinline__ void p0_rest(const Params& P, const Frame& F, int w, int nw) {
    unsigned char* ws = P.ws; const int tid = F.tid;
    const int gtid = w * NTHR + tid, gn = nw * NTHR;
    { const float* p = P.in[I_P]; bf16_t* pb = (bf16_t*)(ws + WS_PB);
      for (int i = gtid; i < 2 * T * 256 / 4; i += gn) { const f32x4 v = *(const f32x4*)(p + (size_t)i * 4); u32x2 w; w.x = cvt_pk(v[0], v[1]); w.y = cvt_pk(v[2], v[3]); *(u32x2*)(pb + (size_t)i * 4) = w; } }
    { bf16_t* wh = (bf16_t*)(ws + WS_WRT); bf16_t* wl = wh + 2 * 48 * 2048;
      for (int i = gtid; i < 2 * 48 * 2048; i += gn) { const int l = i / (48 * 2048), c = (i / 2048) % 48, k = i % 2048; const float g = P.in[I_MOEN][l * 2048 + k];
          float w = 0.f; if (c < 4) w = P.in[I_RGW][((size_t)l * 2048 + k) * 4 + c]; else if (c < 36) w = P.in[I_REW][((size_t)l * 2048 + k) * 32 + (c - 4)];
          w *= g; const bf16_t h = f2bf(w); wh[i] = h; wl[i] = f2bf(w - bf2f(h)); } }
    { float* part = (float*)(ws + WS_SSQP);
      for (int i = gtid; i < 64 * 512; i += gn) { const int kp = i >> 9, z = (i >> 8) & 1, n = i & 255; const float* pe = P.in[z ? I_PEV : I_PEK]; const float* w1 = P.in[z ? I_W1V : I_W1K];
          float a = 0.f;
#pragma unroll 16
          for (int k = kp * 64; k < kp * 64 + 64; ++k) a += pe[k] * w1[(size_t)k * 256 + n];
          part[i] = a; } }
    { u32x4* z0 = (u32x4*)(ws + WS_HBA + (size_t)T * D * 2); u32x4* z1 = (u32x4*)(ws + WS_HBB + (size_t)T * D * 2);
      for (int i = gtid; i < 256 * D * 2 / 16; i += gn) { z0[i] = (u32x4){0u, 0u, 0u, 0u}; z1[i] = (u32x4){0u, 0u, 0u, 0u}; }
      u32x4* z8a = (u32x4*)(ws + WS_H8A + (size_t)T * D); u32x4* z8b = (u32x4*)(ws + WS_H8B + (size_t)T * D);
      for (int i = gtid; i < 256 * D / 16; i += gn) { z8a[i] = (u32x4){0u, 0u, 0u, 0u}; z8b[i] = (u32x4){0u, 0u, 0u, 0u}; }
      float* rm = (float*)(ws + WS_RSTDM); if (gtid < 64) rm[T + gtid] = 0.f; }
}
namespace pg8 {
constexpr int BM = 256, BK = 64, HALF = 128, HTB = HALF * BK * 2, STAGE_BYTES = 8 * HTB, NXCD = 8, WGM = 8;
__device__ __forceinline__ int lds_byte(int r, int c) { const int st = (r >> 4) * 2 + (c >> 5), rr = r & 15, cc = c & 31, ob = rr * 64 + cc * 2; return st * 1024 + (ob ^ (((ob >> 9) & 1) << 5)); }
__device__ __forceinline__ void stage_rc(int b, int& R, int& C) { const int st = b / 1024, sb = b % 1024, swz = sb ^ (((sb >> 9) & 1) << 5); R = (st >> 1) * 16 + swz / 64; C = (st & 1) * 32 + (swz % 64) / 2; }

struct Unit { int pm, pn, e, r0, half, ro; };

struct PlainOrder {
    static constexpr bool DYN_A = false, HALF = false;
    const bf16_t* A; const bf16_t* Bt; int lda, K; int nM, nN, nwg, G, c, lo, cnt;
    __device__ __forceinline__ void init(const bf16_t* A_, int lda_, const bf16_t* Bt_, int K_, int M, int N, int G_, int c_) { A = A_; Bt = Bt_; lda = lda_; K = K_; nM = M / BM; nN = N / BM; nwg = nM * nN; G = G_; c = c_; lo = 0; cnt = nwg; }
    __device__ __forceinline__ void sub(int lo_, int cnt_, int G_, int c_) { lo = lo_; cnt = cnt_; G = G_; c = c_ < 0 ? cnt_ : c_; }
    __device__ __forceinline__ bool next(int i, Unit& u) const {
        const long L = (long)i * G + c; if (L >= cnt) return false;
        int wgid = lo + (int)L; { const int q = nwg / NXCD, r = nwg % NXCD, xcd = wgid % NXCD, off = wgid / NXCD; wgid = (xcd < r ? xcd * (q + 1) : r * (q + 1) + (xcd - r) * q) + off; }
        const int nig = WGM * nN, gid = wgid / nig, fm = gid * WGM, gsz = (nM - fm) < WGM ? (nM - fm) : WGM;
        u.pm = fm + ((wgid % nig) % gsz); u.pn = (wgid % nig) / gsz; u.e = 0; u.r0 = 0; u.half = 0; u.ro = 0; return true;
    }
    __device__ __forceinline__ const char* a_base(const Unit& u) const { return (const char*)(A + (size_t)u.pm * BM * lda); }
    __device__ __forceinline__ const char* b_base(const Unit& u) const { return (const char*)(Bt + (size_t)u.pn * BM * K); }
    __device__ __forceinline__ unsigned a_row_off(const Unit&, int r) const { return (unsigned)r * (unsigned)lda * 2u; }
};

struct HalfOrder {
    static constexpr bool DYN_A = false, HALF = true;
    const bf16_t* A; const bf16_t* Bt; int lda, nU, G, c;
    __device__ __forceinline__ bool next(int i, Unit& u) const { const long L = (long)i * G + c; if (L >= nU) return false; u.pm = (int)L; u.pn = 0; u.e = 0; u.r0 = (int)L * 128; u.half = 1; u.ro = 0; return true; }
    __device__ __forceinline__ const char* a_base(const Unit& u) const { return (const char*)(A + (size_t)u.pm * 128 * lda); }
    __device__ __forceinline__ const char* b_base(const Unit&) const { return (const char*)Bt; }
    __device__ __forceinline__ unsigned a_row_off(const Unit&, int r) const { return (unsigned)r * (unsigned)lda * 2u; }
};

template <bool GATHER, int NPN> struct MoeOrder {
    static constexpr bool DYN_A = GATHER, HALF = true;
    const bf16_t* A; const bf16_t* Bt; int lda, K; size_t bstride;
    const int* list; volatile LAS unsigned* tab; volatile LAS unsigned* cnt; volatile LAS unsigned* ord; int G, c, U;
    __device__ __forceinline__ bool next(int i, Unit& u) const {
        const int L = i * G + c; if (L >= U) return false;
        u.pn = L % NPN; const int w = __builtin_amdgcn_readfirstlane((int)ord[L / NPN]);
        const int rt = w & 255, e = (w >> 8) & 31, kind = w >> 16; u.half = kind != 0; u.ro = kind == 2 ? 128 : 0;
        u.e = e; u.pm = rt; u.r0 = __builtin_amdgcn_readfirstlane((rt - (int)tab[e]) * BM) + u.ro; return true;
    }
    __device__ __forceinline__ const char* a_base(const Unit& u) const { return GATHER ? (const char*)A : (const char*)(A + ((size_t)u.pm * BM + u.ro) * lda); }
    __device__ __forceinline__ const char* b_base(const Unit& u) const { return (const char*)(Bt + (size_t)u.e * bstride + (size_t)u.pn * BM * K); }
    __device__ __forceinline__ unsigned a_row_off(const Unit& u, int r) const {
        if (GATHER) { const int gr = u.r0 + r; const int tok = (gr < __builtin_amdgcn_readfirstlane((int)cnt[u.e])) ? list[(size_t)u.e * T + gr] : T; return (unsigned)tok * (unsigned)lda * 2u; }
        return (unsigned)r * (unsigned)lda * 2u;
    }
};

template <bool F8, class Epi, class Sched>
__device__ __forceinline__ void gemm_phase_t(LAS unsigned char* lds, const int K, const Sched& S, const Epi& E, const unsigned f8scale) {
    const int tid = threadIdx.x, wid = __builtin_amdgcn_readfirstlane(tid >> 6), lane = tid & 63, wr = wid >> 2, wc = wid & 3, fr = lane & 15, fq = lane >> 4;
    const int nt = K / BK;
    unsigned voffB[2];
#pragma unroll
    for (int i = 0; i < 2; ++i) { int R, C; stage_rc(tid * 16 + i * 8192, R, C); voffB[i] = (unsigned)(R * K + C) * 2u; }
    const size_t kstep = (size_t)(BK * 2);
    const size_t hstepB = (size_t)HALF * K * 2;
    const unsigned ldsw = (unsigned)wid * 1024u;
    const int aoff = lds_byte(wr * 64 + fr, fq * 8), boff = lds_byte(wc * 32 + fr, fq * 8);
#define PG8_SA(b, h) (((b) * 2 + (h)) * HTB)
#define PG8_SB(b, h) ((4 + (b) * 2 + (h)) * HTB)
#define PG8_STAGE(bufoff, gbase, voff) do { _Pragma("unroll") for (int _i = 0; _i < 2; ++_i) \
        __builtin_amdgcn_global_load_lds((const unsigned*)((const char*)(gbase) + (voff)[_i]), (LAS unsigned*)(lds + (bufoff) + ldsw + _i * 8192), 16, 0, 0); } while (0)
#define PG8_LD8(p) __builtin_shufflevector(*(const LAS i32x4*)(p), *(const LAS i32x4*)((p) + 1024), 0, 1, 2, 3, 4, 5, 6, 7)
#define PG8_LDA(dst, b, h) do { if (F8) { _Pragma("unroll") for (int m = 0; m < 4; ++m) dst##8[m] = PG8_LD8(lds + PG8_SA(b, h) + aoff + m * 2048); } else { \
        _Pragma("unroll") for (int m = 0; m < 4; ++m) _Pragma("unroll") for (int k = 0; k < 2; ++k) dst[m][k] = *(const LAS bf16x8*)(lds + PG8_SA(b, h) + aoff + m * 2048 + k * 1024); } } while (0)
#define PG8_LDB(dst, b, h) do { if (F8) { _Pragma("unroll") for (int n = 0; n < 2; ++n) dst##8[n] = PG8_LD8(lds + PG8_SB(b, h) + boff + n * 2048); } else { \
        _Pragma("unroll") for (int n = 0; n < 2; ++n) _Pragma("unroll") for (int k = 0; k < 2; ++k) dst[n][k] = *(const LAS bf16x8*)(lds + PG8_SB(b, h) + boff + n * 2048 + k * 1024); } } while (0)
#define PG8_MMA(ai, bj, At, Bt) do { __builtin_amdgcn_s_setprio(1); if (F8) { _Pragma("unroll") for (int m = 0; m < 4; ++m) _Pragma("unroll") for (int n = 0; n < 2; ++n) \
        acc[ai][bj][m][n] = __builtin_amdgcn_mfma_scale_f32_16x16x128_f8f6f4(Bt##8[n], At##8[m], acc[ai][bj][m][n], 0, 0, 0, (int)f8sc, 0, 0x7f7f7f7f); \
        _Pragma("unroll") for (int m = 0; m < 4; ++m) _Pragma("unroll") for (int n = 0; n < 2; ++n) asm volatile("" : "+v"(acc[ai][bj][m][n])); } else { \
        _Pragma("unroll") for (int m = 0; m < 4; ++m) _Pragma("unroll") for (int n = 0; n < 2; ++n) _Pragma("unroll") for (int k = 0; k < 2; ++k) \
        acc[ai][bj][m][n] = __builtin_amdgcn_mfma_f32_16x16x32_bf16(Bt[n][k], At[m][k], acc[ai][bj][m][n], 0, 0, 0); } __builtin_amdgcn_s_setprio(0); } while (0)
#define PG8_WAIT_V(n) asm volatile("s_waitcnt vmcnt(" #n ")" ::: "memory")
#define PG8_WAIT_L(n) asm volatile("s_waitcnt lgkmcnt(" #n ")" ::: "memory")
#define PG8_BAR __builtin_amdgcn_s_barrier()
#define PG8_SCHED __builtin_amdgcn_sched_barrier(0)
#define PG8_AOFF(dst, u) do { int _t = tid; asm volatile("" : "+v"(_t)); _Pragma("unroll") for (int _i = 0; _i < 2; ++_i) { int _R, _C; stage_rc(_t * 16 + _i * 8192, _R, _C); _Pragma("unroll") for (int _h = 0; _h < 2; ++_h) dst[_h][_i] = S.a_row_off(u, _h * HALF + _R) + (unsigned)_C * 2u; } } while (0)
    Unit cur, nxt; int ui = 0;
    if (!S.next(0, cur)) return;
    f32x4 acc[2][2][4][2];
#pragma unroll
    for (int a = 0; a < 2; ++a)
#pragma unroll
        for (int b = 0; b < 2; ++b)
#pragma unroll
            for (int m = 0; m < 4; ++m)
#pragma unroll
                for (int n = 0; n < 2; ++n) acc[a][b][m][n] = (f32x4){0.f, 0.f, 0.f, 0.f};
    bf16x8 At[4][2], B0[2][2], B1[2][2]; i32x8 At8[4], B08[2], B18[2]; const unsigned f8sc = f8scale * 0x01010101u;
    unsigned offA[2][2];
    PG8_AOFF(offA, cur);
    const char* cA = S.a_base(cur); const char* cB = S.b_base(cur);
    PG8_STAGE(PG8_SB(0, 0), cB, voffB); PG8_STAGE(PG8_SB(0, 1), cB + hstepB, voffB); PG8_STAGE(PG8_SA(0, 0), cA, offA[0]); PG8_STAGE(PG8_SA(0, 1), cA, offA[1]);
    if (wr == 1) PG8_BAR;
    PG8_WAIT_V(2); PG8_BAR;
    PG8_STAGE(PG8_SB(1, 0), cB + kstep, voffB); PG8_STAGE(PG8_SA(1, 0), cA + kstep, offA[0]); PG8_STAGE(PG8_SB(1, 1), cB + hstepB + kstep, voffB);
    PG8_WAIT_V(6); PG8_BAR;
#pragma unroll 1
    for (;;) {
        const bool has_next = S.next(ui + 1, nxt);
        const char* nA = has_next ? S.a_base(nxt) : cA; const char* nB = has_next ? S.b_base(nxt) : cB;
        const bool hf = Sched::HALF && cur.half != 0;
#pragma unroll 1
        for (int t = 0; t < nt; t += 2) {
            const bool last = (t == nt - 2);
            const char* a1 = cA + (size_t)(t + 1) * kstep;
            const char* a2 = last ? nA : cA + (size_t)(t + 2) * kstep; const char* b2 = last ? nB : cB + (size_t)(t + 2) * kstep;
            const char* a3 = a2 + kstep; const char* b3 = b2 + kstep;
            PG8_LDB(B0, 0, 0); PG8_LDB(B1, 0, 1); PG8_SCHED; PG8_LDA(At, 0, 0); PG8_STAGE(PG8_SA(1, 1), a1, offA[1]);
            PG8_WAIT_V(8); PG8_WAIT_L(0); PG8_BAR; PG8_MMA(0, 0, At, B0); PG8_MMA(0, 1, At, B1); PG8_BAR; PG8_SCHED;
            if (Sched::DYN_A && last && has_next) PG8_AOFF(offA, nxt);
            if (!hf) PG8_LDA(At, 0, 1); PG8_STAGE(PG8_SB(0, 0), b2, voffB); PG8_STAGE(PG8_SB(0, 1), b2 + hstepB, voffB); PG8_STAGE(PG8_SA(0, 0), a2, offA[0]);
            PG8_WAIT_V(8); PG8_WAIT_L(0); PG8_BAR; if (!hf) { PG8_MMA(1, 0, At, B0); PG8_MMA(1, 1, At, B1); } PG8_BAR; PG8_SCHED;
            PG8_LDB(B0, 1, 0); PG8_LDB(B1, 1, 1); PG8_SCHED; PG8_LDA(At, 1, 0); PG8_STAGE(PG8_SA(0, 1), a2, offA[1]);
            PG8_WAIT_V(8); PG8_WAIT_L(0); PG8_BAR; PG8_MMA(0, 0, At, B0); PG8_MMA(0, 1, At, B1); PG8_BAR; PG8_SCHED;
            if (!hf) PG8_LDA(At, 1, 1); PG8_STAGE(PG8_SB(1, 0), b3, voffB); PG8_STAGE(PG8_SB(1, 1), b3 + hstepB, voffB); PG8_STAGE(PG8_SA(1, 0), a3, offA[0]);
            PG8_WAIT_V(8); PG8_WAIT_L(0); PG8_BAR; if (!hf) { PG8_MMA(1, 0, At, B0); PG8_MMA(1, 1, At, B1); } PG8_BAR; PG8_SCHED;
        }
        if (wr == 0) PG8_BAR;
        { int efr = fr, efq = fq; asm volatile("" : "+v"(efr), "+v"(efq));
          E(acc, cur, wr, wc, efr, efq); }
        if (!has_next) break;
#pragma unroll
        for (int a = 0; a < 2; ++a)
#pragma unroll
            for (int b = 0; b < 2; ++b)
#pragma unroll
                for (int m = 0; m < 4; ++m)
#pragma unroll
                    for (int n = 0; n < 2; ++n) acc[a][b][m][n] = (f32x4){0.f, 0.f, 0.f, 0.f};
        cur = nxt; cA = nA; cB = nB; ++ui;
        if (wr == 1) PG8_BAR;
    }
    PG8_WAIT_V(0);
    PG8_BAR;
#undef PG8_SA
#undef PG8_SB
#undef PG8_STAGE
#undef PG8_LDA
#undef PG8_LD8
#undef PG8_LDB
#undef PG8_MMA
#undef PG8_WAIT_V
#undef PG8_WAIT_L
#undef PG8_BAR
#undef PG8_SCHED
#undef PG8_AOFF
}
template <class Epi, class Sched>
__device__ __forceinline__ void gemm_phase(LAS unsigned char* lds, const int K, const Sched& S, const Epi& E) { gemm_phase_t<false>(lds, K, S, E, 0u); }
template <class Epi, class Sched>
__device__ __forceinline__ void gemm_phase_f8(LAS unsigned char* lds, const int K2, const Sched& S, const Epi& E, const unsigned f8scale) { gemm_phase_t<true>(lds, K2, S, E, f8scale); }
}
namespace epi {
using pg8::Unit;
typedef const f32x4 (&Acc)[2][2][4][2];
#define EPI_ROWL(ai, m) ((ai) * 128 + wr * 64 + (m) * 16 + fr)
#define EPI_ROW(u, ai, m) ((u).pm * 256 + EPI_ROWL(ai, m))
#define EPI_GET8(v, ai, bj, m, sc) do { _Pragma("unroll") for (int _e = 0; _e < 4; ++_e) { v[_e] = acc[ai][bj][m][0][_e] * (sc); v[4 + _e] = acc[ai][bj][m][1][_e] * (sc); } } while (0)

template <class RD, class FL, class FC>
__device__ __forceinline__ void epi_pipe_n(int ng, FL load, FC comp) {
    RD d[2][2];
    load(0, 0, d[0][0]); load(0, 1, d[0][1]);
#pragma unroll
    for (int g = 0; g < 4; ++g) {
        if (g < ng) {
            if (g < 3 && g + 1 < ng) { const int g2 = g + 1; load(g2 >> 1, (g2 & 1) * 2, d[g2 & 1][0]); load(g2 >> 1, (g2 & 1) * 2 + 1, d[g2 & 1][1]); }
            __builtin_amdgcn_sched_barrier(0);
            comp(g >> 1, (g & 1) * 2, d[g & 1][0]); comp(g >> 1, (g & 1) * 2 + 1, d[g & 1][1]);
            __builtin_amdgcn_sched_barrier(0);
        }
    }
}
template <class RD, class FL, class FC>
__device__ __forceinline__ void epi_pipe(FL load, FC comp) {
    RD d[2][2];
    load(0, 0, d[0][0]); load(0, 1, d[0][1]);
#pragma unroll
    for (int g = 0; g < 4; ++g) {
        if (g < 3) { const int g2 = g + 1; load(g2 >> 1, (g2 & 1) * 2, d[g2 & 1][0]); load(g2 >> 1, (g2 & 1) * 2 + 1, d[g2 & 1][1]); }
        __builtin_amdgcn_sched_barrier(0);
        comp(g >> 1, (g & 1) * 2, d[g & 1][0]); comp(g >> 1, (g & 1) * 2 + 1, d[g & 1][1]);
        __builtin_amdgcn_sched_barrier(0);
    }
}
template <class RD, class FL, class FC>
__device__ __forceinline__ void epi_pipe1(FL load, FC comp) {
    RD d[2];
    load(0, 0, d[0]);
#pragma unroll
    for (int g = 0; g < 8; ++g) {
        if (g < 7) { const int g2 = g + 1; load(g2 >> 2, g2 & 3, d[g2 & 1]); }
        __builtin_amdgcn_sched_barrier(0);
        comp(g >> 2, g & 3, d[g & 1]);
        __builtin_amdgcn_sched_barrier(0);
    }
}
__device__ __forceinline__ void store8(bf16_t* p, const float (&v)[8]) { *(u32x4*)p = pack8(v); }

struct RdS { float rs; };
struct RdRope { float rs; f32x4 c0, c1, s0, s1; };
__device__ __forceinline__ void rope8(const float (&x1)[8], const float (&x2)[8], const RdRope& d, float (&y1)[8], float (&y2)[8]) {
#pragma unroll
    for (int e = 0; e < 8; ++e) { const float c = e < 4 ? d.c0[e] : d.c1[e - 4], s = e < 4 ? d.s0[e] : d.s1[e - 4]; y1[e] = x1[e] * c - x2[e] * s; y2[e] = x2[e] * c + x1[e] * s; }
}
__device__ __forceinline__ void ld_rope(RdRope& d, const float* cs, const float* sn) { d.c0 = *(const f32x4*)cs; d.c1 = *(const f32x4*)(cs + 4); d.s0 = *(const f32x4*)sn; d.s1 = *(const f32x4*)(sn + 4); }

__device__ __forceinline__ bf16_t* kvw(bf16_t* base, size_t el) { return (bf16_t*)((unsigned char*)base + el * (KV8 ? 1 : 2)); }
__device__ __forceinline__ void store8_f8(unsigned char* p, const float (&v)[8]) { *(u32x2*)p = pack8_f8(v); }
__device__ __forceinline__ void store16_f8w(unsigned char* p0, unsigned char* p1, int fq, const float (&v0)[8], const float (&v1)[8]) {
    const u32x2 a = pack8_f8(v0), b = pack8_f8(v1);
    const auto rx = __builtin_amdgcn_permlane16_swap(a.x, b.x, false, false); const auto ry = __builtin_amdgcn_permlane16_swap(a.y, b.y, false, false);
    *(u32x4*)((fq & 1) ? p1 - 8 : p0) = (u32x4){rx[0], ry[0], rx[1], ry[1]};
}
template <bool F8 = false, class RS>
__device__ __forceinline__ void rope128_tile(Acc acc, const Unit& u, int wr, int wc, int fr, int fq, RS rsf, const float* c128, const float* s128, bf16_t* dst, int ld) {
    const int qq = 32 * wc + 8 * fq, hl = qq >> 6, i0 = qq & 63;
    epi_pipe1<RdRope>([&](int ai, int m, RdRope& d) { const int row = EPI_ROW(u, ai, m); d.rs = rsf(ai, m, row); ld_rope(d, c128 + (size_t)row * 64 + i0, s128 + (size_t)row * 64 + i0); },
                     [&](int ai, int m, const RdRope& d) { const int row = EPI_ROW(u, ai, m);
                         float x1[8], x2[8], y1[8], y2[8]; EPI_GET8(x1, ai, 0, m, d.rs); EPI_GET8(x2, ai, 1, m, d.rs); rope8(x1, x2, d, y1, y2);
                         if (F8) { unsigned char* p = (unsigned char*)dst + (size_t)row * ld + hl * 128 + i0; store16_f8w(p, p + 64, fq, y1, y2); }
                         else { bf16_t* p = dst + (size_t)row * ld + hl * 128 + i0; store8(p, y1); store8(p + 64, y2); } });
}
template <bool F8 = false, class RS>
__device__ __forceinline__ void plain_tile(Acc acc, const Unit& u, int wr, int wc, int fr, int fq, RS rsf, bf16_t* dst, int ld) {
    const int q0 = 32 * wc + 8 * fq;
    epi_pipe<RdS>([&](int ai, int m, RdS& d) { d.rs = rsf(ai, m, EPI_ROW(u, ai, m)); },
                  [&](int ai, int m, const RdS& d) { const int row = EPI_ROW(u, ai, m);
                      if (F8) { float v0[8], v1[8]; EPI_GET8(v0, ai, 0, m, d.rs); EPI_GET8(v1, ai, 1, m, d.rs); unsigned char* p = (unsigned char*)dst + (size_t)row * ld + q0; store16_f8w(p, p + 128, fq, v0, v1); }
                      else {
#pragma unroll
                      for (int bj = 0; bj < 2; ++bj) { float v[8]; EPI_GET8(v, ai, bj, m, d.rs); store8(dst + (size_t)row * ld + bj * 128 + q0, v); } } });
}
template <class RS>
__device__ __forceinline__ void plain_ssq_tile(Acc acc, const Unit& u, int wr, int wc, int fr, int fq, RS rsf, bf16_t* dst, int ld, float* ssq, int nslot, int slot0) {
    const int q0 = 32 * wc + 8 * fq;
    epi_pipe<RdS>([&](int ai, int m, RdS& d) { d.rs = rsf(ai, m, EPI_ROW(u, ai, m)); },
                  [&](int ai, int m, const RdS& d) { const int row = EPI_ROW(u, ai, m); float ss = 0.f;
#pragma unroll
                      for (int bj = 0; bj < 2; ++bj) { float v[8]; EPI_GET8(v, ai, bj, m, d.rs);
#pragma unroll
                          for (int e = 0; e < 8; ++e) ss += v[e] * v[e];
                          store8(dst + (size_t)row * ld + bj * 128 + q0, v); }
                      ss += __shfl_xor(ss, 16); ss += __shfl_xor(ss, 32);
                      if (fq == 0) ssq[(size_t)row * nslot + slot0 + wc] = ss; });
}
template <class RS>
__device__ __forceinline__ void vt_tile(Acc acc, const Unit& u, int wr, int wc, int fr, int fq, RS rsf, bf16_t* vt, int nh) {
    const int q0 = 32 * wc + 8 * fq;
    epi_pipe<RdS>([&](int ai, int m, RdS& d) { d.rs = rsf(ai, m, EPI_ROW(u, ai, m)); },
                  [&](int ai, int m, const RdS& d) { const int row = EPI_ROW(u, ai, m); const int b = row >> 12, s = row & (S - 1), ps = vpos(s);
#pragma unroll
                      for (int bj = 0; bj < 2; ++bj) { float v[8]; EPI_GET8(v, ai, bj, m, d.rs);
                          bf16_t* p = vt + (((size_t)b * nh + bj) * 128 + q0) * S + ps;
#pragma unroll
                          for (int e = 0; e < 8; ++e) p[(size_t)e * S] = f2bf(v[e]); } });
}
template <class RS>
__device__ __forceinline__ void hm_tile(Acc acc, const Unit& u, int wr, int wc, int fr, int fq, RS rsf, bf16_t* dst) {
    const int q0 = 32 * wc + 8 * fq;
    epi_pipe<RdS>([&](int ai, int m, RdS& d) { d.rs = rsf(ai, m, EPI_ROW(u, ai, m)); },
                  [&](int ai, int m, const RdS& d) { const int row = EPI_ROW(u, ai, m); const int b = row >> 12, s = row & (S - 1);
                      if (F8_CMP) { float v0[8], v1[8]; EPI_GET8(v0, ai, 0, m, d.rs); EPI_GET8(v1, ai, 1, m, d.rs);
                          store16_f8w((unsigned char*)dst + (((size_t)b * 2) * S + s) * 128 + q0, (unsigned char*)dst + (((size_t)b * 2 + 1) * S + s) * 128 + q0, fq, v0, v1); }
                      else {
#pragma unroll
                      for (int bj = 0; bj < 2; ++bj) { float v[8]; EPI_GET8(v, ai, bj, m, d.rs); store8(dst + (((size_t)b * 2 + bj) * S + s) * 128 + q0, v); } } });
}

struct In0 {
    const float* rstd; const float *c128, *s128, *c64, *s64; bf16_t *QA, *KA, *VA, *QLAT, *KVLAT, *KR; float *SSQQ, *SSQKV;
    __device__ __forceinline__ void operator()(Acc acc, const Unit& u, int wr, int wc, int fr, int fq) const {
        const int pn = u.pn; const float* rp = rstd;
        auto rsf = [rp](int, int, int row) { return rp[row]; };
        if (pn < 4) rope128_tile<KV8>(acc, u, wr, wc, fr, fq, rsf, c128, s128, kvw(QA, pn * 256), 1024);
        else if (pn == 4) rope128_tile<KV8>(acc, u, wr, wc, fr, fq, rsf, c128, s128, KA, 256);
        else if (pn == 5) plain_tile<KV8>(acc, u, wr, wc, fr, fq, rsf, VA, 256);
        else if (pn < 8) plain_ssq_tile(acc, u, wr, wc, fr, fq, rsf, QLAT + (pn - 6) * 256, 512, SSQQ, 8, (pn - 6) * 4);
        else if (pn == 8) plain_ssq_tile(acc, u, wr, wc, fr, fq, rsf, KVLAT, 256, SSQKV, 4, 0);
        else if (wc == 0) {
            const int i0 = 8 * fq; const float* c64_ = c64; const float* s64_ = s64; bf16_t* KR_ = KR;
            epi_pipe<RdRope>([&](int ai, int m, RdRope& d) { const int row = EPI_ROW(u, ai, m); d.rs = rp[row]; ld_rope(d, c64_ + (size_t)row * 32 + i0, s64_ + (size_t)row * 32 + i0); },
                             [&](int ai, int m, const RdRope& d) { const int row = EPI_ROW(u, ai, m);
                                 float x1[8], x2[8], y1[8], y2[8]; EPI_GET8(x1, ai, 0, m, d.rs); EPI_GET8(x2, ai, 1, m, d.rs); rope8(x1, x2, d, y1, y2);
                                 if (KV8) { unsigned char* p = (unsigned char*)KR_ + (size_t)row * 64 + i0; store16_f8w(p, p + 32, fq, y1, y2); }
                                 else { bf16_t* p = KR_ + (size_t)row * 64 + i0; store8(p, y1); store8(p + 32, y2); } });
        }
    }
};
struct RdUq { f32x4 a, b, c0, c1, s0, s1; };
struct Uq {
    const float* ssq; const float *c64, *s64; bf16_t* QB;
    __device__ __forceinline__ void operator()(Acc acc, const Unit& u, int wr, int wc, int fr, int fq) const {
        const int pn = u.pn, qq = 32 * wc + 8 * fq; const float* ssq_ = ssq; const float* c64_ = c64; const float* s64_ = s64; bf16_t* QB_ = QB;
        const int head = 4 * (pn - 4) + (qq >> 5), i0 = qq & 31;
        epi_pipe1<RdUq>([&](int ai, int m, RdUq& d) { const int row = EPI_ROW(u, ai, m); d.a = *(const f32x4*)(ssq_ + (size_t)row * 8); d.b = *(const f32x4*)(ssq_ + (size_t)row * 8 + 4);
                           if (pn >= 4) { d.c0 = *(const f32x4*)(c64_ + (size_t)row * 32 + i0); d.c1 = *(const f32x4*)(c64_ + (size_t)row * 32 + i0 + 4); d.s0 = *(const f32x4*)(s64_ + (size_t)row * 32 + i0); d.s1 = *(const f32x4*)(s64_ + (size_t)row * 32 + i0 + 4); } },
                       [&](int ai, int m, const RdUq& d) { const int row = EPI_ROW(u, ai, m);
                           const float rs = __builtin_amdgcn_rsqf(((d.a[0] + d.a[1]) + (d.a[2] + d.a[3]) + (d.b[0] + d.b[1]) + (d.b[2] + d.b[3])) * (1.0f / 512.0f) + EPS);
                           if (pn < 4) {
                               if (KV8) { float v0[8], v1[8]; EPI_GET8(v0, ai, 0, m, rs); EPI_GET8(v1, ai, 1, m, rs); unsigned char* p = (unsigned char*)QB_ + (size_t)row * 1536 + (2 * pn) * 192 + qq; store16_f8w(p, p + 192, fq, v0, v1); }
                               else {
#pragma unroll
                               for (int bj = 0; bj < 2; ++bj) { float v[8]; EPI_GET8(v, ai, bj, m, rs); store8(QB_ + (size_t)row * 1536 + (2 * pn + bj) * 192 + qq, v); } }
                           } else { RdRope r; r.rs = rs; r.c0 = d.c0; r.c1 = d.c1; r.s0 = d.s0; r.s1 = d.s1;
                               float x1[8], x2[8], y1[8], y2[8]; EPI_GET8(x1, ai, 0, m, rs); EPI_GET8(x2, ai, 1, m, rs); rope8(x1, x2, r, y1, y2);
                               if (KV8) { unsigned char* p = (unsigned char*)QB_ + (size_t)row * 1536 + head * 192 + 128 + i0; store16_f8w(p, p + 32, fq, y1, y2); }
                               else { bf16_t* p = QB_ + (size_t)row * 1536 + head * 192 + 128 + i0; store8(p, y1); store8(p + 32, y2); } } });
    }
};
struct RdV4 { f32x4 a; };
struct Ukv {
    const float* ssq; bf16_t *KB, *VB;
    __device__ __forceinline__ void operator()(Acc acc, const Unit& u, int wr, int wc, int fr, int fq) const {
        const int pn = u.pn, qq = 32 * wc + 8 * fq; const float* ssq_ = ssq; bf16_t* KB_ = KB; bf16_t* VB_ = VB;
        epi_pipe<RdV4>([&](int ai, int m, RdV4& d) { d.a = *(const f32x4*)(ssq_ + (size_t)EPI_ROW(u, ai, m) * 4); },
                       [&](int ai, int m, const RdV4& d) { const int row = EPI_ROW(u, ai, m);
                           const float rs = __builtin_amdgcn_rsqf(((d.a[0] + d.a[1]) + (d.a[2] + d.a[3])) * (1.0f / 256.0f) + EPS);
                           if (KV8) { float v0[8], v1[8]; EPI_GET8(v0, ai, 0, m, rs); EPI_GET8(v1, ai, 1, m, rs);
                               unsigned char* p = (pn < 4 ? (unsigned char*)KB_ + (size_t)row * 1024 + (2 * pn) * 128 : (unsigned char*)VB_ + (size_t)row * 1024 + (2 * (pn - 4)) * 128) + qq; store16_f8w(p, p + 128, fq, v0, v1); }
                           else {
#pragma unroll
                           for (int bj = 0; bj < 2; ++bj) { float v[8]; EPI_GET8(v, ai, bj, m, rs);
                               if (pn < 4) store8(KB_ + (size_t)row * 1024 + (2 * pn + bj) * 128 + qq, v);
                               else store8(VB_ + (size_t)row * 1024 + (2 * (pn - 4) + bj) * 128 + qq, v); } } });
    }
};
struct RdWo { f32x4 r[4]; };
template <bool RF32> struct Wo {
    const void* resid; bf16_t* hb; unsigned char* h8;
    __device__ __forceinline__ void operator()(Acc acc, const Unit& u, int wr, int wc, int fr, int fq) const {
        const int q0 = u.pn * 256 + 32 * wc + 8 * fq; const float* rf = (const float*)resid; const bf16_t* rb = (const bf16_t*)resid; bf16_t* hb_ = hb; unsigned char* h8_ = h8;
        epi_pipe<RdWo>([&](int ai, int m, RdWo& d) { const size_t o = (size_t)EPI_ROW(u, ai, m) * D + q0;
                           if (RF32) { d.r[0] = *(const f32x4*)(rf + o); d.r[1] = *(const f32x4*)(rf + o + 4); d.r[2] = *(const f32x4*)(rf + o + 128); d.r[3] = *(const f32x4*)(rf + o + 132); }
                           else { const u32x4 a = *(const u32x4*)(rb + o), b = *(const u32x4*)(rb + o + 128); d.r[0] = __builtin_bit_cast(f32x4, a); d.r[2] = __builtin_bit_cast(f32x4, b); } },
                       [&](int ai, int m, const RdWo& d) { const size_t o0 = (size_t)EPI_ROW(u, ai, m) * D + q0; float vv[2][8];
#pragma unroll
                           for (int bj = 0; bj < 2; ++bj) { float (&v)[8] = vv[bj]; EPI_GET8(v, ai, bj, m, 1.0f); const size_t o = o0 + bj * 128;
                               if (RF32) {
#pragma unroll
                                   for (int e = 0; e < 4; ++e) { v[e] += d.r[2 * bj][e]; v[4 + e] += d.r[2 * bj + 1][e]; }
                               } else { float r8[8]; unpack8(__builtin_bit_cast(u32x4, d.r[2 * bj]), r8);
#pragma unroll
                                   for (int e = 0; e < 8; ++e) v[e] += r8[e]; }
                               store8(hb_ + o, v); }
                           if (h8_) store16_f8w(h8_ + o0, h8_ + o0 + 128, fq, vv[0], vv[1]); });
    }
};
struct PlainBf16 {
    bf16_t* O; int ldc;
    __device__ __forceinline__ void operator()(Acc acc, const Unit& u, int wr, int wc, int fr, int fq) const { plain_tile(acc, u, wr, wc, fr, fq, [](int, int, int) { return 1.0f; }, O + u.pn * 256, ldc); }
};
struct RdPle { float rs; u32x4 pp[2]; u32x4 r[2]; };
struct Ple {
    const float* rstd; const bf16_t* PP; const bf16_t* hin; bf16_t* hout; float* ssq; unsigned char* h8;
    __device__ __forceinline__ void operator()(Acc acc, const Unit& u, int wr, int wc, int fr, int fq) const {
        const int q0 = u.pn * 256 + 32 * wc + 8 * fq; const float* rstd_ = rstd; const bf16_t* PP_ = PP; const bf16_t* hin_ = hin; bf16_t* hout_ = hout; float* ssq_ = ssq; unsigned char* h8_ = h8;
        epi_pipe1<RdPle>([&](int ai, int m, RdPle& d) { const int row = EPI_ROW(u, ai, m); const size_t o = (size_t)row * D + q0; d.rs = rstd_[row];
                            d.pp[0] = *(const u32x4*)(PP_ + o); d.pp[1] = *(const u32x4*)(PP_ + o + 128); d.r[0] = *(const u32x4*)(hin_ + o); d.r[1] = *(const u32x4*)(hin_ + o + 128); },
                        [&](int ai, int m, const RdPle& d) { const int row = EPI_ROW(u, ai, m); const size_t o0 = (size_t)row * D + q0; float ss = 0.f; float vv[2][8];
#pragma unroll
                            for (int bj = 0; bj < 2; ++bj) { float (&v)[8] = vv[bj]; float pp[8], r8[8]; EPI_GET8(v, ai, bj, m, d.rs); unpack8(d.pp[bj], pp); unpack8(d.r[bj], r8);
#pragma unroll
                                for (int e = 0; e < 8; ++e) { const float hh = r8[e] + pp[e] * sigmoidf_(v[e]); v[e] = hh; ss += hh * hh; }
                                store8(hout_ + o0 + bj * 128, v); }
                            if (h8_) store16_f8w(h8_ + o0, h8_ + o0 + 128, fq, vv[0], vv[1]);
                            if (ssq_) { ss += __shfl_xor(ss, 16); ss += __shfl_xor(ss, 32);
                                if (fq == 0) ssq_[(size_t)row * 32 + u.pn * 4 + wc] = ss; } });
    }
};
template <bool F8> struct MoeGu {
    const float* rlist; volatile LAS unsigned* cnt; bf16_t* H;
    __device__ __forceinline__ void operator()(Acc acc, const Unit& u, int wr, int wc, int fr, int fq) const {
        const int q0 = 32 * wc + 8 * fq; const int cn = __builtin_amdgcn_readfirstlane((int)cnt[u.e]); const float* rl = rlist + (size_t)u.e * T; bf16_t* H_ = H;
        float gkeep[8]; unsigned char* pkeep = nullptr;
        epi_pipe_n<RdS>(u.half ? 2 : 4, [&](int ai, int m, RdS& d) { const int gr = u.r0 + EPI_ROWL(ai, m); d.rs = gr < cn ? rl[gr] : 0.f; },
                      [&](int ai, int m, const RdS& d) { const int lr = EPI_ROWL(ai, m);
                          float g[8], w[8]; EPI_GET8(g, ai, 0, m, d.rs); EPI_GET8(w, ai, 1, m, d.rs);
#pragma unroll
                          for (int e = 0; e < 8; ++e) g[e] = g[e] * sigmoidf_(g[e]) * w[e];
                          if (F8) { unsigned char* p = (unsigned char*)H_ + ((size_t)u.pm * 256 + u.ro + lr) * EH + u.pn * 128 + q0;
                              if (!(m & 1)) {
#pragma unroll
                                  for (int e = 0; e < 8; ++e) gkeep[e] = g[e];
                                  pkeep = p; }
                              else store16_f8w(pkeep, p, fq, gkeep, g); }
                          else store8(H_ + ((size_t)u.pm * 256 + u.ro + lr) * EH + u.pn * 128 + q0, g); });
    }
};
template <bool F8Y> struct MoeDn {
    const float* wlist; volatile LAS unsigned* cnt; bf16_t* Y;
    __device__ __forceinline__ void operator()(Acc acc, const Unit& u, int wr, int wc, int fr, int fq) const {
        const int q0 = u.pn * 256 + 32 * wc + 8 * fq; const int cn = __builtin_amdgcn_readfirstlane((int)cnt[u.e]); const float* wl = wlist + (size_t)u.e * T; bf16_t* Y_ = Y;
        epi_pipe_n<RdS>(u.half ? 2 : 4, [&](int ai, int m, RdS& d) { const int gr = u.r0 + EPI_ROWL(ai, m); d.rs = gr < cn ? wl[gr] * (F8Y ? F8_OSC : 1.0f) : 0.f; },
                      [&](int ai, int m, const RdS& d) { const int lr = EPI_ROWL(ai, m);
#pragma unroll
                          for (int bj = 0; bj < 2; ++bj) { if (F8Y) break; float v[8]; EPI_GET8(v, ai, bj, m, d.rs); store8(Y_ + ((size_t)u.pm * 256 + u.ro + lr) * D + q0 + bj * 128, v); }
                          if (F8Y) { float v0[8], v1[8]; EPI_GET8(v0, ai, 0, m, d.rs); EPI_GET8(v1, ai, 1, m, d.rs); unsigned char* p = (unsigned char*)Y_ + ((size_t)u.pm * 256 + u.ro + lr) * D + q0; store16_f8w(p, p + 128, fq, v0, v1); } });
    }
};
struct In1 {
    const float* ssqp;
    const float *c128, *s128; const float* fb; bf16_t *CQ, *CK, *CV, *DQ, *KC, *VC, *KS, *VS, *KW, *VW; float *LF, *DG;
    __device__ __forceinline__ void operator()(Acc acc, const Unit& u, int wr, int wc, int fr, int fq) const {
        float rsv[2][4];
        { const int tid = (wr * 4 + wc) * 64 + fq * 16 + fr, rr = tid >> 1, part = tid & 1;
          const float* sp = ssqp + (size_t)(u.pm * 256 + rr) * 32 + part * 16; float ss = 0.f;
#pragma unroll
          for (int j = 0; j < 4; ++j) { const f32x4 a = *(const f32x4*)(sp + 4 * j); ss += (a[0] + a[1]) + (a[2] + a[3]); }
          ss += __shfl_xor(ss, 1);
          LAS float* rsL = (LAS float*)(LDS_RS);
          if (part == 0) rsL[rr] = __builtin_amdgcn_rsqf(ss * (1.0f / D) + EPS);
          asm volatile("s_waitcnt lgkmcnt(0)" ::: "memory"); __builtin_amdgcn_s_barrier(); asm volatile("" ::: "memory");
#pragma unroll
          for (int ai = 0; ai < 2; ++ai)
#pragma unroll
              for (int m = 0; m < 4; ++m) rsv[ai][m] = rsL[ai * 128 + wr * 64 + m * 16 + fr]; }
        __builtin_amdgcn_sched_barrier(0);
        auto rsf = [&](int ai, int m, int) { return rsv[ai][m]; };
        const int pn = u.pn;
        if (pn < 4) plain_tile<KV8>(acc, u, wr, wc, fr, fq, rsf, kvw(CQ, pn * 256), 1024);
        else if (pn < 8) plain_tile<KV8>(acc, u, wr, wc, fr, fq, rsf, kvw(CK, (pn - 4) * 256), 1024);
        else if (pn < 12) plain_tile<KV8>(acc, u, wr, wc, fr, fq, rsf, kvw(CV, (pn - 8) * 256), 1024);
        else if (pn < 16) rope128_tile(acc, u, wr, wc, fr, fq, rsf, c128, s128, DQ + (pn - 12) * 256, 1024);
        else if (pn == 16) hm_tile(acc, u, wr, wc, fr, fq, rsf, KC);
        else if (pn == 17) hm_tile(acc, u, wr, wc, fr, fq, rsf, VC);
        else if (pn == 18) rope128_tile<KV8>(acc, u, wr, wc, fr, fq, rsf, c128, s128, KS, 256);
        else if (pn == 19) plain_tile<KV8>(acc, u, wr, wc, fr, fq, rsf, VS, 256);
        else if (pn == 20) rope128_tile<KV8>(acc, u, wr, wc, fr, fq, rsf, c128, s128, KW, 256);
        else if (pn == 21) plain_tile<KV8>(acc, u, wr, wc, fr, fq, rsf, VW, 256);
        else if (wc == 0) {
#pragma unroll
            for (int ai = 0; ai < 2; ++ai)
#pragma unroll
                for (int m = 0; m < 4; ++m) { const int row = EPI_ROW(u, ai, m); float v[8]; EPI_GET8(v, ai, 0, m, rsv[ai][m]);
                    if (fq == 0) {
#pragma unroll
                        for (int e = 0; e < 8; ++e) { const float z = v[e] + fb[e];
                            v[e] = fminf(z, 0.f) - __logf(1.0f + __expf(-fabsf(z))); }
                        *(f32x4*)(LF + (size_t)row * 8) = (f32x4){v[0], v[1], v[2], v[3]}; *(f32x4*)(LF + (size_t)row * 8 + 4) = (f32x4){v[4], v[5], v[6], v[7]};
                    } else {
#pragma unroll
                        for (int e = 0; e < 8; ++e) v[e] = sigmoidf_(v[e]);
                        float* p = DG + (size_t)row * 24 + 8 * (fq - 1); *(f32x4*)p = (f32x4){v[0], v[1], v[2], v[3]}; *(f32x4*)(p + 4) = (f32x4){v[4], v[5], v[6], v[7]};
                    } }
        }
    }
};
template <bool HU> struct Cmp1 {
    const float* bias; bf16_t* HID;
    __device__ __forceinline__ void operator()(Acc acc, const Unit& u, int wr, int wc, int fr, int fq) const {
        const int q0 = 32 * wc + 8 * fq;
        f32x4 bb[2][2];
#pragma unroll
        for (int bj = 0; bj < 2; ++bj) { bb[bj][0] = *(const f32x4*)(bias + bj * 128 + q0); bb[bj][1] = *(const f32x4*)(bias + bj * 128 + q0 + 4); }
#pragma unroll
        for (int ai = 0; ai < (HU ? 1 : 2); ++ai)
#pragma unroll
            for (int m = 0; m < 4; ++m) { const int row = HU ? u.r0 + EPI_ROWL(0, m) : EPI_ROW(u, ai, m);
#pragma unroll
                for (int bj = 0; bj < 2; ++bj) { float v[8]; EPI_GET8(v, ai, bj, m, 1.0f); const int c = bj * 128 + q0;
#pragma unroll
                    for (int e = 0; e < 8; ++e) { const float x = v[e] + (e < 4 ? bb[bj][0][e] : bb[bj][1][e - 4]); v[e] = x * sigmoidf_(1.5957691216057308f * (x + 0.044715f * x * x * x)); }
                    store8(HID + (size_t)row * 256 + c, v); } }
    }
};
template <bool ISK, bool HU> struct Cmp2 {
    const float *c128, *s128; bf16_t* OUT;
    __device__ __forceinline__ void operator()(Acc acc, const Unit& u, int wr, int wc, int fr, int fq) const {
        const int q0 = 32 * wc + 8 * fq; const float* c128_ = c128; const float* s128_ = s128; bf16_t* OUT_ = OUT;
        if (ISK) { if (wc < 2) {
            epi_pipe_n<RdRope>(HU ? 2 : 4, [&](int ai, int m, RdRope& d) { const int row = HU ? u.r0 + EPI_ROWL(0, m) : EPI_ROW(u, ai, m); const int grp = row >> 8, c = row & 255; const int tt = (grp >> 1) * S + 16 * (c < 255 ? c : 0) + 31; d.rs = 1.0f;
                                 ld_rope(d, c128_ + (size_t)tt * 64 + q0, s128_ + (size_t)tt * 64 + q0); },
                             [&](int ai, int m, const RdRope& d) { const int row = HU ? u.r0 + EPI_ROWL(0, m) : EPI_ROW(u, ai, m); const bool ok = (row & 255) < 255;
                                 float x1[8], x2[8], y1[8], y2[8]; EPI_GET8(x1, ai, 0, m, 1.0f); EPI_GET8(x2, ai, 1, m, 1.0f); rope8(x1, x2, d, y1, y2);
                                 if (!ok) {
#pragma unroll
                                     for (int e = 0; e < 8; ++e) { y1[e] = 0.f; y2[e] = 0.f; } }
                                 bf16_t* p = OUT_ + (size_t)row * 128 + q0; store8(p, y1); store8(p + 64, y2); }); } }
        else {
#pragma unroll
            for (int ai = 0; ai < (HU ? 1 : 2); ++ai)
#pragma unroll
                for (int m = 0; m < 4; ++m) { const int row = HU ? u.r0 + EPI_ROWL(0, m) : EPI_ROW(u, ai, m); const bool ok = (row & 255) < 255;
                    float v[8]; EPI_GET8(v, ai, 0, m, 1.0f);
                    if (!ok) {
#pragma unroll
                        for (int e = 0; e < 8; ++e) v[e] = 0.f; }
                    store8(OUT_ + (size_t)row * 128 + q0, v); }
        }
    }
};
#undef EPI_ROW
#undef EPI_ROWL
#undef EPI_GET8
}
namespace att {
enum { M_A = 0, M_B = 1, M_C = 2, M_W = 3, M_S = 4 };
template <int MODE> struct Cfg;
template <> struct Cfg<M_A> { static constexpr int DK = 128, WIN = 128; static constexpr bool GQA = true, CUM = false, SEL = false, Q8 = KV8; };
template <> struct Cfg<M_B> { static constexpr int DK = 192, WIN = 0;   static constexpr bool GQA = false, CUM = false, SEL = false, Q8 = KV8; };
template <> struct Cfg<M_C> { static constexpr int DK = 128, WIN = 0;   static constexpr bool GQA = false, CUM = true, SEL = false, Q8 = KV8; };
template <> struct Cfg<M_W> { static constexpr int DK = 128, WIN = 512; static constexpr bool GQA = true, CUM = false, SEL = false, Q8 = false; };
template <> struct Cfg<M_S> { static constexpr int DK = 128, WIN = 0;   static constexpr bool GQA = true, CUM = false, SEL = true, Q8 = false; };

constexpr int LK0 = 0, LK1 = 24576, LV0 = 49152, LV1 = 65536, LCUM = 81920;
constexpr bool FOLDC2 = true;
constexpr float THR = 8.0f;
#define KSWZ(RB, row, colB) ((row) * (RB) + ((colB) ^ (((row) & 7) << 4)))
#define VOFF(row, ch) (256 * (row) + 16 * ((ch) ^ ((((row) & 3) << 2) | (((row) >> 2) & 3))))

__device__ __forceinline__ int crow(int r) { return (r & 3) + 8 * (r >> 2); }
__device__ __forceinline__ bf16x8 pk8(const f32x16& p, int s) {
    u32x4 w; w.x = cvt_pk(p[8 * s + 0], p[8 * s + 1]); w.y = cvt_pk(p[8 * s + 2], p[8 * s + 3]); w.z = cvt_pk(p[8 * s + 4], p[8 * s + 5]); w.w = cvt_pk(p[8 * s + 6], p[8 * s + 7]);
    return *reinterpret_cast<bf16x8*>(&w);
}
template <int DK> __device__ __forceinline__ void kv_addr(int lane, int (&ka)[4], int (&va)[8]) {
    const int kr = lane & 31, hh = lane >> 5, blk = (lane >> 4) & 1, q = (lane & 15) >> 2, p = lane & 3;
#pragma unroll
    for (int i = 0; i < 4; ++i) ka[i] = KSWZ(DK * 2, kr, 32 * i + 16 * hh);
#pragma unroll
    for (int db = 0; db < 4; ++db)
#pragma unroll
        for (int t = 0; t < 2; ++t) va[2 * db + t] = VOFF(4 * hh + q + 8 * t, 4 * db + 2 * blk + (p >> 1)) + 8 * (p & 1);
}
template <int DK> __device__ __forceinline__ void qk_tile(const LAS unsigned char* kb, const int (&ka)[4], const bf16x8 (&qf)[DK / 16], f32x16& p0, f32x16& p1) {
#pragma unroll
    for (int r = 0; r < 16; ++r) { p0[r] = 0.f; p1[r] = 0.f; }
#pragma unroll
    for (int ks = 0; ks < DK / 16; ++ks) {
        const bf16x8 a0 = *(const LAS bf16x8*)(kb + ka[ks & 3] + (ks >> 2) * 128);
        const bf16x8 a1 = *(const LAS bf16x8*)(kb + ka[ks & 3] + (ks >> 2) * 128 + 32 * DK * 2);
        p0 = __builtin_amdgcn_mfma_f32_32x32x16_bf16(a0, qf[ks], p0, 0, 0, 0);
        p1 = __builtin_amdgcn_mfma_f32_32x32x16_bf16(a1, qf[ks], p1, 0, 0, 0);
    }
}
__device__ __forceinline__ u32x2 bf8_to_f8(const u32x4 w) {
    int a = (int)w.x, b = (int)w.z;
    a = __builtin_amdgcn_cvt_pk_fp8_f32(__uint_as_float(w.x << 16), __uint_as_float(w.x), a, false); a = __builtin_amdgcn_cvt_pk_fp8_f32(__uint_as_float(w.y << 16), __uint_as_float(w.y), a, true);
    b = __builtin_amdgcn_cvt_pk_fp8_f32(__uint_as_float(w.z << 16), __uint_as_float(w.z), b, false); b = __builtin_amdgcn_cvt_pk_fp8_f32(__uint_as_float(w.w << 16), __uint_as_float(w.w), b, true);
    u32x2 r; r.x = (unsigned)a; r.y = (unsigned)b; return r;
}
#define K8SWZ(row, colB) ((row) * 128 + ((colB) ^ (((row) & 7) << 4)))
#define K8SWZ2(row, colB) (8192 + (row) * 64 + ((colB) ^ ((((row) >> 1) & 3) << 4)))
__device__ __forceinline__ void k8_addr(int lane, int (&ka)[6]) {
    const int kr = lane & 31, hh = lane >> 5;
#pragma unroll
    for (int t = 0; t < 2; ++t)
#pragma unroll
        for (int u = 0; u < 2; ++u) ka[2 * t + u] = K8SWZ(kr, 64 * t + 32 * hh + 16 * u);
#pragma unroll
    for (int u = 0; u < 2; ++u) ka[4 + u] = K8SWZ2(kr, 32 * hh + 16 * u);
}
template <int DK> __device__ __forceinline__ void qk_tile8(const LAS unsigned char* kb, const int (&ka)[6], const i32x8 (&q8)[DK / 64], f32x16& p0, f32x16& p1) {
#pragma unroll
    for (int r = 0; r < 16; ++r) { p0[r] = 0.f; p1[r] = 0.f; }
#pragma unroll
    for (int t = 0; t < DK / 64; ++t) {
        const int rs = t < 2 ? 32 * 128 : 32 * 64;
        const i32x8 a0 = __builtin_shufflevector(*(const LAS i32x4*)(kb + ka[2 * t]), *(const LAS i32x4*)(kb + ka[2 * t + 1]), 0, 1, 2, 3, 4, 5, 6, 7);
        const i32x8 a1 = __builtin_shufflevector(*(const LAS i32x4*)(kb + ka[2 * t] + rs), *(const LAS i32x4*)(kb + ka[2 * t + 1] + rs), 0, 1, 2, 3, 4, 5, 6, 7);
        p0 = __builtin_amdgcn_mfma_scale_f32_32x32x64_f8f6f4(a0, q8[t], p0, 0, 0, 0, 0x7f7f7f7f, 0, 0x7f7f7f7f);
        p1 = __builtin_amdgcn_mfma_scale_f32_32x32x64_f8f6f4(a1, q8[t], p1, 0, 0, 0, 0x7f7f7f7f, 0, 0x7f7f7f7f);
    }
}
typedef short s16x4 __attribute__((ext_vector_type(4)));
__device__ __forceinline__ void pv_tile(const int vb, const int (&va)[8], const f32x16& p0, const f32x16& p1, f32x16 (&o)[4]) {
    const bf16x8 pb[4] = {pk8(p0, 0), pk8(p0, 1), pk8(p1, 0), pk8(p1, 1)};
#define TRRD(dst, a, off) asm volatile("ds_read_b64_tr_b16 %0, %1 offset:%2" : "=&v"(dst) : "v"(a), "i"(off) : "memory")
#pragma unroll
    for (int db = 0; db < 4; ++db) {
        s16x4 l0, l1, l2, l3, h0, h1, h2, h3; const int a0 = va[2 * db] + vb, a1 = va[2 * db + 1] + vb;
        TRRD(l0, a0, 0); TRRD(h0, a1, 0); TRRD(l1, a0, 4096); TRRD(h1, a1, 4096); TRRD(l2, a0, 8192); TRRD(h2, a1, 8192); TRRD(l3, a0, 12288); TRRD(h3, a1, 12288);
        asm volatile("s_waitcnt lgkmcnt(0)" ::: "memory"); __builtin_amdgcn_sched_barrier(0);
        o[db] = __builtin_amdgcn_mfma_f32_32x32x16_bf16((bf16x8){l0[0], l0[1], l0[2], l0[3], h0[0], h0[1], h0[2], h0[3]}, pb[0], o[db], 0, 0, 0);
        o[db] = __builtin_amdgcn_mfma_f32_32x32x16_bf16((bf16x8){l1[0], l1[1], l1[2], l1[3], h1[0], h1[1], h1[2], h1[3]}, pb[1], o[db], 0, 0, 0);
        o[db] = __builtin_amdgcn_mfma_f32_32x32x16_bf16((bf16x8){l2[0], l2[1], l2[2], l2[3], h2[0], h2[1], h2[2], h2[3]}, pb[2], o[db], 0, 0, 0);
        o[db] = __builtin_amdgcn_mfma_f32_32x32x16_bf16((bf16x8){l3[0], l3[1], l3[2], l3[3], h3[0], h3[1], h3[2], h3[3]}, pb[3], o[db], 0, 0, 0);
    }
#undef TRRD
}
#define V8OFF(row, colB) ((row) * 128 + ((colB) ^ (((((row) >> 1) & 1) | ((((row) >> 3) & 1) << 1)) << 5)))
__device__ __forceinline__ void v8_addr(int lane, int (&va8)[4]) {
    const int hh = lane >> 5, blk = (lane >> 4) & 1, q = (lane & 15) >> 1, p = lane & 1;
    const int key0 = 8 * (q >> 2) + 4 * hh + (q & 3);
#pragma unroll
    for (int db = 0; db < 4; ++db) va8[db] = V8OFF(key0, 32 * db + 16 * blk + 8 * p);
}
typedef int i32x2 __attribute__((ext_vector_type(2)));
__device__ __forceinline__ float pv_tile8(const int vb, const int (&va8)[4], const f32x16& p0, const f32x16& p1, f32x16 (&o)[4], const i32x8& ones) {
    i32x8 pb;
#pragma unroll
    for (int s2 = 0; s2 < 2; ++s2) { float v[8];
#pragma unroll
        for (int e = 0; e < 8; ++e) v[e] = p0[8 * s2 + e];
        u32x2 w = pack8_f8(v); pb[2 * s2] = (int)w.x; pb[2 * s2 + 1] = (int)w.y;
#pragma unroll
        for (int e = 0; e < 8; ++e) v[e] = p1[8 * s2 + e];
        w = pack8_f8(v); pb[4 + 2 * s2] = (int)w.x; pb[4 + 2 * s2 + 1] = (int)w.y; }
#pragma unroll
    for (int db = 0; db < 4; ++db) {
        const LAS unsigned char* a = (const LAS unsigned char*)(unsigned)(va8[db] + vb);
        const i32x2 r0 = __builtin_amdgcn_ds_read_tr8_b64_v2i32((LAS i32x2*)(a)), r1 = __builtin_amdgcn_ds_read_tr8_b64_v2i32((LAS i32x2*)(a + 2048));
        const i32x2 r2 = __builtin_amdgcn_ds_read_tr8_b64_v2i32((LAS i32x2*)(a + 4096)), r3 = __builtin_amdgcn_ds_read_tr8_b64_v2i32((LAS i32x2*)(a + 6144));
        const i32x8 av = {r0[0], r0[1], r1[0], r1[1], r2[0], r2[1], r3[0], r3[1]};
        o[db] = __builtin_amdgcn_mfma_scale_f32_32x32x64_f8f6f4(av, pb, o[db], 0, 0, 0, 0x7f7f7f7f, 0, 0x7f7f7f7f);
    }
    f32x16 z;
#pragma unroll
    for (int r = 0; r < 16; ++r) z[r] = 0.f;
    const f32x16 lt = __builtin_amdgcn_mfma_scale_f32_32x32x64_f8f6f4(ones, pb, z, 0, 0, 0, 0x7f7f7f7f, 0, 0x7f7f7f7f);
    return lt[0];
}

template <int MODE>
__device__ __forceinline__ void flash(const Frame& F, const bf16_t* qrow, const bf16_t* kbase, int ldk, const bf16_t* krope, const bf16_t* vbase, int ldv, const float* cumk, float cumq,
                                      int tpos, int tw_lo, int tw_hi, int tlo, int thi, u64 sel, u64 selu, float c2, float& m_run, float& l_run, f32x16 (&o)[4]) {
    typedef Cfg<MODE> C; constexpr int DK = C::DK, NKC = DK / 64;
    const int tid = F.tid, lane = F.lane, hh = lane >> 5;
    LAS unsigned char* lds = F.lds;
    bf16x8 qf[QK8 ? 1 : DK / 16]; i32x8 q8[DK / 64];
    int ka[4], va[8]; kv_addr<DK>(lane, ka, va); int ka8[6], va8[4]; if (PV8) v8_addr(lane, va8);
    i32x8 ones8;
#pragma unroll
    for (int i = 0; i < 8; ++i) ones8[i] = 0x38383838;
    asm volatile("" : "+v"(ones8));
    if (QK8) {
        k8_addr(lane, ka8);
#pragma unroll
        for (int t = 0; t < DK / 64; ++t)
#pragma unroll
            for (int jq = 0; jq < 4; ++jq) {
                if (C::Q8) { if (jq < 2) { const u32x4 w = *(const u32x4*)((const unsigned char*)qrow + 64 * t + 32 * hh + 16 * jq); q8[t][4 * jq] = (int)w.x; q8[t][4 * jq + 1] = (int)w.y; q8[t][4 * jq + 2] = (int)w.z; q8[t][4 * jq + 3] = (int)w.w; } }
                else { const u32x2 w = bf8_to_f8(*(const u32x4*)(qrow + 64 * t + 32 * hh + 8 * jq)); q8[t][2 * jq] = (int)w.x; q8[t][2 * jq + 1] = (int)w.y; } }
    } else {
#pragma unroll
        for (int ks = 0; ks < DK / 16; ++ks) qf[ks] = *(const bf16x8*)(qrow + 16 * ks + 8 * hh);
    }
    auto next_tile = [&](int j) -> int {
        if (!C::SEL) return j + 1;
        const u64 mk = (j >= 63) ? 0ull : (selu & ~((2ull << j) - 1ull));
        const int n = mk ? (__ffsll((long long)mk) - 1) : 64;
        return n < thi ? n : thi;
    };
    int j = tlo;
    if (C::SEL) { if (!((selu >> tlo) & 1ull)) j = next_tile(tlo); }
    if (j >= thi) return;
    u32x4 kreg[NKC], vreg[2]; float creg = 0.f;
    u32x4 k8m, k8r, v8m;
    unsigned koff[NKC], voff[2];
#pragma unroll
    for (int i = 0; i < NKC; ++i) { const int c = tid + i * NTHR, row = c / (DK / 8), c8 = c % (DK / 8);
        koff[i] = (DK == 192 && c8 >= 16) ? (0x80000000u | (unsigned)(row * 64 + (c8 - 16) * 8) * 2u) : (unsigned)(row * ldk + c8 * 8) * 2u; }
#pragma unroll
    for (int i = 0; i < 2; ++i) { const int c = tid + i * NTHR, row = c >> 4, ch = c & 15; voff[i] = (unsigned)(row * ldv + ch * 8) * 2u; }
    const unsigned kso = (unsigned)((tid >> 3) * ldk + (((tid & 7) ^ ((tid >> 3) & 7)) * 16));
    const unsigned vso = (unsigned)((tid >> 3) * ldv + (((tid & 7) ^ (((((tid >> 3) >> 1) & 1) | ((((tid >> 3) >> 3) & 1) << 1)) << 1)) * 16));
    const unsigned rso = (unsigned)((tid >> 2) * 64 + (((tid & 3) ^ (((tid >> 2) >> 1) & 3)) * 16));
    const int wv = F.wave;
    auto dma = [&](int jt, int b) {
        LAS unsigned char* kb = lds + (b ? LK1 : LK0) + wv * 1024; LAS unsigned char* vb = lds + (b ? LV1 : LV0) + wv * 1024;
        const char* kt8 = (const char*)kbase + (size_t)jt * 64 * ldk; const char* vt8 = (const char*)vbase + (size_t)jt * 64 * ldv;
        __builtin_amdgcn_global_load_lds((const unsigned*)(kt8 + kso), (LAS unsigned*)kb, 16, 0, 0);
        __builtin_amdgcn_global_load_lds((const unsigned*)(vt8 + vso), (LAS unsigned*)vb, 16, 0, 0);
        if (DK == 192) { if (wv < 4) __builtin_amdgcn_global_load_lds((const unsigned*)((const char*)krope + (size_t)jt * 64 * 64 + rso), (LAS unsigned*)(kb + 8192), 16, 0, 0); }
        if (C::CUM) { if (tid < 64) creg = cumk[jt * 64 + tid]; }
    };
    auto dma_done = [&](int b) {
        if (C::CUM) { if (tid < 64) ((LAS float*)(lds + LCUM))[b * 64 + tid] = creg; }
        asm volatile("s_waitcnt vmcnt(0)" ::: "memory");
    };
    auto gload = [&](int jt) {
        if constexpr (KV8) {
            const char* kt8 = (const char*)kbase + (size_t)jt * 64 * ldk; const char* vt8 = (const char*)vbase + (size_t)jt * 64 * ldv;
            k8m = *(const u32x4*)(kt8 + (size_t)(tid >> 3) * ldk + (tid & 7) * 16); v8m = *(const u32x4*)(vt8 + (size_t)(tid >> 3) * ldv + (tid & 7) * 16);
            if (DK == 192) { if (tid < 256) k8r = *(const u32x4*)((const char*)krope + (size_t)jt * 64 * 64 + tid * 16); }
            if (C::CUM) { if (tid < 64) creg = cumk[jt * 64 + tid]; }
            return;
        }
        const char* kt = (const char*)kbase + (size_t)jt * 64 * ldk * 2; const char* vtt = (const char*)vbase + (size_t)jt * 64 * ldv * 2; const char* krt = (const char*)krope + (size_t)jt * 64 * 128;
#pragma unroll
        for (int i = 0; i < NKC; ++i) kreg[i] = (DK == 192 && (koff[i] & 0x80000000u)) ? *(const u32x4*)(krt + (koff[i] & 0x7fffffffu)) : *(const u32x4*)(kt + koff[i]);
#pragma unroll
        for (int i = 0; i < 2; ++i) vreg[i] = *(const u32x4*)(vtt + voff[i]);
        if (C::CUM) { if (tid < 64) creg = cumk[jt * 64 + tid]; }
    };
    auto lstore = [&](int buf) {
        LAS unsigned char* kb = lds + (buf ? LK1 : LK0); LAS unsigned char* vb = lds + (buf ? LV1 : LV0);
        if constexpr (KV8) {
            *(LAS u32x4*)(kb + K8SWZ(tid >> 3, (tid & 7) * 16)) = k8m; *(LAS u32x4*)(vb + V8OFF(tid >> 3, (tid & 7) * 16)) = v8m;
            if (DK == 192) { if (tid < 256) *(LAS u32x4*)(kb + K8SWZ2(tid >> 2, (tid & 3) * 16)) = k8r; }
            if (C::CUM) { if (tid < 64) ((LAS float*)(lds + LCUM))[buf * 64 + tid] = creg; }
            return;
        }
#pragma unroll
        for (int i = 0; i < NKC; ++i) { const int c = tid + i * NTHR, row = c / (DK / 8), c8 = c % (DK / 8);
            if (QK8) *(LAS u32x2*)(kb + (c8 < 16 ? K8SWZ(row, c8 * 8) : K8SWZ2(row, (c8 - 16) * 8))) = bf8_to_f8(kreg[i]);
            else *(LAS u32x4*)(kb + KSWZ(DK * 2, row, c8 * 16)) = kreg[i]; }
#pragma unroll
        for (int i = 0; i < 2; ++i) { const int c = tid + i * NTHR, row = c >> 4, ch = c & 15;
            if (PV8) *(LAS u32x2*)(vb + V8OFF(row, 8 * ch)) = bf8_to_f8(vreg[i]);
            else *(LAS u32x4*)(vb + VOFF(row, ch)) = vreg[i]; }
        if (C::CUM) { if (tid < 64) ((LAS float*)(lds + LCUM))[buf * 64 + tid] = creg; }
    };
    if constexpr (KVDMA) { dma(j, 0); dma_done(0); } else { gload(j); lstore(0); }
    __syncthreads();
    int buf = 0;
    constexpr unsigned WCMP = C::WIN ? (unsigned)C::WIN : 0x7fffffffu;
    while (j < thi) {
        const int jn = next_tile(j);
        if (jn < thi) { if constexpr (KVDMA) dma(jn, buf ^ 1); else gload(jn); }
        bool act = (64 * j <= tw_hi);
        if (C::WIN) act = act && (64 * j + 63 >= tw_lo - (C::WIN - 1));
        const bool selb = C::SEL ? (((sel >> j) & 1ull) != 0ull) : true;
        if (C::SEL) act = act && (__ballot(selb) != 0ull);
        if (act) {
            const LAS unsigned char* kb = lds + (buf ? LK1 : LK0);
            f32x16 p0, p1;
            if constexpr (QK8) qk_tile8<DK>(kb, ka8, q8, p0, p1); else qk_tile<DK>(kb, ka, qf, p0, p1);
            if (C::CUM) {
                const LAS float* cb = (const LAS float*)(lds + LCUM) + buf * 64 + 4 * hh;
#pragma unroll
                for (int g = 0; g < 4; ++g) { const f32x4 k0 = *(const LAS f32x4*)(cb + 8 * g), k1 = *(const LAS f32x4*)(cb + 32 + 8 * g);
#pragma unroll
                    for (int e = 0; e < 4; ++e) { p0[4 * g + e] = fmaf(p0[4 * g + e], c2, cumq - k0[e]); p1[4 * g + e] = fmaf(p1[4 * g + e], c2, cumq - k1[e]); } }
            } else if (!FOLDC2) {
#pragma unroll
                for (int r = 0; r < 16; ++r) { p0[r] *= c2; p1[r] *= c2; }
            }
            bool need = (64 * j + 63 > tw_lo);
            if (C::WIN) need = need || (tw_hi - 64 * j >= C::WIN);
            if (C::SEL) need = true;
            if (need) {
                const float NEG = -__builtin_inff();
                int dq = tpos - 64 * j - 4 * hh; if (C::SEL && !selb) dq = -1;
#pragma unroll
                for (int r = 0; r < 16; ++r) { const int c = crow(r);
                    if ((unsigned)(dq - c) >= WCMP) p0[r] = NEG;
                    if ((unsigned)(dq - c - 32) >= WCMP) p1[r] = NEG; }
            }
            float pmax = p0[0];
#pragma unroll
            for (int r = 1; r < 16; ++r) pmax = fmaxf(pmax, p0[r]);
#pragma unroll
            for (int r = 0; r < 16; ++r) pmax = fmaxf(pmax, p1[r]);
            pmax = fmaxf(pmax, __shfl_xor(pmax, 32));
            if (!C::CUM && FOLDC2) pmax *= c2;
            float mn = m_run;
            if (!__all(pmax - m_run <= THR)) {
                mn = fmaxf(m_run, pmax); const float alpha = fast_exp2(m_run - mn); m_run = mn; l_run *= alpha;
#pragma unroll
                for (int db = 0; db < 4; ++db)
#pragma unroll
                    for (int r = 0; r < 16; ++r) o[db][r] *= alpha;
            }
            float ps = 0.f;
#pragma unroll
            for (int r = 0; r < 16; ++r) {
                if (C::CUM || !FOLDC2) { p0[r] = fast_exp2(p0[r] - mn); p1[r] = fast_exp2(p1[r] - mn); }
                else { p0[r] = fast_exp2(fmaf(p0[r], c2, -mn)); p1[r] = fast_exp2(fmaf(p1[r], c2, -mn)); }
                if (!PV8) ps += p0[r] + p1[r]; }
            if (!PV8) { ps += __shfl_xor(ps, 32); l_run += ps; }
            if (PV8) l_run += pv_tile8(buf ? LV1 : LV0, va8, p0, p1, o, ones8); else pv_tile(buf ? LV1 : LV0, va, p0, p1, o);
        }
        if (jn < thi) { if constexpr (KVDMA) dma_done(buf ^ 1); else lstore(buf ^ 1); }
        __syncthreads();
        j = jn; buf ^= 1;
    }
}

template <bool ADD, bool IMG = false, bool NOBF = false>
__device__ __forceinline__ void out_row(bf16_t* orow, const f32x16 (&o)[4], float scale, int hh, unsigned char* o8 = nullptr) {
#pragma unroll
    for (int db = 0; db < 4; ++db) {
        u32x2 wb[4], wo[4]; unsigned qi[4];
        if (ADD) {
#pragma unroll
            for (int pr = 0; pr < 2; ++pr) { const u32x4 l = *(const u32x4*)(orow + 32 * db + 16 * pr + 8 * hh);
                const auto rx = __builtin_amdgcn_permlane32_swap(l.x, l.z, false, false); const auto ry = __builtin_amdgcn_permlane32_swap(l.y, l.w, false, false);
                wo[2 * pr].x = rx[0]; wo[2 * pr].y = ry[0]; wo[2 * pr + 1].x = rx[1]; wo[2 * pr + 1].y = ry[1]; }
        }
#pragma unroll
        for (int g = 0; g < 4; ++g) {
            float v0 = o[db][4 * g] * scale, v1 = o[db][4 * g + 1] * scale, v2 = o[db][4 * g + 2] * scale, v3 = o[db][4 * g + 3] * scale;
            if (ADD) { const u32x2 w = wo[g]; v0 += __uint_as_float(w.x << 16); v1 += __uint_as_float(w.x & 0xffff0000u); v2 += __uint_as_float(w.y << 16); v3 += __uint_as_float(w.y & 0xffff0000u); }
            if (!NOBF) { wb[g].x = cvt_pk(v0, v1); wb[g].y = cvt_pk(v2, v3); }
            if (IMG) { int q = __float_as_int(v0); q = __builtin_amdgcn_cvt_pk_fp8_f32(v0 * F8_OSC, v1 * F8_OSC, q, false); q = __builtin_amdgcn_cvt_pk_fp8_f32(v2 * F8_OSC, v3 * F8_OSC, q, true); qi[g] = (unsigned)q; }
        }
        if (!NOBF) {
#pragma unroll
            for (int pr = 0; pr < 2; ++pr) {
                const auto rx = __builtin_amdgcn_permlane32_swap(wb[2 * pr].x, wb[2 * pr + 1].x, false, false); const auto ry = __builtin_amdgcn_permlane32_swap(wb[2 * pr].y, wb[2 * pr + 1].y, false, false);
                *(u32x4*)(orow + 32 * db + 16 * pr + 8 * hh) = (u32x4){rx[0], ry[0], rx[1], ry[1]};
            }
        }
        if (IMG) {
            const auto a = __builtin_amdgcn_permlane32_swap(qi[0], qi[1], false, false); const auto b = __builtin_amdgcn_permlane32_swap(qi[2], qi[3], false, false);
            const auto x = __builtin_amdgcn_permlane32_swap(a[0], b[0], false, false); const auto y = __builtin_amdgcn_permlane32_swap(a[1], b[1], false, false);
            *(u32x4*)(o8 + 32 * db + 16 * hh) = (u32x4){x[0], y[0], x[1], y[1]};
        }
    }
}
__device__ __forceinline__ void zero_o(f32x16 (&o)[4]) {
#pragma unroll
    for (int db = 0; db < 4; ++db)
#pragma unroll
        for (int r = 0; r < 16; ++r) o[db][r] = 0.f;
}
constexpr float TINY = 1.17549435e-38f;

__device__ __forceinline__ const bf16_t* kvp(const bf16_t* base, size_t el) { return (const bf16_t*)((const unsigned char*)base + el * (KV8 ? 1 : 2)); }
struct L0Bufs { const bf16_t *QA, *KA, *VA, *QB, *KB, *KR, *VB; const float* sinks; bf16_t* O; };
__device__ __forceinline__ void item_A(const Frame& F, const L0Bufs& Bf, int b, int hk, int qt) {
    const int lane = F.lane, n = lane & 31, hh = lane >> 5, w = F.wave;
    const int tok = 64 * qt + 8 * w + (n & 7), head = 4 * hk + (n >> 3);
    const bf16_t* qrow = kvp(Bf.QA, ((size_t)b * S + tok) * 1024 + head * 128);
    float m = Bf.sinks[head] * LOG2E, l = 1.0f; f32x16 o[4]; zero_o(o);
    const int tlo = qt - 2 < 0 ? 0 : qt - 2;
    flash<M_A>(F, qrow, kvp(Bf.KA, (size_t)b * S * 256 + hk * 128), 256, nullptr, kvp(Bf.VA, (size_t)b * S * 256 + hk * 128), 256, nullptr, 0.f,
               tok, 64 * qt + 8 * w, 64 * qt + 8 * w + 7, tlo, qt + 1, 0ull, 0ull, 0.08838834764831845f * LOG2E, m, l, o);
    out_row<false, F8_WO0, F8_WO0>(Bf.O + ((size_t)b * S + tok) * D + head * 128, o, 1.0f / fmaxf(l, TINY), hh, F.ws + WS_O8 + ((size_t)b * S + tok) * D + head * 128);
}
__device__ __forceinline__ void item_B(const Frame& F, const L0Bufs& Bf, int b, int h, int qt) {
    const int lane = F.lane, n = lane & 31, hh = lane >> 5, w = F.wave;
    const int tok = 256 * qt + 32 * w + n;
    const bf16_t* qrow = kvp(Bf.QB, ((size_t)b * S + tok) * 1536 + h * 192);
    float m = -1e30f, l = 0.f; f32x16 o[4]; zero_o(o);
    flash<M_B>(F, qrow, kvp(Bf.KB, (size_t)b * S * 1024 + h * 128), 1024, kvp(Bf.KR, (size_t)b * S * 64), kvp(Bf.VB, (size_t)b * S * 1024 + h * 128), 1024, nullptr, 0.f,
               tok, 256 * qt + 32 * w, 256 * qt + 32 * w + 31, 0, 4 * (qt + 1), 0ull, 0ull, 0.07216878364870322f * LOG2E, m, l, o);
    out_row<false, F8_WO0, F8_WO0>(Bf.O + ((size_t)b * S + tok) * D + 1024 + h * 128, o, 1.0f / fmaxf(l, TINY), hh, F.ws + WS_O8 + ((size_t)b * S + tok) * D + 1024 + h * 128);
}
struct L1Bufs { const bf16_t *CQ, *CK, *CV, *DQ, *KS, *VS, *KW, *VW, *KCMP, *VCMP; const float *CUM, *DG; u64* SEL; bf16_t* O; };
__device__ __forceinline__ void item_C(const Frame& F, const L1Bufs& Bf, int b, int h, int qt) {
    const int lane = F.lane, n = lane & 31, hh = lane >> 5, w = F.wave;
    const int tok = 256 * qt + 32 * w + n;
    const bf16_t* qrow = kvp(Bf.CQ, ((size_t)b * S + tok) * 1024 + h * 128);
    const float* cumk = Bf.CUM + (size_t)(b * 8 + h) * S;
    float m = -1e30f, l = 0.f; f32x16 o[4]; zero_o(o);
    flash<M_C>(F, qrow, kvp(Bf.CK, (size_t)b * S * 1024 + h * 128), 1024, nullptr, kvp(Bf.CV, (size_t)b * S * 1024 + h * 128), 1024, cumk, cumk[tok],
               tok, 256 * qt + 32 * w, 256 * qt + 32 * w + 31, 0, 4 * (qt + 1), 0ull, 0ull, 0.08838834764831845f * LOG2E, m, l, o);
    out_row<false, F8_WO1, F8_WO1>(Bf.O + ((size_t)b * S + tok) * D + h * 128, o, 1.0f / fmaxf(l, TINY), hh, F.ws + WS_O8 + ((size_t)b * S + tok) * D + h * 128);
}
__device__ __forceinline__ void item_W(const Frame& F, const L1Bufs& Bf, int b, int hk, int qt) {
    const int lane = F.lane, n = lane & 31, hh = lane >> 5, w = F.wave;
    const int tok = 64 * qt + 8 * w + (n & 7), head = 4 * hk + (n >> 3);
    const bf16_t* qrow = Bf.DQ + ((size_t)b * S + tok) * 1024 + head * 128;
    float m = -1e30f, l = 0.f; f32x16 o[4]; zero_o(o);
    const int tlo = qt - 8 < 0 ? 0 : qt - 8;
    flash<M_W>(F, qrow, kvp(Bf.KW, (size_t)b * S * 256 + hk * 128), 256, nullptr, kvp(Bf.VW, (size_t)b * S * 256 + hk * 128), 256, nullptr, 0.f,
               tok, 64 * qt + 8 * w, 64 * qt + 8 * w + 7, tlo, qt + 1, 0ull, 0ull, 0.08838834764831845f * LOG2E, m, l, o);
    const float g2 = Bf.DG[((size_t)b * S + tok) * 24 + 16 + head];
    out_row<false>(Bf.O + ((size_t)b * S + tok) * D + 1024 + head * 128, o, g2 / fmaxf(l, TINY), hh);
}
__device__ __forceinline__ void item_S(const Frame& F, const L1Bufs& Bf, int b, int hk, int qt) {
    const int tid = F.tid, lane = F.lane, n = lane & 31, hh = lane >> 5, w = F.wave;
    const int tl = 8 * w + (n & 7), tok = 64 * qt + tl, gq = n >> 3, head = 4 * hk + gq;
    const bf16_t* qrow = Bf.DQ + ((size_t)b * S + tok) * 1024 + head * 128;
    LAS unsigned char* lds = F.lds;
    LAS float* imp = (LAS float*)(lds + LDS_IMP);
    LAS u64* selL = (LAS u64*)(lds + LDS_SEL);
    const float c2 = 0.08838834764831845f * LOG2E;
    bf16_t* orow = Bf.O + ((size_t)b * S + tok) * D + 1024 + head * 128;
    const int cmax = (64 * qt + 63 - 31) >> 4;
    const int ntile = (cmax >> 6) + 1;
    for (int i = tid; i < 64 * 64; i += NTHR) imp[i] = 0.f;
    {
        const bf16_t* kc = Bf.KCMP + (size_t)(b * 2 + hk) * 256 * 128; const bf16_t* vc = Bf.VCMP + (size_t)(b * 2 + hk) * 256 * 128;
        for (int c = tid; c < ntile * 1024; c += NTHR) { const int tt = c >> 10, cc = c & 1023, row = cc >> 4, c8 = cc & 15;
            *(LAS u32x4*)(lds + tt * 16384 + KSWZ(256, row, c8 * 16)) = *(const u32x4*)(kc + (size_t)(tt * 64 + row) * 128 + c8 * 8);
            *(LAS u32x4*)(lds + 65536 + tt * 16384 + VOFF(row, c8)) = *(const u32x4*)(vc + (size_t)(tt * 64 + row) * 128 + c8 * 8); }
    }
    __syncthreads();
    bf16x8 qf[8];
#pragma unroll
    for (int ks = 0; ks < 8; ++ks) qf[ks] = *(const bf16x8*)(qrow + 16 * ks + 8 * hh);
    int ka[4], va[8]; kv_addr<128>(lane, ka, va);
    const int cq = (tok - 31) >> 4;
    float m = -1e30f, l = 0.f;
    for (int tt = 0; tt < ntile; ++tt) {
        f32x16 p0, p1; qk_tile<128>(lds + tt * 16384, ka, qf, p0, p1);
        const int dq = cq - 64 * tt - 4 * hh; float pmax = -__builtin_inff();
#pragma unroll
        for (int r = 0; r < 16; ++r) { const int c = crow(r);
            p0[r] = (dq - c >= 0) ? p0[r] * c2 : -__builtin_inff(); p1[r] = (dq - c - 32 >= 0) ? p1[r] * c2 : -__builtin_inff(); pmax = fmaxf(pmax, fmaxf(p0[r], p1[r])); }
        pmax = fmaxf(pmax, __shfl_xor(pmax, 32));
        const float mn = fmaxf(m, pmax); float ps = 0.f;
#pragma unroll
        for (int r = 0; r < 16; ++r) ps += fast_exp2(p0[r] - mn) + fast_exp2(p1[r] - mn);
        ps += __shfl_xor(ps, 32);
        l = l * fast_exp2(m - mn) + ps; m = mn;
    }
    const float invl = 1.0f / fmaxf(l, TINY);
    f32x16 o[4]; zero_o(o);
    float carry = 0.f;
    for (int tt = 0; tt < ntile; ++tt) {
        f32x16 p0, p1; qk_tile<128>(lds + tt * 16384, ka, qf, p0, p1);
        const int dq = cq - 64 * tt - 4 * hh;
#pragma unroll
        for (int r = 0; r < 16; ++r) { const int c = crow(r);
            p0[r] = (dq - c >= 0) ? fast_exp2(p0[r] * c2 - m) * invl : 0.f; p1[r] = (dq - c - 32 >= 0) ? fast_exp2(p1[r] * c2 - m) * invl : 0.f; }
        float qs[8], e3[8];
#pragma unroll
        for (int q = 0; q < 4; ++q) { qs[q] = (p0[4 * q] + p0[4 * q + 1]) + (p0[4 * q + 2] + p0[4 * q + 3]); e3[q] = p0[4 * q + 3];
                                      qs[4 + q] = (p1[4 * q] + p1[4 * q + 1]) + (p1[4 * q + 2] + p1[4 * q + 3]); e3[4 + q] = p1[4 * q + 3]; }
        float pe[8];
#pragma unroll
        for (int q = 0; q < 8; ++q) pe[q] = __shfl_xor(e3[q], 32);
#pragma unroll
        for (int q = 0; q < 8; ++q) { const float add = hh ? pe[q] : (q > 0 ? pe[q - 1] : carry); float v = qs[q] + add;
            v += __shfl_xor(v, 8); v += __shfl_xor(v, 16);
            if (gq == 0) imp[tl * 64 + 16 * tt + 2 * q + hh] = v; }
        carry = pe[7];
        pv_tile(65536 + tt * 16384, va, p0, p1, o);
    }
    const float* dg = Bf.DG + ((size_t)b * S + tok) * 24;
    out_row<true>(orow, o, dg[head], hh);
    __syncthreads();
    {
        const int srow = tid >> 3, part = tid & 7, cur = qt;
        u64 mk = 1ull | (1ull << cur); if (cur >= 1) mk |= 1ull << (cur - 1);
        const int nvalid = cur + 1, ksel = nvalid < 8 ? nvalid : 8;
        const f32x4 i0 = *(const LAS f32x4*)(imp + srow * 64 + part * 8), i1 = *(const LAS f32x4*)(imp + srow * 64 + part * 8 + 4);
        const float iv[8] = {i0[0], i0[1], i0[2], i0[3], i1[0], i1[1], i1[2], i1[3]};
        unsigned lm = (unsigned)(mk >> (part * 8)) & 0xffu;
        unsigned vm = 0u;
#pragma unroll
        for (int i = 0; i < 8; ++i) vm |= (part * 8 + i <= cur) ? (1u << i) : 0u;
        for (int have = __popcll(mk); have < ksel; ++have) {
            float bv = -__builtin_inff(); int bi = 64;
#pragma unroll
            for (int i = 0; i < 8; ++i) if (((vm & ~lm) >> i) & 1u) { if (iv[i] > bv) { bv = iv[i]; bi = part * 8 + i; } }
#pragma unroll
            for (int off = 1; off < 8; off <<= 1) { const float ov = __shfl_xor(bv, off); const int oi = __shfl_xor(bi, off); if (ov > bv || (ov == bv && oi < bi)) { bv = ov; bi = oi; } }
            mk |= 1ull << bi; if ((bi >> 3) == part) lm |= 1u << (bi & 7);
        }
        if (part == 0) { selL[srow] = mk; Bf.SEL[(size_t)(b * 2 + hk) * S + 64 * qt + srow] = mk; }
    }
    __syncthreads();
    const u64 sel = selL[tl]; u64 selu = 0ull;
    for (int i = 0; i < 64; ++i) selu |= selL[i];
    __syncthreads();
    m = -1e30f; l = 0.f; zero_o(o);
    flash<M_S>(F, qrow, kvp(Bf.KS, (size_t)b * S * 256 + hk * 128), 256, nullptr, kvp(Bf.VS, (size_t)b * S * 256 + hk * 128), 256, nullptr, 0.f,
               tok, 64 * qt + 8 * w, 64 * qt + 8 * w + 7, 0, qt + 1, sel, selu, c2, m, l, o);
    out_row<true, F8_WO1>(orow, o, dg[8 + head] / fmaxf(l, TINY), hh, F.ws + WS_O8 + (size_t)(orow - Bf.O));
}
#undef KSWZ
#undef K8SWZ
#undef K8SWZ2
#undef V8OFF
#undef VOFF
}
__device__ __forceinline__ void router_phase(const Params& P, const Frame& F, int layer, const bf16_t* h) {
    unsigned char* ws = P.ws;
    const bf16_t* wrh = (const bf16_t*)(ws + WS_WRT) + (size_t)layer * 48 * 2048; const bf16_t* wrl = wrh + 2 * 48 * 2048;
    const float* gb = P.in[I_RGB] + layer * 4; const float* eb = P.in[I_REB] + layer * 32;
    float* rstdm = (float*)(ws + WS_RSTDM); int* slote = (int*)(ws + WS_SLOTE); int* slotr = (int*)(ws + WS_SLOTR);
    int* list = (int*)(ws + WS_LIST); float* wlist = (float*)(ws + WS_WLIST); float* rlist = (float*)(ws + WS_RLIST); unsigned* cntg = F.ctl + CW_CNT + layer * 32;
    LAS float* part = (LAS float*)F.lds;
    LAS float* ssqL = part + 2 * 64 * 48;
    LAS unsigned* cl = (LAS unsigned*)(ssqL + 128);
    LAS int* asg = (LAS int*)(cl + 64);
    LAS float* asw = (LAS float*)(asg + 256);
    const int tid = F.tid, lane = F.lane, w = F.wave, tg = w & 3, kh = w >> 2, li = lane & 15, kq = lane >> 4;
    for (int blk = F.bx; blk < T / 64; blk += F.G) {
        const int tok0 = blk * 64;
        if (tid < 32) cl[tid] = 0u;
        f32x4 acc[3]; acc[0] = acc[1] = acc[2] = (f32x4){0.f, 0.f, 0.f, 0.f}; float ss = 0.f;
        const bf16_t* hp = h + (size_t)(tok0 + 16 * tg + li) * D + kh * 1024 + 8 * kq;
        const bf16_t* wph = wrh + (size_t)li * 2048 + kh * 1024 + 8 * kq; const bf16_t* wpl = wrl + (size_t)li * 2048 + kh * 1024 + 8 * kq;
#pragma unroll 4
        for (int c = 0; c < 32; ++c) {
            const u32x4 au = *(const u32x4*)(hp + 32 * c); const bf16x8 a = __builtin_bit_cast(bf16x8, au);
            float av[8]; unpack8(au, av);
#pragma unroll
            for (int e = 0; e < 8; ++e) ss += av[e] * av[e];
#pragma unroll
            for (int nb = 0; nb < 3; ++nb) {
                const bf16x8 bh = *(const bf16x8*)(wph + (size_t)nb * 16 * 2048 + 32 * c), bl = *(const bf16x8*)(wpl + (size_t)nb * 16 * 2048 + 32 * c);
                acc[nb] = __builtin_amdgcn_mfma_f32_16x16x32_bf16(a, bh, acc[nb], 0, 0, 0);
                acc[nb] = __builtin_amdgcn_mfma_f32_16x16x32_bf16(a, bl, acc[nb], 0, 0, 0);
            }
        }
        ss += __shfl_xor(ss, 16); ss += __shfl_xor(ss, 32);
#pragma unroll
        for (int nb = 0; nb < 3; ++nb)
#pragma unroll
            for (int r = 0; r < 4; ++r) part[(kh * 64 + 16 * tg + 4 * kq + r) * 48 + 16 * nb + li] = acc[nb][r];
        if (kq == 0) ssqL[kh * 64 + 16 * tg + li] = ss;
        __syncthreads();
        if (tid < 64) {
            const int t = tok0 + tid;
            const float rs = __builtin_amdgcn_rsqf((ssqL[tid] + ssqL[64 + tid]) * (1.0f / D) + EPS);
            rstdm[t] = rs; asw[256 + tid] = rs;
            float lg[4]; int gi = 0;
#pragma unroll
            for (int c = 0; c < 4; ++c) lg[c] = rs * (part[tid * 48 + c] + part[(64 + tid) * 48 + c]) + gb[c];
#pragma unroll
            for (int c = 1; c < 4; ++c) gi = lg[c] > lg[gi] ? c : gi;
            float gden = 0.f;
#pragma unroll
            for (int c = 0; c < 4; ++c) gden += __expf(lg[c] - lg[gi]);
            const float gval = 1.0f / gden;
            float el[8];
#pragma unroll
            for (int c = 0; c < 8; ++c) el[c] = rs * (part[tid * 48 + 4 + gi * 8 + c] + part[(64 + tid) * 48 + 4 + gi * 8 + c]) + eb[gi * 8 + c];
            int e0 = 0;
#pragma unroll
            for (int c = 1; c < 8; ++c) e0 = el[c] > el[e0] ? c : e0;
            int e1 = e0 == 0 ? 1 : 0;
#pragma unroll
            for (int c = 0; c < 8; ++c) e1 = (c != e0 && el[c] > el[e1]) ? c : e1;
            const float x1 = __expf(el[e1] - el[e0]);
            const float w0 = gval / (1.0f + x1), w1 = gval * x1 / (1.0f + x1);
            const int E0 = gi * 8 + e0, E1 = gi * 8 + e1;
            asg[tid * 2] = E0; asg[tid * 2 + 1] = E1; asw[tid * 2] = w0; asw[tid * 2 + 1] = w1;
            asg[128 + tid * 2] = (int)atomicAdd((unsigned*)&cl[E0], 1u); asg[128 + tid * 2 + 1] = (int)atomicAdd((unsigned*)&cl[E1], 1u);
        }
        __syncthreads();
        if (tid < 32) { const unsigned n = cl[tid]; cl[32 + tid] = n ? atomicAdd(&cntg[tid], n) : 0u; }
        __syncthreads();
        if (tid < 128) { const int t = tok0 + (tid >> 1), e = asg[tid], r = (int)cl[32 + e] + asg[128 + tid];
            list[(size_t)e * T + r] = t; wlist[(size_t)e * T + r] = asw[tid]; rlist[(size_t)e * T + r] = asw[256 + (tid >> 1)]; slote[t * 2 + (tid & 1)] = e; slotr[t * 2 + (tid & 1)] = r; }
        __syncthreads();
    }
}
__device__ __forceinline__ int moe_tables(const Frame& F, int layer) {
    volatile LAS unsigned* ord = (volatile LAS unsigned*)(F.lds + LDS_ORD);
    __syncthreads();
    if (F.tid < 64) {
        const int e = F.tid & 31;
        const unsigned n = __hip_atomic_load(F.ctl + CW_CNT + layer * 32 + e, __ATOMIC_RELAXED, __HIP_MEMORY_SCOPE_AGENT);
        const int nt = (int)((n + 255u) >> 8), nfu = (int)(n >> 8), r = (int)(n & 255u), nh = (r > 0) + (r > 128);
        int pt = nt, pf = nfu, ph = nh;
#pragma unroll
        for (int o = 1; o < 32; o <<= 1) { const int a = __shfl_up(pt, o), b = __shfl_up(pf, o), c = __shfl_up(ph, o); if ((F.tid & 31) >= o) { pt += a; pf += b; ph += c; } }
        const int tot_f = __shfl(pf, 31), tot_h = __shfl(ph, 31), tot = __shfl(pt, 31);
        if (F.tid < 32) {
            const int t0 = pt - nt;
            F.misc[MW_CNT + e] = n; F.misc[MW_TAB + e] = (unsigned)t0; if (e == 31) { F.misc[MW_TAB + NEXP] = (unsigned)tot; F.misc[MW_NORD] = (unsigned)(tot_f + tot_h); }
            for (int k = 0; k < nfu; ++k) ord[(pf - nfu) + k] = (unsigned)(t0 + k) | ((unsigned)e << 8);
            if (nh > 0) ord[tot_f + (ph - nh)] = (unsigned)(t0 + nfu) | ((unsigned)e << 8) | (1u << 16);
            if (nh > 1) ord[tot_f + (ph - nh) + 1] = (unsigned)(t0 + nfu) | ((unsigned)e << 8) | (2u << 16);
        }
    }
    __syncthreads();
    return __builtin_amdgcn_readfirstlane((int)F.misc[MW_NORD]);
}
__device__ __forceinline__ void unpack8_f8(const u32x2 w, float (&v)[8]) {
    const f32x2 a = __builtin_amdgcn_cvt_pk_f32_fp8((int)w.x, false), b = __builtin_amdgcn_cvt_pk_f32_fp8((int)w.x, true), c = __builtin_amdgcn_cvt_pk_f32_fp8((int)w.y, false), d = __builtin_amdgcn_cvt_pk_f32_fp8((int)w.y, true);
    v[0] = a[0]; v[1] = a[1]; v[2] = b[0]; v[3] = b[1]; v[4] = c[0]; v[5] = c[1]; v[6] = d[0]; v[7] = d[1]; }
template <bool F8Y>
__device__ __forceinline__ void combine_phase(const Params& P, const Frame& F, const bf16_t* hin, bf16_t* hout, unsigned char* h8) {
    unsigned char* ws = P.ws; const bf16_t* Y = (const bf16_t*)(ws + SM_Y);
    const int* slote = (const int*)(ws + WS_SLOTE); const int* slotr = (const int*)(ws + WS_SLOTR); float* rstdp = (float*)(ws + WS_RSTDP);
    const int step = F.G * 8;
    for (int t0 = F.bx * 8 + F.wave; t0 < T; t0 += 2 * step) {
        const int t1 = t0 + step; const bool two = t1 < T; const int tb = two ? t1 : t0;
        const int ea0 = slote[t0 * 2], ea1 = slote[t0 * 2 + 1], eb0 = slote[tb * 2], eb1 = slote[tb * 2 + 1];
        const size_t ra0 = (size_t)F.misc[MW_TAB + ea0] * 256 + slotr[t0 * 2], ra1 = (size_t)F.misc[MW_TAB + ea1] * 256 + slotr[t0 * 2 + 1];
        const size_t rb0 = (size_t)F.misc[MW_TAB + eb0] * 256 + slotr[tb * 2], rb1 = (size_t)F.misc[MW_TAB + eb1] * 256 + slotr[tb * 2 + 1];
        u32x4 ya0[4], ya1[4], ha[4], yb0[4], yb1[4], hb_[4];
#pragma unroll
        for (int j = 0; j < 4; ++j) { const int c = 8 * (F.lane + 64 * j);
            if (F8Y) { const unsigned char* Y8 = (const unsigned char*)Y; ya0[j].x = ((const u32x2*)(Y8 + ra0 * D + c))->x; ya0[j].y = ((const u32x2*)(Y8 + ra0 * D + c))->y; ya1[j].x = ((const u32x2*)(Y8 + ra1 * D + c))->x; ya1[j].y = ((const u32x2*)(Y8 + ra1 * D + c))->y;
                       yb0[j].x = ((const u32x2*)(Y8 + rb0 * D + c))->x; yb0[j].y = ((const u32x2*)(Y8 + rb0 * D + c))->y; yb1[j].x = ((const u32x2*)(Y8 + rb1 * D + c))->x; yb1[j].y = ((const u32x2*)(Y8 + rb1 * D + c))->y; }
            else { ya0[j] = *(const u32x4*)(Y + ra0 * D + c); ya1[j] = *(const u32x4*)(Y + ra1 * D + c); yb0[j] = *(const u32x4*)(Y + rb0 * D + c); yb1[j] = *(const u32x4*)(Y + rb1 * D + c); }
            ha[j] = *(const u32x4*)(hin + (size_t)t0 * D + c); hb_[j] = *(const u32x4*)(hin + (size_t)tb * D + c); }
        float ssa = 0.f, ssb = 0.f;
#pragma unroll
        for (int j = 0; j < 4; ++j) { const int c = 8 * (F.lane + 64 * j); const size_t o = (size_t)t0 * D + c;
            float y0[8], y1[8], v[8]; if (F8Y) { unpack8_f8((u32x2){ya0[j].x, ya0[j].y}, y0); unpack8_f8((u32x2){ya1[j].x, ya1[j].y}, y1); } else { unpack8(ya0[j], y0); unpack8(ya1[j], y1); } unpack8(ha[j], v);
#pragma unroll
            for (int e = 0; e < 8; ++e) { v[e] = F8Y ? fmaf(y0[e] + y1[e], 1.0f / F8_OSC, v[e]) : v[e] + y0[e] + y1[e]; ssa += v[e] * v[e]; }
            *(u32x4*)(hout + o) = pack8(v); if (h8) *(u32x2*)(h8 + o) = pack8_f8(v); }
        if (two) {
#pragma unroll
            for (int j = 0; j < 4; ++j) { const int c = 8 * (F.lane + 64 * j); const size_t o = (size_t)t1 * D + c;
                float y0[8], y1[8], v[8]; if (F8Y) { unpack8_f8((u32x2){yb0[j].x, yb0[j].y}, y0); unpack8_f8((u32x2){yb1[j].x, yb1[j].y}, y1); } else { unpack8(yb0[j], y0); unpack8(yb1[j], y1); } unpack8(hb_[j], v);
#pragma unroll
                for (int e = 0; e < 8; ++e) { v[e] = F8Y ? fmaf(y0[e] + y1[e], 1.0f / F8_OSC, v[e]) : v[e] + y0[e] + y1[e]; ssb += v[e] * v[e]; }
                *(u32x4*)(hout + o) = pack8(v); if (h8) *(u32x2*)(h8 + o) = pack8_f8(v); }
        }
#pragma unroll
        for (int o = 32; o > 0; o >>= 1) { ssa += __shfl_xor(ssa, o); ssb += __shfl_xor(ssb, o); }
        if (F.lane == 0) { rstdp[t0] = __builtin_amdgcn_rsqf(ssa * (1.0f / D) + EPS); if (two) rstdp[t1] = __builtin_amdgcn_rsqf(ssb * (1.0f / D) + EPS); }
    }
}
__device__ __forceinline__ void final_norm_phase(const Params& P, const Frame& F, const bf16_t* hin) {
    float* out = P.out; const float* g = P.in[I_FINN];
    const int step = F.G * 8;
    f32x4 g0[4], g1[4];
#pragma unroll
    for (int j = 0; j < 4; ++j) { const int c = 8 * (F.lane + 64 * j); g0[j] = *(const f32x4*)(g + c); g1[j] = *(const f32x4*)(g + c + 4); }
    for (int t0 = F.bx * 8 + F.wave; t0 < T; t0 += 2 * step) {
        const int t1 = t0 + step; const bool two = t1 < T; const int tb = two ? t1 : t0;
        u32x4 wa[4], wb[4];
#pragma unroll
        for (int j = 0; j < 4; ++j) { wa[j] = *(const u32x4*)(hin + (size_t)t0 * D + 8 * (F.lane + 64 * j)); wb[j] = *(const u32x4*)(hin + (size_t)tb * D + 8 * (F.lane + 64 * j)); }
#pragma unroll
        for (int k = 0; k < 2; ++k) {
            if (k == 1 && !two) break;
            const int t = k ? t1 : t0;
            float v[4][8]; float ss = 0.f;
#pragma unroll
            for (int j = 0; j < 4; ++j) { unpack8(k ? wb[j] : wa[j], v[j]);
#pragma unroll
                for (int e = 0; e < 8; ++e) ss += v[j][e] * v[j][e]; }
#pragma unroll
            for (int o = 32; o > 0; o >>= 1) ss += __shfl_xor(ss, o);
            const float rs = __builtin_amdgcn_rsqf(ss * (1.0f / D) + EPS);
#pragma unroll
            for (int j = 0; j < 4; ++j) { const int c = 8 * (F.lane + 64 * j);
                __builtin_nontemporal_store((f32x4){v[j][0] * rs * g0[j][0], v[j][1] * rs * g0[j][1], v[j][2] * rs * g0[j][2], v[j][3] * rs * g0[j][3]}, (f32x4*)(out + (size_t)t * D + c));
                __builtin_nontemporal_store((f32x4){v[j][4] * rs * g1[j][0], v[j][5] * rs * g1[j][1], v[j][6] * rs * g1[j][2], v[j][7] * rs * g1[j][3]}, (f32x4*)(out + (size_t)t * D + c + 4)); }
        }
    }
}
__device__ __forceinline__ void cumsum_seq(const Params& P, const Frame& F, int seq) {
    const float* lf = (const float*)(P.ws + S1_LF); float* cum = (float*)(P.ws + S1_CUM);
    LAS float* sc = (LAS float*)F.lds;
    const int b = seq >> 3, hd = seq & 7, tid = F.tid;
    float v[8], run = 0.f;
#pragma unroll
    for (int i = 0; i < 8; ++i) { run += lf[((size_t)b * S + tid * 8 + i) * 8 + hd]; v[i] = run; }
    sc[tid] = run; __syncthreads();
    if (tid == 0) { float r = 0.f; for (int i = 0; i < NTHR; ++i) { const float x = sc[i]; sc[i] = r; r += x; } }
    __syncthreads();
    const float base = sc[tid];
#pragma unroll
    for (int i = 0; i < 8; ++i) cum[(size_t)seq * S + tid * 8 + i] = (base + v[i]) * LOG2E;
    __syncthreads();
}
__device__ __forceinline__ int queue_next(const Frame& F, int q) {
    __syncthreads();
    if (F.tid == 0) F.misc[MW_ITEM] = atomicAdd(F.ctl + CW_QUEUE + 64 * q, 1u);
    __syncthreads();
    return __builtin_amdgcn_readfirstlane((int)F.misc[MW_ITEM]);
}
__device__ __forceinline__ int queue_next1(const Frame& F, int q, unsigned& n) {
    const int slot = MW_ITEM + (int)(n & 1u); ++n;
    if (F.tid == 0) F.misc[slot] = atomicAdd(F.ctl + CW_QUEUE + 64 * q, 1u);
    __syncthreads();
    return __builtin_amdgcn_readfirstlane((int)F.misc[slot]);
}
constexpr int NPHASE = 21;
constexpr int PP1_GU_V0 = 160;
__device__ __forceinline__ int pp1_gu(int G) { return G == 256 ? 2 * (256 - PP1_GU_V0) : 0; }
__device__ __forceinline__ int pp1_tail(int G) { const int nfull = ((NIN1 / 256) * (T / 256)) % G; int n = 2 * (G - nfull); const int all = (T / 256) * (D / 256); return n < all ? n : all; }
__global__ void __launch_bounds__(NTHR, 2) mega_fwd(Params P) {
    extern __shared__ __attribute__((aligned(16))) unsigned char lds_raw[];
    Frame F;
    F.lds = (LAS unsigned char*)lds_raw; F.misc = (volatile LAS unsigned*)(F.lds + LDS_MISC);
    F.tid = threadIdx.x; F.lane = F.tid & 63; F.wave = __builtin_amdgcn_readfirstlane(F.tid >> 6);
    F.G = gridDim.x; F.bx = blockIdx.x; F.vcu = (F.G % 8 == 0) ? (F.bx % 8) * (F.G / 8) + F.bx / 8 : F.bx;
    F.ws = P.ws; F.ctl = (unsigned*)(P.ws + WS_CTL);
    unsigned char* ws = P.ws;
    for (int u = F.tid; u < 256; u += NTHR) F.misc[u] = 0u;
    __syncthreads();
    const int lo = P.ph_lo, hi = P.ph_hi;
    const bool fused = (hi - lo) > 1;
    XcdBarrier bar; bar.bar = F.ctl + CW_BAR; bar.x = 0; bar.st = F.misc + MW_BAR;
    if (fused) bar = xcd_barrier_post(F.ctl + CW_BAR, F.misc + MW_BAR);
#define IN(k) (lo <= (k) && (k) < hi)
#define SEAM(k) do { if (IN((k) + 1)) xcd_barrier(bar); } while (0)
    LAS unsigned char* stage = F.lds + LDS_STAGE;
    bf16_t* hbA = (bf16_t*)(ws + WS_HBA); bf16_t* hbB = (bf16_t*)(ws + WS_HBB); unsigned char* h8A = ws + WS_H8A; unsigned char* h8B = ws + WS_H8B;
    const float* c128 = (const float*)(ws + WS_COS128); const float* s128 = (const float*)(ws + WS_SIN128);
    const float* c64 = (const float*)(ws + WS_COS64); const float* s64 = (const float*)(ws + WS_SIN64);

    if (IN(0)) { p0_prologue(P, F); SEAM(0); }

    if (IN(1)) {
        pg8::PlainOrder S; S.init(F8_IN0 ? (const bf16_t*)h8A : hbA, F8_IN0 ? D / 2 : D, (const bf16_t*)(ws + WS_WIN0T), F8_IN0 ? D / 2 : D, T, NIN0, F.G, F.bx);
        epi::In0 E{(const float*)(ws + WS_RSTD0), c128, s128, c64, s64, (bf16_t*)(ws + S0_QA), (bf16_t*)(ws + S0_KA), (bf16_t*)(ws + S0_VTA), (bf16_t*)(ws + S0_QLAT), (bf16_t*)(ws + S0_KVLAT),
                   (bf16_t*)(ws + S0_KB + (size_t)T * 1024 * (KV8 ? 1 : 2)), (float*)(ws + WS_SSQQ), (float*)(ws + WS_SSQKV)};
        pg8::gemm_phase_t<F8_IN0>(stage, F8_IN0 ? D / 2 : D, S, E, F8_SC_IN1);
        if (F.bx >= F.G / 2) p0_rest(P, F, F.bx - F.G / 2, F.G - F.G / 2);
        unsigned qn4 = 0;
        for (;;) { const int i = queue_next1(F, 4, qn4); if (i >= (NCONV_FG - 320 + 1) / 2) break;
            Frame Fi = F; asm volatile("" : "+v"(Fi.tid), "+v"(Fi.lane));
            const int t0 = 320 + 2 * i; conv_range(P, Fi.tid, t0, 1, t0 + 2 < NCONV_FG ? t0 + 2 : NCONV_FG, -1); }
        SEAM(1);
    }
    if (IN(2)) {
        { pg8::PlainOrder S; S.init((const bf16_t*)(ws + S0_QLAT), 512, (const bf16_t*)(ws + WS_WUQT), 512, T, 1536, F.G, F.bx);
          epi::Uq E{(const float*)(ws + WS_SSQQ), c64, s64, (bf16_t*)(ws + S0_QB)};
          pg8::gemm_phase(stage, 512, S, E); }
        { pg8::PlainOrder S; S.init((const bf16_t*)(ws + S0_KVLAT), 256, (const bf16_t*)(ws + WS_WUKVT), 256, T, 2048, F.G, F.bx);
          epi::Ukv E{(const float*)(ws + WS_SSQKV), (bf16_t*)(ws + S0_KB), (bf16_t*)(ws + S0_VTB)};
          pg8::gemm_phase(stage, 256, S, E); }
        {
          pg8::PlainOrder S; S.init((const bf16_t*)(ws + WS_PB), 256, (const bf16_t*)(ws + WS_WPPT), 256, T, D, F.G, F.bx);
          const int nlo = F.G / 2, nhi = F.G - nlo, chi = (S.nwg * 3) / 4;
          if (F.bx >= nlo) S.sub(0, chi, nhi, F.bx - nlo); else S.sub(chi, S.nwg - chi, nlo, F.bx);
          epi::PlainBf16 E{(bf16_t*)(ws + WS_PP), D};
          pg8::gemm_phase(stage, 256, S, E); }
        if (F.bx == 0) {
            const float* part = (const float*)(ws + WS_SSQP); float* cb = (float*)(ws + WS_CBIAS);
            float a = 0.f;
#pragma unroll
            for (int kp = 0; kp < 64; ++kp) a += part[kp * 512 + F.tid];
            cb[F.tid] = a;
        }
        SEAM(2);
    }
    if (IN(3)) {
        const att::L0Bufs Bf{(const bf16_t*)(ws + S0_QA), (const bf16_t*)(ws + S0_KA), (const bf16_t*)(ws + S0_VTA), (const bf16_t*)(ws + S0_QB), (const bf16_t*)(ws + S0_KB), (const bf16_t*)(ws + S0_KB + (size_t)T * 1024 * (KV8 ? 1 : 2)), (const bf16_t*)(ws + S0_VTB),
                             P.in[I_SINKS], (bf16_t*)(ws + S0_O)};
        unsigned qn0 = 0;
        for (;;) { const int p = queue_next1(F, 0, qn0); if (p >= 2048) break;
            Frame Fi = F; asm volatile("" : "+v"(Fi.tid), "+v"(Fi.lane));
            if (p < 1536) { const int grp = p / 3, r3 = p - 3 * grp;
                            if (r3 == 0) { const int idx = grp, qt = 15 - (idx >> 5), bh = idx & 31; att::item_B(Fi, Bf, bh >> 3, bh & 7, qt); }
                            else { const int cc = grp * 2 + r3 - 1; conv_range(P, Fi.tid, 6 * cc, 1, 6 * cc + 6, 0); } }
            else { const int ia = p - 1536, qt = 63 - (ia >> 3), bhk = ia & 7; att::item_A(Fi, Bf, bhk >> 1, bhk & 1, qt); } }
        SEAM(3);
    }
    if (IN(4)) {
        { pg8::PlainOrder S; S.init(F8_WO0 ? (const bf16_t*)(ws + WS_O8) : (const bf16_t*)(ws + S0_O), F8_WO0 ? D / 2 : D, (const bf16_t*)(ws + WS_WO0T), F8_WO0 ? D / 2 : D, T, D, F.G, F.bx);
          epi::Wo<true> E{P.in[I_X], hbB, F8_MOE0 ? h8B : nullptr};
          pg8::gemm_phase_t<F8_WO0>(stage, F8_WO0 ? D / 2 : D, S, E, F8_SC_WO); }
        SEAM(4);
    }
#define MOE_PLE_PHASES(PH, LAYER, HB_IN, HB_MID, HB_OUT, H8_IN, H8_MID, H8_OUT, F8M, F8P, F8Y)                                                                             \
    if (IN((PH) + 0)) { router_phase(P, F, (LAYER), (HB_IN)); SEAM((PH) + 0); }                                                                                       \
    if (IN((PH) + 1)) { const int nrt = moe_tables(F, (LAYER));                                                                                                       \
        pg8::MoeOrder<true, 4> S{(F8M) ? (const bf16_t*)(H8_IN) : (HB_IN), (const bf16_t*)(ws + WS_WGU) + (size_t)(LAYER) * 32 * 1024 * 2048, (F8M) ? D / 2 : D, (F8M) ? D / 2 : D, \
                                 (F8M) ? (size_t)1024 * 1024 : (size_t)1024 * 2048, (const int*)(ws + WS_LIST), F.misc + MW_TAB, F.misc + MW_CNT, (volatile LAS unsigned*)(F.lds + LDS_ORD), F.G, F.vcu, nrt * 4};                             \
        epi::MoeGu<F8M> E{(const float*)(ws + WS_RLIST), F.misc + MW_CNT, (bf16_t*)(ws + SM_H)};                                                                      \
        pg8::gemm_phase_t<F8M>(stage, (F8M) ? D / 2 : D, S, E, F8_SC_GU);                                                                                              \
        if ((LAYER) == 0 && pp1_gu(F.G) > 0 && F.vcu >= PP1_GU_V0) { pg8::PlainOrder S2; S2.init((const bf16_t*)(ws + WS_PB) + (size_t)T * 256, 256, (const bf16_t*)(ws + WS_WPPT) + (size_t)2048 * 256, 256, T, D, F.G, F.bx); \
            S2.sub(0, pp1_gu(F.G), F.G - PP1_GU_V0, F.vcu - PP1_GU_V0); epi::PlainBf16 E2{(bf16_t*)(ws + WS_PP1), D}; pg8::gemm_phase(stage, 256, S2, E2); }                         \
        SEAM((PH) + 1); }                                                                           \
    if (IN((PH) + 2)) { const int nrt = moe_tables(F, (LAYER));                                                                                                       \
        pg8::MoeOrder<false, 8> S{(const bf16_t*)(ws + SM_H), (const bf16_t*)(ws + WS_WDN) + (size_t)(LAYER) * 32 * 2048 * 512, (F8M) ? EH / 2 : EH, (F8M) ? EH / 2 : EH, \
                                  (size_t)2048 * 512, (const int*)(ws + WS_LIST), F.misc + MW_TAB, F.misc + MW_CNT, (volatile LAS unsigned*)(F.lds + LDS_ORD), F.G, F.vcu, nrt * 8};                             \
        epi::MoeDn<F8Y> E{(const float*)(ws + WS_WLIST), F.misc + MW_CNT, (bf16_t*)(ws + SM_Y)};                                                                           \
        pg8::gemm_phase_t<F8M>(stage, (F8M) ? EH / 2 : EH, S, E, F8_SC_DN); SEAM((PH) + 2); }                                                                         \
    if (IN((PH) + 3)) { (void)moe_tables(F, (LAYER)); combine_phase<F8Y>(P, F, (HB_IN), (HB_MID), (F8P) ? (H8_MID) : nullptr); SEAM((PH) + 3); }                           \
    if (IN((PH) + 4)) { pg8::PlainOrder S; S.init((F8P) ? (const bf16_t*)(H8_MID) : (HB_MID), (F8P) ? D / 2 : D, (const bf16_t*)(ws + WS_WPGT) + (size_t)(LAYER) * 2048 * 2048, (F8P) ? D / 2 : D, T, D, F.G, F.bx); \
        epi::Ple E{(const float*)(ws + WS_RSTDP), (const bf16_t*)(ws + ((LAYER) ? WS_PP1 : WS_PP)), (HB_MID), (HB_OUT), (LAYER) == 0 ? (float*)(ws + WS_SSQP) : (float*)nullptr, (H8_OUT)};                                 \
        pg8::gemm_phase_t<F8P>(stage, (F8P) ? D / 2 : D, S, E, F8_SC_PG); SEAM((PH) + 4); }

    MOE_PLE_PHASES(5, 0, hbB, hbA, hbB, h8B, h8A, (F8_IN1 ? h8B : nullptr), F8_MOE0, F8_PLE0, false)

    if (IN(10)) {
        pg8::PlainOrder S; S.init(F8_IN1 ? (const bf16_t*)h8B : hbB, F8_IN1 ? D / 2 : D, (const bf16_t*)(ws + WS_WIN1T), F8_IN1 ? D / 2 : D, T, NIN1, F.G, F.bx);
        epi::In1 E{(const float*)(ws + WS_SSQP), c128, s128, P.in[I_FB], (bf16_t*)(ws + S1_CQ), (bf16_t*)(ws + S1_CK), (bf16_t*)(ws + S1_CVT), (bf16_t*)(ws + S1_DQ), (bf16_t*)(ws + S1_KC), (bf16_t*)(ws + S1_VC),
                   (bf16_t*)(ws + S1_KS), (bf16_t*)(ws + S1_VST), (bf16_t*)(ws + S1_KW), (bf16_t*)(ws + S1_VWT), (float*)(ws + S1_LF), (float*)(ws + S1_DG)};
        pg8::gemm_phase_t<F8_IN1>(stage, F8_IN1 ? D / 2 : D, S, E, F8_SC_IN1);
        {
          const int nfull = S.nwg % F.G;
          if (nfull > 0) {
              pg8::PlainOrder S2; S2.init((const bf16_t*)(ws + WS_PB) + (size_t)T * 256, 256, (const bf16_t*)(ws + WS_WPPT) + (size_t)2048 * 256, 256, T, D, F.G, F.bx);
              S2.sub(pp1_gu(F.G), pp1_tail(F.G), F.G - nfull, F.bx >= nfull ? F.bx - nfull : -1);
              epi::PlainBf16 E2{(bf16_t*)(ws + WS_PP1), D};
              pg8::gemm_phase(stage, 256, S2, E2); } }
        SEAM(10);
    }
    const att::L1Bufs B1{(const bf16_t*)(ws + S1_CQ), (const bf16_t*)(ws + S1_CK), (const bf16_t*)(ws + S1_CVT), (const bf16_t*)(ws + S1_DQ), (const bf16_t*)(ws + S1_KS), (const bf16_t*)(ws + S1_VST),
                         (const bf16_t*)(ws + S1_KW), (const bf16_t*)(ws + S1_VWT), (const bf16_t*)(ws + S1_KCMP), (const bf16_t*)(ws + S1_VCMPT), (const float*)(ws + S1_CUM), (const float*)(ws + S1_DG),
                         (u64*)(ws + S1_SEL), (bf16_t*)(ws + S1_O)};
    if (IN(11)) {
        const int cv = (F.bx + F.G - 16) % F.G;
        { pg8::HalfOrder S{(const bf16_t*)(ws + S1_KC), (const bf16_t*)(ws + WS_WC1KT), F8_CMP ? 1024 : 2048, 16, F.G, F.bx};
          epi::Cmp1<true> E{(const float*)(ws + WS_CBIAS), (bf16_t*)(ws + S1_HID)};
          pg8::gemm_phase_t<F8_CMP>(stage, F8_CMP ? 2048 : 4096, S, E, F8_SC_IN1); }
        { pg8::HalfOrder S{(const bf16_t*)(ws + S1_VC), (const bf16_t*)(ws + WS_WC1VT), F8_CMP ? 1024 : 2048, 16, F.G, cv};
          epi::Cmp1<true> E{(const float*)(ws + WS_CBIAS) + 256, (bf16_t*)(ws + S1_HID) + (size_t)2048 * 256};
          pg8::gemm_phase_t<F8_CMP>(stage, F8_CMP ? 2048 : 4096, S, E, F8_SC_IN1); }
        if (F.bx < 32) { asm volatile("s_waitcnt vmcnt(0)" ::: "memory"); __syncthreads(); __builtin_amdgcn_fence(__ATOMIC_ACQUIRE, "agent"); asm volatile("s_waitcnt vmcnt(0)" ::: "memory"); __syncthreads(); }
        { pg8::HalfOrder S{(const bf16_t*)(ws + S1_HID), (const bf16_t*)(ws + WS_WC2KT), 256, 16, F.G, F.bx};
          epi::Cmp2<true, true> E{c128, s128, (bf16_t*)(ws + S1_KCMP)};
          pg8::gemm_phase(stage, 256, S, E); }
        { pg8::HalfOrder S{(const bf16_t*)(ws + S1_HID) + (size_t)2048 * 256, (const bf16_t*)(ws + WS_WC2VT), 256, 16, F.G, cv};
          epi::Cmp2<false, true> E{c128, s128, (bf16_t*)(ws + S1_VCMPT)};
          pg8::gemm_phase(stage, 256, S, E); }
        if (F.bx >= 32 && F.bx < 64) cumsum_seq(P, F, F.bx - 32);
        if (F.bx >= 32) {
          pg8::PlainOrder S; S.init((const bf16_t*)(ws + WS_PB) + (size_t)T * 256, 256, (const bf16_t*)(ws + WS_WPPT) + (size_t)2048 * 256, 256, T, D, F.G - 32, F.bx - 32);
          { const int done = pp1_gu(F.G) + (((NIN1 / 256) * (T / 256)) % F.G > 0 ? pp1_tail(F.G) : 0); S.sub(done, S.nwg - done, F.G - 32, F.bx - 32); }
          epi::PlainBf16 E{(bf16_t*)(ws + WS_PP1), D};
          pg8::gemm_phase(stage, 256, S, E); }
        unsigned qn1 = 0;
        for (;;) { const int idx = queue_next1(F, 1, qn1); if (idx >= 512) break;
            Frame Fi = F; asm volatile("" : "+v"(Fi.tid), "+v"(Fi.lane));
            const int qt = 63 - (idx >> 3), bhk = idx & 7; att::item_W(Fi, B1, bhk >> 1, bhk & 1, qt); }
        SEAM(11);
    }
    if (IN(13)) {
        unsigned qn2 = 0;
        for (;;) { const int p = queue_next1(F, 2, qn2); if (p >= 2048) break;
            Frame Fi = F; asm volatile("" : "+v"(Fi.tid), "+v"(Fi.lane));
            const int grp2 = p / 3, r32 = p - 3 * grp2;
            if (p < 1536 && r32 != 0) { const int cc = grp2 * 2 + r32 - 1; conv_range(P, Fi.tid, 6 * cc, 1, 6 * cc + 6, 1); }
            else { const int idx = p < 1536 ? grp2 : 512 + (p - 1536); const int k = idx >> 1;
                if (!(idx & 1)) { const int qt = 15 - (k >> 5), bh = k & 31; att::item_C(Fi, B1, bh >> 3, bh & 7, qt); }
                else { const int qt = 63 - (k >> 3), bhk = k & 7; att::item_S(Fi, B1, bhk >> 1, bhk & 1, qt); } } }
        SEAM(13);
    }
    if (IN(14)) {
        { pg8::PlainOrder S; S.init(F8_WO1 ? (const bf16_t*)(ws + WS_O8) : (const bf16_t*)(ws + S1_O), F8_WO1 ? D / 2 : D, (const bf16_t*)(ws + WS_WO1T), F8_WO1 ? D / 2 : D, T, D, F.G, F.bx);
          epi::Wo<false> E{hbB, hbA, F8_MOE1 ? h8A : nullptr};
          pg8::gemm_phase_t<F8_WO1>(stage, F8_WO1 ? D / 2 : D, S, E, F8_SC_WO); }
        SEAM(14);
    }
    MOE_PLE_PHASES(15, 1, hbA, hbB, hbA, h8A, h8B, ((unsigned char*)nullptr), F8_MOE1, F8_PLE1, F8_Y1)
    if (IN(20)) { final_norm_phase(P, F, hbA); }
#undef IN
#undef SEAM
}

extern "C" void kernel_launch(void* const* d_in, const int* in_sizes, int n_in, void* d_out, int out_size, void* d_ws, size_t ws_size, hipStream_t stream) {
    static int grid = 0;
    if (grid == 0) {
        if (n_in != 32 || out_size != T * D || ws_size < WS_END) { fprintf(stderr, "kernel_launch: unexpected problem (n_in %d, out %d, ws %zu < %zu)\n", n_in, out_size, ws_size, (size_t)WS_END); grid = -1; return; }
        int dev = 0, cus = 0, per_cu = 0;
        if (hipGetDevice(&dev) != hipSuccess || hipDeviceGetAttribute(&cus, hipDeviceAttributeMultiprocessorCount, dev) != hipSuccess) { grid = -1; return; }
        if (hipFuncSetAttribute((const void*)mega_fwd, hipFuncAttributeMaxDynamicSharedMemorySize, LDS_BYTES) != hipSuccess) { fprintf(stderr, "kernel_launch: hipFuncSetAttribute failed\n"); grid = -1; return; }
        if (hipOccupancyMaxActiveBlocksPerMultiprocessor(&per_cu, (const void*)mega_fwd, NTHR, LDS_BYTES) != hipSuccess || per_cu < 1) fprintf(stderr, "kernel_launch: occupancy query says %d\n", per_cu);
        (void)hipGetLastError();
        grid = cus;
    }
    if (grid < 0) return;
    (void)in_sizes;
    if (hipMemsetAsync((char*)d_ws + WS_CTL, 0, CTL_BYTES, stream) != hipSuccess) return;
    Params p{};
    for (int i = 0; i < 32; ++i) p.in[i] = (const float*)d_in[i];
    p.out = (float*)d_out; p.ws = (unsigned char*)d_ws;
    p.ph_lo = 0; p.ph_hi = NPHASE;
    hipLaunchKernelGGL(mega_fwd, dim3(grid), dim3(NTHR), LDS_BYTES, stream, p);
}
```
